# Optimizing an MI355X kernel written in HIP

```python
import jax, jax.numpy as jnp
from jax import lax
import numpy as np

D_MODEL = 1024
BATCH = 8
SEQ = 2048
DEPTH = 2
DEC_BATCH = 128
DEC_SEQ = 4
PAST_LEN = 16384
PAGE_SIZE = 128

HEAD_DIM = 64
W_A = 3 * D_MODEL // 8
W_B = 3 * D_MODEL // 8
W_C = D_MODEL // 4
A_HEADS = W_A // HEAD_DIM
B_HEADS = W_B // HEAD_DIM
C_HEADS = W_C // HEAD_DIM
MIX_WIDTH = W_A + W_B + W_C
A_KERNEL = 31
B_KERNEL = 3
CHUNK = 128
EPS = 1e-6
SPLIT_SIZES = (W_A, W_A, W_A, W_B, W_B, W_B, W_B, W_C, W_C, W_C)
IN_WIDTH = sum(SPLIT_SIZES)

kernel_name = "hybrid_conformer_shortconv_chunkmlp_step"


def rms_norm(x, g):
    xf = x.astype(jnp.float32)
    y = xf * lax.rsqrt(jnp.mean(xf * xf, axis=-1, keepdims=True) + EPS)
    return (y * g.astype(jnp.float32)).astype(x.dtype)


def layer_norm(x, g, b):
    xf = x.astype(jnp.float32)
    mu = jnp.mean(xf, axis=-1, keepdims=True)
    var = jnp.mean(jnp.square(xf - mu), axis=-1, keepdims=True)
    y = (xf - mu) * lax.rsqrt(var + EPS)
    return (y * g.astype(jnp.float32) + b.astype(jnp.float32)).astype(x.dtype)


def causal_dwconv(buf, x, w):
    full = jnp.concatenate([buf.astype(x.dtype), x], axis=1)
    k, c = w.shape
    y = lax.conv_general_dilated(full, w.astype(x.dtype)[:, None, :], window_strides=(1,),
                                 padding='VALID', dimension_numbers=('NWC', 'WIO', 'NWC'),
                                 feature_group_count=c)
    return y, full[:, full.shape[1] - (k - 1):, :]


def chunk_mix_prompt(v, ws, bs):
    n, t, _ = v.shape
    mask = jnp.tril(jnp.ones((CHUNK, CHUNK), ws.dtype))
    wm = (ws * mask).astype(v.dtype)
    vh = v.reshape(n, t // CHUNK, CHUNK, C_HEADS, HEAD_DIM)
    out = jnp.einsum('hts,ncshd->ncthd', wm, vh) + bs.astype(v.dtype).T[None, None, :, :, None]
    return out.reshape(n, t, W_C)


def chunk_mix_new_chunk(v, ws, bs):
    n, t, _ = v.shape
    mask = jnp.tril(jnp.ones((CHUNK, CHUNK), ws.dtype))
    wm = (ws * mask)[:, :t, :t].astype(v.dtype)
    vh = v.reshape(n, t, C_HEADS, HEAD_DIM)
    out = jnp.einsum('hts,nshd->nthd', wm, vh) + bs[:, :t].astype(v.dtype).T[None, :, :, None]
    return out.reshape(n, t, W_C)


def hybrid_layer(x, a_buf, b_buf, chunk_fn, norm_g, w_in, a_conv_w, a_conv_b, a_ln_g, a_ln_b,
                 b_conv_w, c_ln_g, c_ln_b, c_ws, c_bs, w_out):
    h = rms_norm(x, norm_g)
    p = jnp.einsum('ntd,de->nte', h, w_in.astype(h.dtype))
    idx = np.cumsum(SPLIT_SIZES)[:-1].tolist()
    a_val, a_gate, a_z, b_h, b_b, b_c, b_z, c_u, c_v, c_z = jnp.split(p, idx, axis=-1)
    a = a_val * jax.nn.sigmoid(a_gate)
    a_conv, new_a_buf = causal_dwconv(a_buf, a, a_conv_w)
    a_conv = a_conv + a_conv_b.astype(a_conv.dtype)
    y_a = jax.nn.silu(layer_norm(a_conv, a_ln_g, a_ln_b)) * jax.nn.silu(a_z)
    z = b_c * b_h
    b_conv, new_b_buf = causal_dwconv(b_buf, z, b_conv_w)
    y_b = b_b * b_conv * jax.nn.silu(b_z)
    vn = layer_norm(c_v, c_ln_g, c_ln_b)
    y_c = c_u * chunk_fn(vn, c_ws, c_bs) * jax.nn.silu(c_z)
    mix = jnp.concatenate([y_a, y_b, y_c], axis=-1)
    out = jnp.einsum('nte,ed->ntd', mix, w_out.astype(mix.dtype))
    return x + out, new_a_buf, new_b_buf, vn


def setup_inputs(seed: int = 0) -> dict:
    key = jax.random.key(seed)
    ks = jax.random.split(key, 20)
    f32 = jnp.float32
    nrm = lambda k, s: jax.random.normal(k, s, f32)
    return {
        "x_prompt": nrm(ks[0], (BATCH, SEQ, D_MODEL)),
        "x_sample": nrm(ks[1], (DEC_BATCH, DEC_SEQ, D_MODEL)),
        "state_a_conv": 0.5 * nrm(ks[2], (DEPTH, DEC_BATCH, A_KERNEL - 1, W_A)),
        "state_b_conv": 0.5 * nrm(ks[3], (DEPTH, DEC_BATCH, B_KERNEL - 1, W_B)),
        "norm_g": 1.0 + 0.05 * nrm(ks[4], (DEPTH, D_MODEL)),
        "w_in": nrm(ks[5], (DEPTH, D_MODEL, IN_WIDTH)) * D_MODEL ** -0.5,
        "a_conv_w": nrm(ks[6], (DEPTH, A_KERNEL, W_A)) * A_KERNEL ** -0.5,
        "a_conv_b": 0.02 * nrm(ks[7], (DEPTH, W_A)),
        "a_ln_g": 1.0 + 0.05 * nrm(ks[8], (DEPTH, W_A)),
        "a_ln_b": 0.02 * nrm(ks[9], (DEPTH, W_A)),
        "b_conv_w": nrm(ks[10], (DEPTH, B_KERNEL, W_B)) * B_KERNEL ** -0.5,
        "c_ln_g": 1.0 + 0.05 * nrm(ks[11], (DEPTH, W_C)),
        "c_ln_b": 0.02 * nrm(ks[12], (DEPTH, W_C)),
        "c_ws": nrm(ks[13], (DEPTH, C_HEADS, CHUNK, CHUNK)) * CHUNK ** -0.5,
        "c_bs": 1.0 + 0.1 * nrm(ks[14], (DEPTH, C_HEADS, CHUNK)),
        "w_out": nrm(ks[15], (DEPTH, MIX_WIDTH, D_MODEL)) * MIX_WIDTH ** -0.5,
        "final_g": 1.0 + 0.05 * nrm(ks[16], (D_MODEL,)),
    }


def reference(x_prompt, x_sample, state_a_conv, state_b_conv, norm_g, w_in, a_conv_w, a_conv_b,
              a_ln_g, a_ln_b, b_conv_w, c_ln_g, c_ln_b, c_ws, c_bs, w_out, final_g):
    xp, xs = x_prompt, x_sample
    n_p = xp.shape[0]
    pa, pb, sa, sb, sv = [], [], [], [], []
    for l in range(DEPTH):
        lw = (norm_g[l], w_in[l], a_conv_w[l], a_conv_b[l], a_ln_g[l], a_ln_b[l], b_conv_w[l],
              c_ln_g[l], c_ln_b[l], c_ws[l], c_bs[l], w_out[l])
        a0 = jnp.zeros((n_p, A_KERNEL - 1, W_A), xp.dtype)
        b0 = jnp.zeros((n_p, B_KERNEL - 1, W_B), xp.dtype)
        xp, na, nb, _ = hybrid_layer(xp, a0, b0, chunk_mix_prompt, *lw)
        pa.append(na)
        pb.append(nb)
        xs, na, nb, vn = hybrid_layer(xs, state_a_conv[l], state_b_conv[l], chunk_mix_new_chunk, *lw)
        sa.append(na)
        sb.append(nb)
        sv.append(vn)
    y_prompt = rms_norm(xp, final_g)
    y_sample = rms_norm(xs, final_g)
    return (y_prompt, y_sample, jnp.stack(pa), jnp.stack(pb), jnp.stack(sa), jnp.stack(sb), jnp.stack(sv))
```

```cpp
#include <hip/hip_runtime.h>
#include <hip/hip_cooperative_groups.h>
#include <cstdio>
#include <cstdint>
namespace cg = cooperative_groups;

typedef unsigned short u16;
typedef short bf16x8 __attribute__((ext_vector_type(8)));
typedef float f32x16 __attribute__((ext_vector_type(16)));

constexpr int NTOK = 16896, NPR = 16384, DM = 1024, INW = 3456, IW = 2048;
constexpr int NT = 512;
constexpr int LDS_BYTES = 98304;
constexpr float EPS = 1e-6f;

constexpr size_t O_SAP = 17301504, O_SBP = 17485824, O_SAS = 17498112, O_SBS = 20447232, O_SCV = 20643840;

struct Params {
  const float *x_prompt, *x_sample, *state_a, *state_b, *norm_g, *w_in, *a_conv_w, *a_conv_b, *a_ln_g, *a_ln_b,
      *b_conv_w, *c_ln_g, *c_ln_b, *c_ws, *c_bs, *w_out, *final_g;
  float* out;
  u16 *win_b, *wout_b, *wc_b, *xb, *inter, *mix;
  float *sumsq, *x1;
};

__device__ __forceinline__ u16 f2bf(float f) {
  unsigned u = __float_as_uint(f);
  u += 0x7fffu + ((u >> 16) & 1u);
  return (u16)(u >> 16);
}
__device__ __forceinline__ float bf2f(u16 h) { return __uint_as_float(((unsigned)h) << 16); }
__device__ __forceinline__ unsigned pack2(float a, float b) { return (unsigned)f2bf(a) | ((unsigned)f2bf(b) << 16); }
__device__ __forceinline__ float sigmoidf_(float x) { return 1.f / (1.f + __expf(-x)); }
__device__ __forceinline__ float siluf_(float x) { return x / (1.f + __expf(-x)); }

__device__ __forceinline__ int otid() {
  int t = threadIdx.x;
  asm volatile("" : "+v"(t));
  return t;
}

__device__ __forceinline__ int vcol_src(int vc) {
  int j = vc >> 7, v = vc & 127;
  int wn = v >> 6, ni = (v >> 5) & 1, l32 = v & 31;
  int chp = wn * 32 + l32;
  if (j < 6) return (ni ? 384 : 0) + j * 64 + chp;
  if (j < 9) return 768 + (j - 6) * 128 + v;
  if (j < 15) return (ni ? 1920 : 1152) + (j - 9) * 64 + chp;
  if (j < 21) return (ni ? 2304 : 1536) + (j - 15) * 64 + chp;
  if (j < 25) return (ni ? 3200 : 2688) + (j - 21) * 64 + chp;
  return 2944 + (j - 25) * 128 + v;
}

__device__ void p0_transpose(const float* __restrict__ W, int ncols, const float* __restrict__ g, u16* __restrict__ outp,
                             int k0, int v0, bool mapv, float* tile) {
  int tid = otid();
#pragma unroll
  for (int i = 0; i < 8; i++) {
    int e = tid + i * NT;
    int kk = e >> 6, v = e & 63;
    int src = mapv ? vcol_src(v0 + v) : (v0 + v);
    float val = W[(size_t)(k0 + kk) * ncols + src];
    if (g) val *= g[k0 + kk];
    tile[kk * 65 + v] = val;
  }
  __syncthreads();
  {
    int v = tid >> 3, kq = tid & 7;
    const float* tp = tile + (kq * 8) * 65 + v;
    uint4 o;
    o.x = pack2(tp[0], tp[65]);
    o.y = pack2(tp[2 * 65], tp[3 * 65]);
    o.z = pack2(tp[4 * 65], tp[5 * 65]);
    o.w = pack2(tp[6 * 65], tp[7 * 65]);
    *(uint4*)(outp + (size_t)(v0 + v) * 1024 + k0 + kq * 8) = o;
  }
  __syncthreads();
}

__device__ void phase0(const Params& p, char* smem) {
  float* tile = (float*)smem;
  int nb = gridDim.x, b = blockIdx.x, tid = otid();
  for (int it = b; it < 2 * 16 * 54; it += nb) {
    int l = it / (16 * 54), rem = it % (16 * 54);
    int kb = rem / 54, vb = rem % 54;
    p0_transpose(p.w_in + (size_t)l * DM * INW, INW, p.norm_g + l * DM, p.win_b + (size_t)l * INW * DM, kb * 64, vb * 64, true, tile);
  }
  for (int it = b; it < 2 * 16 * 16; it += nb) {
    int l = it >> 8, rem = it & 255;
    int kb = rem >> 4, vb = rem & 15;
    p0_transpose(p.w_out + (size_t)l * DM * DM, DM, nullptr, p.wout_b + (size_t)l * DM * DM, kb * 64, vb * 64, false, tile);
  }
  for (int e = b * NT + tid; e < 2 * 4 * 128 * 128; e += nb * NT) {
    int s = e & 127, t = (e >> 7) & 127;
    p.wc_b[e] = (s <= t) ? f2bf(p.c_ws[e]) : (u16)0;
  }
  for (int e = b * NT + tid; e < NTOK; e += nb * NT) p.sumsq[NTOK + e] = 0.f;
  int wave = tid >> 6, lane = tid & 63;
  for (int row = b * 8 + wave; row < NTOK; row += nb * 8) {
    const float* xr = (row < NPR) ? (p.x_prompt + (size_t)row * DM) : (p.x_sample + (size_t)(row - NPR) * DM);
    float ss = 0.f;
#pragma unroll
    for (int j = 0; j < 4; j++) {
      float4 v = *(const float4*)(xr + (j * 64 + lane) * 4);
      ss += v.x * v.x + v.y * v.y + v.z * v.z + v.w * v.w;
      uint2 o;
      o.x = pack2(v.x, v.y);
      o.y = pack2(v.z, v.w);
      *(uint2*)(p.xb + (size_t)row * DM + (j * 64 + lane) * 4) = o;
    }
#pragma unroll
    for (int m = 32; m >= 1; m >>= 1) ss += __shfl_xor(ss, m);
    if (lane == 0) p.sumsq[row] = ss;
  }
}

__device__ __forceinline__ void gemm_mainloop(const u16* __restrict__ Ag, const u16* __restrict__ Bg, char* smem,
                                              f32x16 (&acc)[2][2]) {
  const int tid = otid();
  const int lane = tid & 63, w = tid >> 6;
  const int wm = w >> 1, wn = w & 1;
  const int l32 = lane & 31, lh = lane >> 5;
  const int sr = tid >> 3, sc = tid & 7;
  const int st_off = sr * 128 + ((sc ^ ((sr >> 1) & 7)) << 4);
  const u16* ag = Ag + (size_t)sr * DM + sc * 8;
  const u16* bg = Bg + (size_t)sr * DM + sc * 8;
  const int fsw = (l32 >> 1) & 7;
  const int a_off = (wm * 64 + l32) * 128;
  const int b_off = 32768 + (wn * 64 + l32) * 128;

  uint4 ra[4], rb[2];
#pragma unroll
  for (int i = 0; i < 4; i++) ra[i] = *(const uint4*)(ag + (size_t)i * 64 * DM);
#pragma unroll
  for (int i = 0; i < 2; i++) rb[i] = *(const uint4*)(bg + (size_t)i * 64 * DM);
#pragma unroll
  for (int i = 0; i < 4; i++) *(uint4*)(smem + st_off + i * 8192) = ra[i];
#pragma unroll
  for (int i = 0; i < 2; i++) *(uint4*)(smem + 32768 + st_off + i * 8192) = rb[i];
  __syncthreads();

  for (int kt = 0; kt < 16; kt++) {
    char* cur = smem + (kt & 1) * 49152;
    char* nxt = smem + ((kt + 1) & 1) * 49152;
    if (kt < 15) {
#pragma unroll
      for (int i = 0; i < 4; i++) ra[i] = *(const uint4*)(ag + (size_t)i * 64 * DM + (kt + 1) * 64);
#pragma unroll
      for (int i = 0; i < 2; i++) rb[i] = *(const uint4*)(bg + (size_t)i * 64 * DM + (kt + 1) * 64);
    }
#pragma unroll
    for (int kk = 0; kk < 4; kk++) {
      const int co = ((kk * 2 + lh) ^ fsw) << 4;
      bf16x8 a0 = *(const bf16x8*)(cur + a_off + co);
      bf16x8 a1 = *(const bf16x8*)(cur + a_off + 32 * 128 + co);
      bf16x8 b0 = *(const bf16x8*)(cur + b_off + co);
      bf16x8 b1 = *(const bf16x8*)(cur + b_off + 32 * 128 + co);
      acc[0][0] = __builtin_amdgcn_mfma_f32_32x32x16_bf16(a0, b0, acc[0][0], 0, 0, 0);
      acc[0][1] = __builtin_amdgcn_mfma_f32_32x32x16_bf16(a0, b1, acc[0][1], 0, 0, 0);
      acc[1][0] = __builtin_amdgcn_mfma_f32_32x32x16_bf16(a1, b0, acc[1][0], 0, 0, 0);
      acc[1][1] = __builtin_amdgcn_mfma_f32_32x32x16_bf16(a1, b1, acc[1][1], 0, 0, 0);
    }
    if (kt < 15) {
#pragma unroll
      for (int i = 0; i < 4; i++) *(uint4*)(nxt + st_off + i * 8192) = ra[i];
#pragma unroll
      for (int i = 0; i < 2; i++) *(uint4*)(nxt + 32768 + st_off + i * 8192) = rb[i];
    }
    __syncthreads();
  }
}

__device__ __forceinline__ bool next_tile(int& u, int ntiles, int& T) {
  int nb = gridDim.x, b = blockIdx.x;
  if ((nb & 7) == 0) {
    int per = (ntiles + 7) >> 3;
    int x = b & 7, nslots = nb >> 3;
    while (true) {
      if (u >= per) return false;
      T = x * per + u;
      u += nslots;
      if (T < ntiles) return true;
    }
  } else {
    if (u >= ntiles) return false;
    T = u;
    u += nb;
    return true;
  }
}
__device__ __forceinline__ int first_u() {
  return ((gridDim.x & 7) == 0) ? (int)(blockIdx.x >> 3) : (int)blockIdx.x;
}

__device__ void phase1(const Params& p, int l, char* smem) {
  const int tid = otid();
  const int lane = tid & 63, w = tid >> 6;
  const int wm = w >> 1, wn = w & 1;
  const int l32 = lane & 31, lh = lane >> 5;
  const float* ssq = p.sumsq + (size_t)l * NTOK;
  int u = first_u(), T;
  while (next_tile(u, 66 * 27, T)) {
    int rb = T / 27, j = T - rb * 27;
    int row0 = rb * 256;
    f32x16 acc[2][2];
#pragma unroll
    for (int a = 0; a < 2; a++)
#pragma unroll
      for (int c = 0; c < 2; c++)
#pragma unroll
        for (int r = 0; r < 16; r++) acc[a][c][r] = 0.f;
    gemm_mainloop(p.xb + (size_t)row0 * DM, p.win_b + ((size_t)l * INW + (size_t)j * 128) * DM, smem, acc);
    int kind, ob;
    if (j < 6) { kind = 0; ob = j * 64; }
    else if (j < 9) { kind = 1; ob = 384 + (j - 6) * 128; }
    else if (j < 15) { kind = 2; ob = 768 + (j - 9) * 64; }
    else if (j < 21) { kind = 3; ob = 1152 + (j - 15) * 64; }
    else if (j < 25) { kind = 3; ob = 1536 + (j - 21) * 64; }
    else { kind = 4; ob = 1792 + (j - 25) * 128; }
    const bool paired = (kind == 0 || kind == 2 || kind == 3);
    const int oc = paired ? (ob + wn * 32 + l32) : (ob + wn * 64 + l32);
#pragma unroll
    for (int mi = 0; mi < 2; mi++) {
#pragma unroll
      for (int r = 0; r < 16; r++) {
        int row = row0 + wm * 64 + mi * 32 + (r & 3) + 8 * (r >> 2) + 4 * lh;
        float rs = rsqrtf(ssq[row] * (1.f / 1024.f) + EPS);
        float v0 = acc[mi][0][r] * rs, v1 = acc[mi][1][r] * rs;
        u16* o = p.inter + (size_t)row * IW + oc;
        if (kind == 0) o[0] = f2bf(v0 * sigmoidf_(v1));
        else if (kind == 2) o[0] = f2bf(v0 * v1);
        else if (kind == 3) o[0] = f2bf(v0 * siluf_(v1));
        else if (kind == 1) { o[0] = f2bf(siluf_(v0)); o[32] = f2bf(siluf_(v1)); }
        else { o[0] = f2bf(v0); o[32] = f2bf(v1); }
      }
    }
  }
}

__device__ void phase3(const Params& p, int l, char* smem) {
  const int tid = otid();
  const int lane = tid & 63, w = tid >> 6;
  const int wm = w >> 1, wn = w & 1;
  const int l32 = lane & 31, lh = lane >> 5;
  int u = first_u(), T;
  while (next_tile(u, 66 * 8, T)) {
    int rb = T >> 3, j = T & 7;
    int row0 = rb * 256, col0 = j * 128;
    f32x16 acc[2][2];
#pragma unroll
    for (int a = 0; a < 2; a++)
#pragma unroll
      for (int c = 0; c < 2; c++)
#pragma unroll
        for (int r = 0; r < 16; r++) acc[a][c][r] = 0.f;
    gemm_mainloop(p.mix + (size_t)row0 * DM, p.wout_b + ((size_t)l * DM + col0) * DM, smem, acc);
    const int n0 = col0 + wn * 64 + l32;
#pragma unroll
    for (int mi = 0; mi < 2; mi++) {
#pragma unroll
      for (int r = 0; r < 16; r++) {
        int row = row0 + wm * 64 + mi * 32 + (r & 3) + 8 * (r >> 2) + 4 * lh;
        if (l == 0) {
          const float* xo = (row < NPR) ? (p.x_prompt + (size_t)row * DM) : (p.x_sample + (size_t)(row - NPR) * DM);
          float a0 = xo[n0] + acc[mi][0][r];
          float a1 = xo[n0 + 32] + acc[mi][1][r];
          p.x1[(size_t)row * DM + n0] = a0;
          p.x1[(size_t)row * DM + n0 + 32] = a1;
          p.xb[(size_t)row * DM + n0] = f2bf(a0);
          p.xb[(size_t)row * DM + n0 + 32] = f2bf(a1);
          float ss = a0 * a0 + a1 * a1;
#pragma unroll
          for (int m = 16; m >= 1; m >>= 1) ss += __shfl_xor(ss, m);
          if (l32 == 0) atomicAdd(p.sumsq + NTOK + row, ss);
        } else {
          const float* xo = p.x1 + (size_t)row * DM;
          p.out[(size_t)row * DM + n0] = xo[n0] + acc[mi][0][r];
          p.out[(size_t)row * DM + n0 + 32] = xo[n0 + 32] + acc[mi][1][r];
        }
      }
    }
  }
}

__device__ void p2_ab(const Params& p, int l, int it, char* smem) {
  const int tid = otid();
  const int c0 = tid & 127, q = tid >> 7;
  const int lane = tid & 63, w = tid >> 6;
  const int R0 = it * 32;
  const int spos = R0 & 2047;
  const int rowq = R0 + q * 8;
  const int bseq = R0 >> 11;
  const bool last = (spos == 2016);
  const u16* __restrict__ inter = p.inter;
  u16* atile = (u16*)smem;
  float* cbuf = (float*)(smem + 47616);
  float* red = (float*)(smem + 96768);
  for (int e = tid; e < 62 * 48; e += NT) {
    int r = e / 48, ch = e - r * 48;
    uint4 v = make_uint4(0, 0, 0, 0);
    if (spos - 30 + r >= 0) v = *(const uint4*)(inter + (size_t)(R0 - 30 + r) * IW + ch * 8);
    *(uint4*)(atile + r * 384 + ch * 8) = v;
  }
  __syncthreads();
  float s1[8], s2[8];
#pragma unroll
  for (int t = 0; t < 8; t++) { s1[t] = 0.f; s2[t] = 0.f; }
#pragma unroll 1
  for (int jc = 0; jc < 3; jc++) {
    const int c = c0 + 128 * jc;
    float wv[31];
#pragma unroll
    for (int j = 0; j < 31; j++) wv[j] = p.a_conv_w[(l * 31 + j) * 384 + c];
    const float bias = p.a_conv_b[l * 384 + c];
    float o[8];
#pragma unroll
    for (int t = 0; t < 8; t++) o[t] = bias;
    const u16* ap = atile + (q * 8) * 384 + c;
#pragma unroll
    for (int s = 0; s < 38; s++) {
      float v = bf2f(ap[s * 384]);
#pragma unroll
      for (int t = 0; t < 8; t++) {
        const int j = s - t;
        if (j >= 0 && j <= 30) o[t] += wv[j] * v;
      }
      if (s >= 30) {
        int pp = spos + q * 8 + (s - 30);
        if (last && pp >= 2018) p.out[O_SAP + ((size_t)(l * 8 + bseq) * 30 + (pp - 2018)) * 384 + c] = v;
      }
    }
#pragma unroll
    for (int t = 0; t < 8; t++) { cbuf[(jc * 8 + t) * NT + tid] = o[t]; s1[t] += o[t]; s2[t] += o[t] * o[t]; }
  }
#pragma unroll
  for (int t = 0; t < 8; t++) {
#pragma unroll
    for (int m = 32; m >= 1; m >>= 1) { s1[t] += __shfl_xor(s1[t], m); s2[t] += __shfl_xor(s2[t], m); }
  }
  if (lane == 0) {
#pragma unroll
    for (int t = 0; t < 8; t++) { red[w * 16 + t] = s1[t]; red[w * 16 + 8 + t] = s2[t]; }
  }
  __syncthreads();
  float mu[8], rstd[8];
#pragma unroll
  for (int t = 0; t < 8; t++) {
    float S1 = red[(2 * q) * 16 + t] + red[(2 * q + 1) * 16 + t];
    float S2 = red[(2 * q) * 16 + 8 + t] + red[(2 * q + 1) * 16 + 8 + t];
    float m_ = S1 * (1.f / 384.f);
    float var = S2 * (1.f / 384.f) - m_ * m_;
    mu[t] = m_;
    rstd[t] = rsqrtf(fmaxf(var, 0.f) + EPS);
  }
#pragma unroll 1
  for (int jc = 0; jc < 3; jc++) {
    const int c = c0 + 128 * jc;
    const float g = p.a_ln_g[l * 384 + c], bb = p.a_ln_b[l * 384 + c];
    const u16* ip = inter + (size_t)rowq * IW + c;
    u16* mp = p.mix + (size_t)rowq * DM + c;
#pragma unroll
    for (int t = 0; t < 8; t++) {
      float y = (cbuf[(jc * 8 + t) * NT + tid] - mu[t]) * rstd[t] * g + bb;
      float ya = siluf_(y) * bf2f(ip[(size_t)t * IW + 384]);
      mp[t * DM] = f2bf(ya);
    }
    const float w0 = p.b_conv_w[(l * 3 + 0) * 384 + c], w1 = p.b_conv_w[(l * 3 + 1) * 384 + c], w2 = p.b_conv_w[(l * 3 + 2) * 384 + c];
    float z[10];
#pragma unroll
    for (int s = 0; s < 10; s++) {
      int pp = spos + q * 8 - 2 + s;
      z[s] = 0.f;
      if (pp >= 0) z[s] = bf2f(inter[(size_t)(rowq - 2 + s) * IW + 768 + c]);
    }
#pragma unroll
    for (int t = 0; t < 8; t++) {
      float cv = w0 * z[t] + w1 * z[t + 1] + w2 * z[t + 2];
      float yb = bf2f(ip[(size_t)t * IW + 1152]) * cv;
      mp[t * DM + 384] = f2bf(yb);
    }
    if (last && q == 3) {
      p.out[O_SBP + ((size_t)(l * 8 + bseq) * 2 + 0) * 384 + c] = z[8];
      p.out[O_SBP + ((size_t)(l * 8 + bseq) * 2 + 1) * 384 + c] = z[9];
    }
  }
  __syncthreads();
}

__device__ void p2_c(const Params& p, int l, int ci, char* smem) {
  const int tid = otid();
  const int lane = tid & 63, w = tid >> 6;
  const int l32 = lane & 31, lh = lane >> 5;
  const int R0 = ci * 128;
  const u16* __restrict__ inter = p.inter;
  float* stats = (float*)(smem + 65536);
  {
    int tok = tid >> 2, qd = tid & 3;
    const u16* src = inter + (size_t)(R0 + tok) * IW + 1792 + qd * 64;
    float s1 = 0.f, s2 = 0.f;
#pragma unroll
    for (int i = 0; i < 8; i++) {
      uint4 v = *(const uint4*)(src + i * 8);
      unsigned uu[4] = {v.x, v.y, v.z, v.w};
#pragma unroll
      for (int k = 0; k < 4; k++) {
        float a = __uint_as_float(uu[k] << 16), bq = __uint_as_float(uu[k] & 0xffff0000u);
        s1 += a + bq;
        s2 += a * a + bq * bq;
      }
    }
    s1 += __shfl_xor(s1, 1); s2 += __shfl_xor(s2, 1);
    s1 += __shfl_xor(s1, 2); s2 += __shfl_xor(s2, 2);
    if (qd == 0) {
      float m_ = s1 * (1.f / 256.f);
      float var = s2 * (1.f / 256.f) - m_ * m_;
      stats[tok * 2] = m_;
      stats[tok * 2 + 1] = rsqrtf(fmaxf(var, 0.f) + EPS);
    }
  }
  __syncthreads();
  {
    int c = tid & 255, th = tid >> 8;
    const float g = p.c_ln_g[l * 256 + c], bb = p.c_ln_b[l * 256 + c];
#pragma unroll
    for (int g8 = 0; g8 < 8; g8++) {
      int t0 = th * 64 + g8 * 8;
      float vn[8];
#pragma unroll
      for (int i = 0; i < 8; i++) {
        float x = bf2f(inter[(size_t)(R0 + t0 + i) * IW + 1792 + c]);
        vn[i] = (x - stats[(t0 + i) * 2]) * stats[(t0 + i) * 2 + 1] * g + bb;
      }
      uint4 o;
      o.x = pack2(vn[0], vn[1]); o.y = pack2(vn[2], vn[3]); o.z = pack2(vn[4], vn[5]); o.w = pack2(vn[6], vn[7]);
      *(uint4*)(smem + c * 256 + ((((t0 >> 3)) ^ (c & 15)) << 4)) = o;
    }
  }
  __syncthreads();
  {
    const int h = w >> 1;
    const int c = h * 64 + (w & 1) * 32 + l32;
    f32x16 acc[4];
#pragma unroll
    for (int ti = 0; ti < 4; ti++)
#pragma unroll
      for (int r = 0; r < 16; r++) acc[ti][r] = 0.f;
    const u16* wb = p.wc_b + ((size_t)(l * 4 + h) * 128 + l32) * 128 + lh * 8;
#pragma unroll
    for (int ks = 0; ks < 8; ks++) {
      bf16x8 bfrag = *(const bf16x8*)(smem + c * 256 + (((ks * 2 + lh) ^ (c & 15)) << 4));
#pragma unroll
      for (int ti = 0; ti < 4; ti++) {
        if (ti >= (ks >> 1)) {
          bf16x8 afrag = *(const bf16x8*)(wb + (size_t)ti * 32 * 128 + ks * 16);
          acc[ti] = __builtin_amdgcn_mfma_f32_32x32x16_bf16(afrag, bfrag, acc[ti], 0, 0, 0);
        }
      }
    }
#pragma unroll
    for (int ti = 0; ti < 4; ti++) {
#pragma unroll
      for (int r = 0; r < 16; r++) {
        int t = ti * 32 + (r & 3) + 8 * (r >> 2) + 4 * lh;
        size_t row = R0 + t;
        float val = acc[ti][r] + p.c_bs[(l * 4 + h) * 128 + t];
        float yc = bf2f(inter[row * IW + 1536 + c]) * val;
        p.mix[row * DM + 768 + c] = f2bf(yc);
      }
    }
  }
  __syncthreads();
}

__device__ void p2_s(const Params& p, int l, int n, float* red, float* smem_f) {
  const int tid = otid();
  const int lane = tid & 63, w = tid >> 6;
  const int c = tid;
  const size_t Rs = NPR + (size_t)n * 4;
  const u16* __restrict__ inter = p.inter;
  float rv[16];
#pragma unroll
  for (int i = 0; i < 16; i++) rv[i] = 0.f;
  float o[4] = {0.f, 0.f, 0.f, 0.f};
  float zin[6] = {0.f, 0.f, 0.f, 0.f, 0.f, 0.f};
  float cvv[4] = {0.f, 0.f, 0.f, 0.f};
  if (c < 384) {
    float* inl = (float*)smem_f + tid;
    const float* sa = p.state_a + ((size_t)(l * 128 + n) * 30) * 384 + c;
    float* so = p.out + O_SAS + ((size_t)(l * 128 + n) * 30) * 384 + c;
#pragma unroll 2
    for (int i = 0; i < 30; i++) {
      float v = sa[i * 384];
      inl[i * NT] = v;
      if (i >= 4) so[(i - 4) * 384] = v;
    }
#pragma unroll
    for (int t = 0; t < 4; t++) {
      float v = bf2f(inter[(Rs + t) * IW + c]);
      inl[(30 + t) * NT] = v;
      so[(26 + t) * 384] = v;
    }
    const float bias = p.a_conv_b[l * 384 + c];
#pragma unroll
    for (int t = 0; t < 4; t++) o[t] = bias;
    float i0 = inl[0], i1 = inl[NT], i2 = inl[2 * NT];
#pragma unroll 1
    for (int j = 0; j < 31; j++) {
      float wj = p.a_conv_w[(l * 31 + j) * 384 + c];
      float i3 = inl[(j + 3) * NT];
      o[0] += wj * i0; o[1] += wj * i1; o[2] += wj * i2; o[3] += wj * i3;
      i0 = i1; i1 = i2; i2 = i3;
    }
#pragma unroll
    for (int t = 0; t < 4; t++) { rv[t] = o[t]; rv[4 + t] = o[t] * o[t]; }
    const float* sb = p.state_b + ((size_t)(l * 128 + n) * 2) * 384 + c;
    zin[0] = sb[0]; zin[1] = sb[384];
#pragma unroll
    for (int t = 0; t < 4; t++) zin[2 + t] = bf2f(inter[(Rs + t) * IW + 768 + c]);
  }
  if (c < 256) {
#pragma unroll
    for (int t = 0; t < 4; t++) {
      cvv[t] = bf2f(inter[(Rs + t) * IW + 1792 + c]);
      rv[8 + t] = cvv[t];
      rv[12 + t] = cvv[t] * cvv[t];
    }
  }
#pragma unroll
  for (int i = 0; i < 16; i++) {
#pragma unroll
    for (int m = 32; m >= 1; m >>= 1) rv[i] += __shfl_xor(rv[i], m);
  }
  if (lane == 0) {
#pragma unroll
    for (int i = 0; i < 16; i++) red[w * 16 + i] = rv[i];
  }
  __syncthreads();
#pragma unroll
  for (int i = 0; i < 16; i++) {
    float s = 0.f;
#pragma unroll
    for (int ww = 0; ww < 8; ww++) s += red[ww * 16 + i];
    rv[i] = s;
  }
  if (c < 384) {
    const float g = p.a_ln_g[l * 384 + c], bb = p.a_ln_b[l * 384 + c];
    const float w0 = p.b_conv_w[(l * 3 + 0) * 384 + c], w1 = p.b_conv_w[(l * 3 + 1) * 384 + c], w2 = p.b_conv_w[(l * 3 + 2) * 384 + c];
#pragma unroll
    for (int t = 0; t < 4; t++) {
      float m_ = rv[t] * (1.f / 384.f);
      float var = rv[4 + t] * (1.f / 384.f) - m_ * m_;
      float rstd = rsqrtf(fmaxf(var, 0.f) + EPS);
      float y = (o[t] - m_) * rstd * g + bb;
      float ya = siluf_(y) * bf2f(inter[(Rs + t) * IW + 384 + c]);
      p.mix[(Rs + t) * DM + c] = f2bf(ya);
      float cv = w0 * zin[t] + w1 * zin[t + 1] + w2 * zin[t + 2];
      float yb = bf2f(inter[(Rs + t) * IW + 1152 + c]) * cv;
      p.mix[(Rs + t) * DM + 384 + c] = f2bf(yb);
    }
    p.out[O_SBS + ((size_t)(l * 128 + n) * 2 + 0) * 384 + c] = zin[4];
    p.out[O_SBS + ((size_t)(l * 128 + n) * 2 + 1) * 384 + c] = zin[5];
  }
  if (c < 256) {
    const float g = p.c_ln_g[l * 256 + c], bb = p.c_ln_b[l * 256 + c];
    const int h = c >> 6;
    float vn[4];
#pragma unroll
    for (int t = 0; t < 4; t++) {
      float m_ = rv[8 + t] * (1.f / 256.f);
      float var = rv[12 + t] * (1.f / 256.f) - m_ * m_;
      float rstd = rsqrtf(fmaxf(var, 0.f) + EPS);
      vn[t] = (cvv[t] - m_) * rstd * g + bb;
      p.out[O_SCV + ((size_t)(l * 128 + n) * 4 + t) * 256 + c] = vn[t];
    }
#pragma unroll
    for (int t = 0; t < 4; t++) {
      float acc = p.c_bs[(l * 4 + h) * 128 + t];
#pragma unroll
      for (int s = 0; s < 4; s++)
        if (s <= t) acc += p.c_ws[((size_t)(l * 4 + h) * 128 + t) * 128 + s] * vn[s];
      float yc = bf2f(inter[(Rs + t) * IW + 1536 + c]) * acc;
      p.mix[(Rs + t) * DM + 768 + c] = f2bf(yc);
    }
  }
  __syncthreads();
}

__device__ void phase2(const Params& p, int l, char* smem) {
  float* red = (float*)(smem + 90112);
  const int nb = gridDim.x, b = blockIdx.x;
  for (int it = b; it < 512; it += nb) {
    asm volatile("" ::: "memory");
    p2_ab(p, l, it, smem);
  }
  for (int it = b; it < 128; it += nb) {
    asm volatile("" ::: "memory");
    p2_c(p, l, it, smem);
  }
  for (int it = (b + nb - (128 % nb)) % nb; it < 128; it += nb) {
    asm volatile("" ::: "memory");
    p2_s(p, l, it, red, (float*)smem);
  }
}

__device__ void phase4(const Params& p) {
  const int tid = otid(), wave = tid >> 6, lane = tid & 63;
  for (int row = blockIdx.x * 8 + wave; row < NTOK; row += gridDim.x * 8) {
    float* xr = p.out + (size_t)row * DM;
    float4 v[4];
    float ss = 0.f;
#pragma unroll
    for (int j = 0; j < 4; j++) {
      v[j] = *(const float4*)(xr + (j * 64 + lane) * 4);
      ss += v[j].x * v[j].x + v[j].y * v[j].y + v[j].z * v[j].z + v[j].w * v[j].w;
    }
#pragma unroll
    for (int m = 32; m >= 1; m >>= 1) ss += __shfl_xor(ss, m);
    float rs = rsqrtf(ss * (1.f / 1024.f) + EPS);
#pragma unroll
    for (int j = 0; j < 4; j++) {
      float4 g = *(const float4*)(p.final_g + (j * 64 + lane) * 4);
      float4 o;
      o.x = v[j].x * rs * g.x; o.y = v[j].y * rs * g.y; o.z = v[j].z * rs * g.z; o.w = v[j].w * rs * g.w;
      *(float4*)(xr + (j * 64 + lane) * 4) = o;
    }
  }
}

__global__ void __launch_bounds__(NT) fwd_megakernel(Params p) {
  extern __shared__ __attribute__((aligned(16))) char smem[];
  cg::grid_group grid = cg::this_grid();
  phase0(p, smem);
  grid.sync();
#pragma unroll 1
  for (int l = 0; l < 2; l++) {
    phase1(p, l, smem);
    grid.sync();
    phase2(p, l, smem);
    grid.sync();
    phase3(p, l, smem);
    grid.sync();
  }
  phase4(p);
}

extern "C" void kernel_launch(void* const* d_in, const int* in_sizes, int n_in, void* d_out, int out_size, void* d_ws,
                              size_t ws_size, hipStream_t stream) {
  static int grid_blocks = 0;
  if (!grid_blocks) {
    int dev = 0, cus = 0, per_cu = 0;
    hipGetDevice(&dev);
    hipDeviceGetAttribute(&cus, hipDeviceAttributeMultiprocessorCount, dev);
    hipFuncSetAttribute((const void*)fwd_megakernel, hipFuncAttributeMaxDynamicSharedMemorySize, LDS_BYTES);
    hipOccupancyMaxActiveBlocksPerMultiprocessor(&per_cu, (const void*)fwd_megakernel, NT, LDS_BYTES);
    if (per_cu < 1) { fprintf(stderr, "occupancy query returned %d\n", per_cu); per_cu = 1; }
    if (per_cu > 1) per_cu = 1;
    grid_blocks = cus * per_cu;
  }
  Params p{};
  p.x_prompt = (const float*)d_in[0];
  p.x_sample = (const float*)d_in[1];
  p.state_a = (const float*)d_in[2];
  p.state_b = (const float*)d_in[3];
  p.norm_g = (const float*)d_in[4];
  p.w_in = (const float*)d_in[5];
  p.a_conv_w = (const float*)d_in[6];
  p.a_conv_b = (const float*)d_in[7];
  p.a_ln_g = (const float*)d_in[8];
  p.a_ln_b = (const float*)d_in[9];
  p.b_conv_w = (const float*)d_in[10];
  p.c_ln_g = (const float*)d_in[11];
  p.c_ln_b = (const float*)d_in[12];
  p.c_ws = (const float*)d_in[13];
  p.c_bs = (const float*)d_in[14];
  p.w_out = (const float*)d_in[15];
  p.final_g = (const float*)d_in[16];
  p.out = (float*)d_out;
  char* ws = (char*)d_ws;
  size_t off = 0;
  auto take = [&](size_t bytes) { char* r = ws + off; off += (bytes + 255) & ~(size_t)255; return r; };
  p.win_b = (u16*)take((size_t)2 * INW * DM * 2);
  p.wout_b = (u16*)take((size_t)2 * DM * DM * 2);
  p.wc_b = (u16*)take((size_t)2 * 4 * 128 * 128 * 2);
  p.xb = (u16*)take((size_t)NTOK * DM * 2);
  p.inter = (u16*)take((size_t)NTOK * IW * 2);
  p.mix = (u16*)take((size_t)NTOK * DM * 2);
  p.sumsq = (float*)take((size_t)2 * NTOK * 4);
  p.x1 = (float*)take((size_t)NTOK * DM * 4);
  void* args[] = {&p};
  hipError_t e = hipLaunchCooperativeKernel((const void*)fwd_megakernel, dim3(grid_blocks), dim3(NT), args, LDS_BYTES, stream);
  if (e != hipSuccess) fprintf(stderr, "cooperative launch failed: %s (grid %d)\n", hipGetErrorString(e), grid_blocks);
}
```

```cpp
#include <hip/hip_runtime.h>
#include <cstdio>
#include <cstdint>

typedef unsigned short u16;
typedef short bf16x8 __attribute__((ext_vector_type(8)));
typedef float f32x16 __attribute__((ext_vector_type(16)));

constexpr int NTOK = 16896, NPR = 16384, DM = 1024, INW = 3456, IW = 2048;
constexpr int NT = 512;
constexpr int LDS_BYTES = 98304;
constexpr float EPS = 1e-6f;

constexpr size_t O_SAP = 17301504, O_SBP = 17485824, O_SAS = 17498112, O_SBS = 20447232, O_SCV = 20643840;

struct Params {
  const float *x_prompt, *x_sample, *state_a, *state_b, *norm_g, *w_in, *a_conv_w, *a_conv_b, *a_ln_g, *a_ln_b,
      *b_conv_w, *c_ln_g, *c_ln_b, *c_ws, *c_bs, *w_out, *final_g;
  float* out;
  u16 *win_b, *wout_b, *wc_b, *xb, *inter, *mix;
  float *sumsq, *x1;
  unsigned* bar;
};

__device__ __forceinline__ u16 f2bf(float f) {
  unsigned u = __float_as_uint(f);
  u += 0x7fffu + ((u >> 16) & 1u);
  return (u16)(u >> 16);
}
__device__ __forceinline__ float bf2f(u16 h) { return __uint_as_float(((unsigned)h) << 16); }
__device__ __forceinline__ unsigned pack2(float a, float b) { return (unsigned)f2bf(a) | ((unsigned)f2bf(b) << 16); }
__device__ __forceinline__ float sigmoidf_(float x) { return 1.f / (1.f + __expf(-x)); }
__device__ __forceinline__ float siluf_(float x) { return x / (1.f + __expf(-x)); }

__device__ __forceinline__ int otid() {
  int t = threadIdx.x;
  asm volatile("" : "+v"(t));
  return t;
}

__device__ __forceinline__ int vcol_src(int vc) {
  int j = vc >> 7, v = vc & 127;
  int wn = v >> 6, ni = (v >> 5) & 1, l32 = v & 31;
  int chp = wn * 32 + l32;
  if (j < 6) return (ni ? 384 : 0) + j * 64 + chp;
  if (j < 9) return 768 + (j - 6) * 128 + v;
  if (j < 15) return (ni ? 1920 : 1152) + (j - 9) * 64 + chp;
  if (j < 21) return (ni ? 2304 : 1536) + (j - 15) * 64 + chp;
  if (j < 25) return (ni ? 3200 : 2688) + (j - 21) * 64 + chp;
  return 2944 + (j - 25) * 128 + v;
}


#define XB_TMO      128
#define XB_XCNT(j)  (256  + 64 * (j))
#define XB_XSUB(j)  (1280 + 64 * (j))
#define XB_XGEN(j)  (2304 + 64 * (j))
#define XB_TOP      3328
#define XB_TOPGEN   3392
#define XCD_BAR_WORDS 3456
#define XB_SPIN_CAP (1u << 18)
#define LAS __attribute__((address_space(3)))

__device__ __forceinline__ unsigned xb_ld(unsigned* p)              { return __hip_atomic_load(p, __ATOMIC_RELAXED, __HIP_MEMORY_SCOPE_AGENT); }
__device__ __forceinline__ unsigned xb_add(unsigned* p, unsigned v) { return __hip_atomic_fetch_add(p, v, __ATOMIC_RELAXED, __HIP_MEMORY_SCOPE_AGENT); }
__device__ __forceinline__ unsigned xb_xcc_id() { return (unsigned)__builtin_amdgcn_s_getreg((3 << 11) | 20) & 0xFu; }
#define XB_SPIN(cond, bar) do { unsigned _sp = 0; while (cond) { __builtin_amdgcn_s_sleep(1); \
    if ((++_sp & 255u) == 0u) { if (xb_ld(&(bar)[XB_TMO])) break; if (_sp > XB_SPIN_CAP) { atomicAdd(&(bar)[XB_TMO], 1u); break; } } } } while (0)

struct XcdBarrier {
  unsigned* bar; unsigned x;
  volatile LAS unsigned* st;
};
__device__ __forceinline__ XcdBarrier xcd_barrier_post(unsigned* bar, volatile LAS unsigned* st) {
  XcdBarrier b; b.bar = bar; b.x = xb_xcc_id(); b.st = st;
  if (threadIdx.x == 0) (void)xb_add(&bar[XB_XCNT(b.x)], 1u);
  return b;
}
__device__ __forceinline__ void xcd_barrier_complete(unsigned* bar, unsigned x, unsigned& nloc, unsigned& nx) {
  const unsigned G = gridDim.x * gridDim.y * gridDim.z;
  unsigned sum, cnt, mine, sp = 0u;
  for (;;) {
    sum = 0u; cnt = 0u; mine = 0u;
#pragma unroll
    for (unsigned j = 0; j < 16; ++j) { const unsigned c = xb_ld(&bar[XB_XCNT(j)]); sum += c; cnt += (c > 0u) ? 1u : 0u; mine = (j == x) ? c : mine; }
    if (sum == G) break;
    __builtin_amdgcn_s_sleep(1);
    if ((++sp & 255u) == 0u) { if (xb_ld(&bar[XB_TMO])) break; if (sp > XB_SPIN_CAP) { atomicAdd(&bar[XB_TMO], 1u); break; } }
  }
  nloc = mine > 0u ? mine : 1u; nx = cnt > 0u ? cnt : 1u;
}
__device__ __forceinline__ void xcd_barrier(const XcdBarrier& b) {
  asm volatile("s_waitcnt vmcnt(0)" ::: "memory");
  __syncthreads();
  if (threadIdx.x == 0) {
    unsigned* bar = b.bar;
    __builtin_amdgcn_s_waitcnt(0);
    unsigned nloc = b.st[0], nx = b.st[1];
    if (nloc == 0u) { xcd_barrier_complete(bar, b.x, nloc, nx); b.st[0] = nloc; b.st[1] = nx; }
    const unsigned old = xb_add(&bar[XB_XSUB(b.x)], 1u);
    const unsigned gen = old / nloc;
    if (old + 1u == (gen + 1u) * nloc) {
      __builtin_amdgcn_fence(__ATOMIC_RELEASE, "agent");
      asm volatile("s_waitcnt vmcnt(0)" ::: "memory");
      const unsigned og = xb_add(&bar[XB_TOP], 1u);
      const unsigned tg = og / nx;
      if (og + 1u == (tg + 1u) * nx) xb_add(&bar[XB_TOPGEN], 1u);
      else XB_SPIN(xb_ld(&bar[XB_TOPGEN]) == tg, bar);
      __builtin_amdgcn_fence(__ATOMIC_ACQUIRE, "agent");
      xb_add(&bar[XB_XGEN(b.x)], 1u);
      asm volatile("s_waitcnt vmcnt(0)" ::: "memory");
    } else {
      XB_SPIN(xb_ld(&bar[XB_XGEN(b.x)]) == gen, bar);
      __builtin_amdgcn_fence(__ATOMIC_ACQUIRE, "agent");
      asm volatile("s_waitcnt vmcnt(0)" ::: "memory");
    }
  }
  __syncthreads();
}

__device__ void p0_transpose(const float* __restrict__ W, int ncols, const float* __restrict__ g, u16* __restrict__ outp,
                             int k0, int v0, bool mapv, float* tile) {
  int tid = otid();
#pragma unroll
  for (int i = 0; i < 8; i++) {
    int e = tid + i * NT;
    int kk = e >> 6, v = e & 63;
    int src = mapv ? vcol_src(v0 + v) : (v0 + v);
    float val = W[(size_t)(k0 + kk) * ncols + src];
    if (g) val *= g[k0 + kk];
    tile[kk * 65 + v] = val;
  }
  __syncthreads();
  {
    int v = tid >> 3, kq = tid & 7;
    const float* tp = tile + (kq * 8) * 65 + v;
    uint4 o;
    o.x = pack2(tp[0], tp[65]);
    o.y = pack2(tp[2 * 65], tp[3 * 65]);
    o.z = pack2(tp[4 * 65], tp[5 * 65]);
    o.w = pack2(tp[6 * 65], tp[7 * 65]);
    *(uint4*)(outp + (size_t)(v0 + v) * 1024 + k0 + kq * 8) = o;
  }
  __syncthreads();
}

__device__ void phase0(const Params& p, char* smem) {
  float* tile = (float*)smem;
  int nb = gridDim.x, b = blockIdx.x, tid = otid();
  for (int it = b; it < 2 * 16 * 54; it += nb) {
    int l = it / (16 * 54), rem = it % (16 * 54);
    int kb = rem / 54, vb = rem % 54;
    p0_transpose(p.w_in + (size_t)l * DM * INW, INW, p.norm_g + l * DM, p.win_b + (size_t)l * INW * DM, kb * 64, vb * 64, true, tile);
  }
  for (int it = b; it < 2 * 16 * 16; it += nb) {
    int l = it >> 8, rem = it & 255;
    int kb = rem >> 4, vb = rem & 15;
    p0_transpose(p.w_out + (size_t)l * DM * DM, DM, nullptr, p.wout_b + (size_t)l * DM * DM, kb * 64, vb * 64, false, tile);
  }
  for (int e = b * NT + tid; e < 2 * 4 * 128 * 128; e += nb * NT) {
    int s = e & 127, t = (e >> 7) & 127;
    p.wc_b[e] = (s <= t) ? f2bf(p.c_ws[e]) : (u16)0;
  }
  for (int e = b * NT + tid; e < NTOK; e += nb * NT) p.sumsq[NTOK + e] = 0.f;
  int wave = tid >> 6, lane = tid & 63;
  for (int row = b * 8 + wave; row < NTOK; row += nb * 8) {
    const float* xr = (row < NPR) ? (p.x_prompt + (size_t)row * DM) : (p.x_sample + (size_t)(row - NPR) * DM);
    float ss = 0.f;
#pragma unroll
    for (int j = 0; j < 4; j++) {
      float4 v = *(const float4*)(xr + (j * 64 + lane) * 4);
      ss += v.x * v.x + v.y * v.y + v.z * v.z + v.w * v.w;
      uint2 o;
      o.x = pack2(v.x, v.y);
      o.y = pack2(v.z, v.w);
      *(uint2*)(p.xb + (size_t)row * DM + (j * 64 + lane) * 4) = o;
    }
#pragma unroll
    for (int m = 32; m >= 1; m >>= 1) ss += __shfl_xor(ss, m);
    if (lane == 0) p.sumsq[row] = ss;
  }
}

__device__ __forceinline__ void gemm_mainloop(const u16* __restrict__ Ag, const u16* __restrict__ Bg, char* smem,
                                              f32x16 (&acc)[2][2]) {
  const int tid = otid();
  const int lane = tid & 63, w = tid >> 6;
  const int wm = w >> 1, wn = w & 1;
  const int l32 = lane & 31, lh = lane >> 5;
  const int sr = tid >> 3, sc = tid & 7;
  const int st_off = sr * 128 + ((sc ^ ((sr >> 1) & 7)) << 4);
  const u16* ag = Ag + (size_t)sr * DM + sc * 8;
  const u16* bg = Bg + (size_t)sr * DM + sc * 8;
  const int fsw = (l32 >> 1) & 7;
  const int a_off = (wm * 64 + l32) * 128;
  const int b_off = 32768 + (wn * 64 + l32) * 128;

  uint4 ra[4], rb[2];
#pragma unroll
  for (int i = 0; i < 4; i++) ra[i] = *(const uint4*)(ag + (size_t)i * 64 * DM);
#pragma unroll
  for (int i = 0; i < 2; i++) rb[i] = *(const uint4*)(bg + (size_t)i * 64 * DM);
#pragma unroll
  for (int i = 0; i < 4; i++) *(uint4*)(smem + st_off + i * 8192) = ra[i];
#pragma unroll
  for (int i = 0; i < 2; i++) *(uint4*)(smem + 32768 + st_off + i * 8192) = rb[i];
  __syncthreads();

  for (int kt = 0; kt < 16; kt++) {
    char* cur = smem + (kt & 1) * 49152;
    char* nxt = smem + ((kt + 1) & 1) * 49152;
    if (kt < 15) {
#pragma unroll
      for (int i = 0; i < 4; i++) ra[i] = *(const uint4*)(ag + (size_t)i * 64 * DM + (kt + 1) * 64);
#pragma unroll
      for (int i = 0; i < 2; i++) rb[i] = *(const uint4*)(bg + (size_t)i * 64 * DM + (kt + 1) * 64);
    }
#pragma unroll
    for (int kk = 0; kk < 4; kk++) {
      const int co = ((kk * 2 + lh) ^ fsw) << 4;
      bf16x8 a0 = *(const bf16x8*)(cur + a_off + co);
      bf16x8 a1 = *(const bf16x8*)(cur + a_off + 32 * 128 + co);
      bf16x8 b0 = *(const bf16x8*)(cur + b_off + co);
      bf16x8 b1 = *(const bf16x8*)(cur + b_off + 32 * 128 + co);
      acc[0][0] = __builtin_amdgcn_mfma_f32_32x32x16_bf16(a0, b0, acc[0][0], 0, 0, 0);
      acc[0][1] = __builtin_amdgcn_mfma_f32_32x32x16_bf16(a0, b1, acc[0][1], 0, 0, 0);
      acc[1][0] = __builtin_amdgcn_mfma_f32_32x32x16_bf16(a1, b0, acc[1][0], 0, 0, 0);
      acc[1][1] = __builtin_amdgcn_mfma_f32_32x32x16_bf16(a1, b1, acc[1][1], 0, 0, 0);
    }
    if (kt < 15) {
#pragma unroll
      for (int i = 0; i < 4; i++) *(uint4*)(nxt + st_off + i * 8192) = ra[i];
#pragma unroll
      for (int i = 0; i < 2; i++) *(uint4*)(nxt + 32768 + st_off + i * 8192) = rb[i];
    }
    __syncthreads();
  }
}

__device__ __forceinline__ bool next_tile(int& u, int ntiles, int& T) {
  int nb = gridDim.x, b = blockIdx.x;
  if ((nb & 7) == 0) {
    int per = (ntiles + 7) >> 3;
    int x = b & 7, nslots = nb >> 3;
    while (true) {
      if (u >= per) return false;
      T = x * per + u;
      u += nslots;
      if (T < ntiles) return true;
    }
  } else {
    if (u >= ntiles) return false;
    T = u;
    u += nb;
    return true;
  }
}
__device__ __forceinline__ int first_u() {
  return ((gridDim.x & 7) == 0) ? (int)(blockIdx.x >> 3) : (int)blockIdx.x;
}

__device__ void phase1(const Params& p, int l, char* smem) {
  const int tid = otid();
  const int lane = tid & 63, w = tid >> 6;
  const int wm = w >> 1, wn = w & 1;
  const int l32 = lane & 31, lh = lane >> 5;
  const float* ssq = p.sumsq + (size_t)l * NTOK;
  int u = first_u(), T;
  while (next_tile(u, 66 * 27, T)) {
    int rb = T / 27, j = T - rb * 27;
    int row0 = rb * 256;
    f32x16 acc[2][2];
#pragma unroll
    for (int a = 0; a < 2; a++)
#pragma unroll
      for (int c = 0; c < 2; c++)
#pragma unroll
        for (int r = 0; r < 16; r++) acc[a][c][r] = 0.f;
    gemm_mainloop(p.xb + (size_t)row0 * DM, p.win_b + ((size_t)l * INW + (size_t)j * 128) * DM, smem, acc);
    int kind, ob;
    if (j < 6) { kind = 0; ob = j * 64; }
    else if (j < 9) { kind = 1; ob = 384 + (j - 6) * 128; }
    else if (j < 15) { kind = 2; ob = 768 + (j - 9) * 64; }
    else if (j < 21) { kind = 3; ob = 1152 + (j - 15) * 64; }
    else if (j < 25) { kind = 3; ob = 1536 + (j - 21) * 64; }
    else { kind = 4; ob = 1792 + (j - 25) * 128; }
    const bool paired = (kind == 0 || kind == 2 || kind == 3);
    const int oc = paired ? (ob + wn * 32 + l32) : (ob + wn * 64 + l32);
#pragma unroll
    for (int mi = 0; mi < 2; mi++) {
#pragma unroll
      for (int r = 0; r < 16; r++) {
        int row = row0 + wm * 64 + mi * 32 + (r & 3) + 8 * (r >> 2) + 4 * lh;
        float rs = rsqrtf(ssq[row] * (1.f / 1024.f) + EPS);
        float v0 = acc[mi][0][r] * rs, v1 = acc[mi][1][r] * rs;
        u16* o = p.inter + (size_t)row * IW + oc;
        if (kind == 0) o[0] = f2bf(v0 * sigmoidf_(v1));
        else if (kind == 2) o[0] = f2bf(v0 * v1);
        else if (kind == 3) o[0] = f2bf(v0 * siluf_(v1));
        else if (kind == 1) { o[0] = f2bf(siluf_(v0)); o[32] = f2bf(siluf_(v1)); }
        else { o[0] = f2bf(v0); o[32] = f2bf(v1); }
      }
    }
  }
}

__device__ void phase3(const Params& p, int l, char* smem) {
  const int tid = otid();
  const int lane = tid & 63, w = tid >> 6;
  const int wm = w >> 1, wn = w & 1;
  const int l32 = lane & 31, lh = lane >> 5;
  int u = first_u(), T;
  while (next_tile(u, 66 * 8, T)) {
    int rb = T >> 3, j = T & 7;
    int row0 = rb * 256, col0 = j * 128;
    f32x16 acc[2][2];
#pragma unroll
    for (int a = 0; a < 2; a++)
#pragma unroll
      for (int c = 0; c < 2; c++)
#pragma unroll
        for (int r = 0; r < 16; r++) acc[a][c][r] = 0.f;
    gemm_mainloop(p.mix + (size_t)row0 * DM, p.wout_b + ((size_t)l * DM + col0) * DM, smem, acc);
    const int n0 = col0 + wn * 64 + l32;
#pragma unroll
    for (int mi = 0; mi < 2; mi++) {
#pragma unroll
      for (int r = 0; r < 16; r++) {
        int row = row0 + wm * 64 + mi * 32 + (r & 3) + 8 * (r >> 2) + 4 * lh;
        if (l == 0) {
          const float* xo = (row < NPR) ? (p.x_prompt + (size_t)row * DM) : (p.x_sample + (size_t)(row - NPR) * DM);
          float a0 = xo[n0] + acc[mi][0][r];
          float a1 = xo[n0 + 32] + acc[mi][1][r];
          p.x1[(size_t)row * DM + n0] = a0;
          p.x1[(size_t)row * DM + n0 + 32] = a1;
          p.xb[(size_t)row * DM + n0] = f2bf(a0);
          p.xb[(size_t)row * DM + n0 + 32] = f2bf(a1);
          float ss = a0 * a0 + a1 * a1;
#pragma unroll
          for (int m = 16; m >= 1; m >>= 1) ss += __shfl_xor(ss, m);
          if (l32 == 0) atomicAdd(p.sumsq + NTOK + row, ss);
        } else {
          const float* xo = p.x1 + (size_t)row * DM;
          p.out[(size_t)row * DM + n0] = xo[n0] + acc[mi][0][r];
          p.out[(size_t)row * DM + n0 + 32] = xo[n0 + 32] + acc[mi][1][r];
        }
      }
    }
  }
}

__device__ void p2_ab(const Params& p, int l, int it, char* smem) {
  const int tid = otid();
  const int c0 = tid & 127, q = tid >> 7;
  const int lane = tid & 63, w = tid >> 6;
  const int R0 = it * 32;
  const int spos = R0 & 2047;
  const int rowq = R0 + q * 8;
  const int bseq = R0 >> 11;
  const bool last = (spos == 2016);
  const u16* __restrict__ inter = p.inter;
  u16* atile = (u16*)smem;
  float* cbuf = (float*)(smem + 47616);
  float* red = (float*)(smem + 96768);
  for (int e = tid; e < 62 * 48; e += NT) {
    int r = e / 48, ch = e - r * 48;
    uint4 v = make_uint4(0, 0, 0, 0);
    if (spos - 30 + r >= 0) v = *(const uint4*)(inter + (size_t)(R0 - 30 + r) * IW + ch * 8);
    *(uint4*)(atile + r * 384 + ch * 8) = v;
  }
  __syncthreads();
  float s1[8], s2[8];
#pragma unroll
  for (int t = 0; t < 8; t++) { s1[t] = 0.f; s2[t] = 0.f; }
#pragma unroll 1
  for (int jc = 0; jc < 3; jc++) {
    const int c = c0 + 128 * jc;
    float wv[31];
#pragma unroll
    for (int j = 0; j < 31; j++) wv[j] = p.a_conv_w[(l * 31 + j) * 384 + c];
    const float bias = p.a_conv_b[l * 384 + c];
    float o[8];
#pragma unroll
    for (int t = 0; t < 8; t++) o[t] = bias;
    const u16* ap = atile + (q * 8) * 384 + c;
#pragma unroll
    for (int s = 0; s < 38; s++) {
      float v = bf2f(ap[s * 384]);
#pragma unroll
      for (int t = 0; t < 8; t++) {
        const int j = s - t;
        if (j >= 0 && j <= 30) o[t] += wv[j] * v;
      }
      if (s >= 30) {
        int pp = spos + q * 8 + (s - 30);
        if (last && pp >= 2018) p.out[O_SAP + ((size_t)(l * 8 + bseq) * 30 + (pp - 2018)) * 384 + c] = v;
      }
    }
#pragma unroll
    for (int t = 0; t < 8; t++) { cbuf[(jc * 8 + t) * NT + tid] = o[t]; s1[t] += o[t]; s2[t] += o[t] * o[t]; }
  }
#pragma unroll
  for (int t = 0; t < 8; t++) {
#pragma unroll
    for (int m = 32; m >= 1; m >>= 1) { s1[t] += __shfl_xor(s1[t], m); s2[t] += __shfl_xor(s2[t], m); }
  }
  if (lane == 0) {
#pragma unroll
    for (int t = 0; t < 8; t++) { red[w * 16 + t] = s1[t]; red[w * 16 + 8 + t] = s2[t]; }
  }
  __syncthreads();
  float mu[8], rstd[8];
#pragma unroll
  for (int t = 0; t < 8; t++) {
    float S1 = red[(2 * q) * 16 + t] + red[(2 * q + 1) * 16 + t];
    float S2 = red[(2 * q) * 16 + 8 + t] + red[(2 * q + 1) * 16 + 8 + t];
    float m_ = S1 * (1.f / 384.f);
    float var = S2 * (1.f / 384.f) - m_ * m_;
    mu[t] = m_;
    rstd[t] = rsqrtf(fmaxf(var, 0.f) + EPS);
  }
#pragma unroll 1
  for (int jc = 0; jc < 3; jc++) {
    const int c = c0 + 128 * jc;
    const float g = p.a_ln_g[l * 384 + c], bb = p.a_ln_b[l * 384 + c];
    const u16* ip = inter + (size_t)rowq * IW + c;
    u16* mp = p.mix + (size_t)rowq * DM + c;
#pragma unroll
    for (int t = 0; t < 8; t++) {
      float y = (cbuf[(jc * 8 + t) * NT + tid] - mu[t]) * rstd[t] * g + bb;
      float ya = siluf_(y) * bf2f(ip[(size_t)t * IW + 384]);
      mp[t * DM] = f2bf(ya);
    }
    const float w0 = p.b_conv_w[(l * 3 + 0) * 384 + c], w1 = p.b_conv_w[(l * 3 + 1) * 384 + c], w2 = p.b_conv_w[(l * 3 + 2) * 384 + c];
    float z[10];
#pragma unroll
    for (int s = 0; s < 10; s++) {
      int pp = spos + q * 8 - 2 + s;
      z[s] = 0.f;
      if (pp >= 0) z[s] = bf2f(inter[(size_t)(rowq - 2 + s) * IW + 768 + c]);
    }
#pragma unroll
    for (int t = 0; t < 8; t++) {
      float cv = w0 * z[t] + w1 * z[t + 1] + w2 * z[t + 2];
      float yb = bf2f(ip[(size_t)t * IW + 1152]) * cv;
      mp[t * DM + 384] = f2bf(yb);
    }
    if (last && q == 3) {
      p.out[O_SBP + ((size_t)(l * 8 + bseq) * 2 + 0) * 384 + c] = z[8];
      p.out[O_SBP + ((size_t)(l * 8 + bseq) * 2 + 1) * 384 + c] = z[9];
    }
  }
  __syncthreads();
}

__device__ void p2_c(const Params& p, int l, int ci, char* smem) {
  const int tid = otid();
  const int lane = tid & 63, w = tid >> 6;
  const int l32 = lane & 31, lh = lane >> 5;
  const int R0 = ci * 128;
  const u16* __restrict__ inter = p.inter;
  float* stats = (float*)(smem + 65536);
  {
    int tok = tid >> 2, qd = tid & 3;
    const u16* src = inter + (size_t)(R0 + tok) * IW + 1792 + qd * 64;
    float s1 = 0.f, s2 = 0.f;
#pragma unroll
    for (int i = 0; i < 8; i++) {
      uint4 v = *(const uint4*)(src + i * 8);
      unsigned uu[4] = {v.x, v.y, v.z, v.w};
#pragma unroll
      for (int k = 0; k < 4; k++) {
        float a = __uint_as_float(uu[k] << 16), bq = __uint_as_float(uu[k] & 0xffff0000u);
        s1 += a + bq;
        s2 += a * a + bq * bq;
      }
    }
    s1 += __shfl_xor(s1, 1); s2 += __shfl_xor(s2, 1);
    s1 += __shfl_xor(s1, 2); s2 += __shfl_xor(s2, 2);
    if (qd == 0) {
      float m_ = s1 * (1.f / 256.f);
      float var = s2 * (1.f / 256.f) - m_ * m_;
      stats[tok * 2] = m_;
      stats[tok * 2 + 1] = rsqrtf(fmaxf(var, 0.f) + EPS);
    }
  }
  __syncthreads();
  {
    int c = tid & 255, th = tid >> 8;
    const float g = p.c_ln_g[l * 256 + c], bb = p.c_ln_b[l * 256 + c];
#pragma unroll
    for (int g8 = 0; g8 < 8; g8++) {
      int t0 = th * 64 + g8 * 8;
      float vn[8];
#pragma unroll
      for (int i = 0; i < 8; i++) {
        float x = bf2f(inter[(size_t)(R0 + t0 + i) * IW + 1792 + c]);
        vn[i] = (x - stats[(t0 + i) * 2]) * stats[(t0 + i) * 2 + 1] * g + bb;
      }
      uint4 o;
      o.x = pack2(vn[0], vn[1]); o.y = pack2(vn[2], vn[3]); o.z = pack2(vn[4], vn[5]); o.w = pack2(vn[6], vn[7]);
      *(uint4*)(smem + c * 256 + ((((t0 >> 3)) ^ (c & 15)) << 4)) = o;
    }
  }
  __syncthreads();
  {
    const int h = w >> 1;
    const int c = h * 64 + (w & 1) * 32 + l32;
    f32x16 acc[4];
#pragma unroll
    for (int ti = 0; ti < 4; ti++)
#pragma unroll
      for (int r = 0; r < 16; r++) acc[ti][r] = 0.f;
    const u16* wb = p.wc_b + ((size_t)(l * 4 + h) * 128 + l32) * 128 + lh * 8;
#pragma unroll
    for (int ks = 0; ks < 8; ks++) {
      bf16x8 bfrag = *(const bf16x8*)(smem + c * 256 + (((ks * 2 + lh) ^ (c & 15)) << 4));
#pragma unroll
      for (int ti = 0; ti < 4; ti++) {
        if (ti >= (ks >> 1)) {
          bf16x8 afrag = *(const bf16x8*)(wb + (size_t)ti * 32 * 128 + ks * 16);
          acc[ti] = __builtin_amdgcn_mfma_f32_32x32x16_bf16(afrag, bfrag, acc[ti], 0, 0, 0);
        }
      }
    }
#pragma unroll
    for (int ti = 0; ti < 4; ti++) {
#pragma unroll
      for (int r = 0; r < 16; r++) {
        int t = ti * 32 + (r & 3) + 8 * (r >> 2) + 4 * lh;
        size_t row = R0 + t;
        float val = acc[ti][r] + p.c_bs[(l * 4 + h) * 128 + t];
        float yc = bf2f(inter[row * IW + 1536 + c]) * val;
        p.mix[row * DM + 768 + c] = f2bf(yc);
      }
    }
  }
  __syncthreads();
}

__device__ void p2_s(const Params& p, int l, int n, float* red, float* smem_f) {
  const int tid = otid();
  const int lane = tid & 63, w = tid >> 6;
  const int c = tid;
  const size_t Rs = NPR + (size_t)n * 4;
  const u16* __restrict__ inter = p.inter;
  float rv[16];
#pragma unroll
  for (int i = 0; i < 16; i++) rv[i] = 0.f;
  float o[4] = {0.f, 0.f, 0.f, 0.f};
  float zin[6] = {0.f, 0.f, 0.f, 0.f, 0.f, 0.f};
  float cvv[4] = {0.f, 0.f, 0.f, 0.f};
  if (c < 384) {
    float* inl = (float*)smem_f + tid;
    const float* sa = p.state_a + ((size_t)(l * 128 + n) * 30) * 384 + c;
    float* so = p.out + O_SAS + ((size_t)(l * 128 + n) * 30) * 384 + c;
#pragma unroll 2
    for (int i = 0; i < 30; i++) {
      float v = sa[i * 384];
      inl[i * NT] = v;
      if (i >= 4) so[(i - 4) * 384] = v;
    }
#pragma unroll
    for (int t = 0; t < 4; t++) {
      float v = bf2f(inter[(Rs + t) * IW + c]);
      inl[(30 + t) * NT] = v;
      so[(26 + t) * 384] = v;
    }
    const float bias = p.a_conv_b[l * 384 + c];
#pragma unroll
    for (int t = 0; t < 4; t++) o[t] = bias;
    float i0 = inl[0], i1 = inl[NT], i2 = inl[2 * NT];
#pragma unroll 1
    for (int j = 0; j < 31; j++) {
      float wj = p.a_conv_w[(l * 31 + j) * 384 + c];
      float i3 = inl[(j + 3) * NT];
      o[0] += wj * i0; o[1] += wj * i1; o[2] += wj * i2; o[3] += wj * i3;
      i0 = i1; i1 = i2; i2 = i3;
    }
#pragma unroll
    for (int t = 0; t < 4; t++) { rv[t] = o[t]; rv[4 + t] = o[t] * o[t]; }
    const float* sb = p.state_b + ((size_t)(l * 128 + n) * 2) * 384 + c;
    zin[0] = sb[0]; zin[1] = sb[384];
#pragma unroll
    for (int t = 0; t < 4; t++) zin[2 + t] = bf2f(inter[(Rs + t) * IW + 768 + c]);
  }
  if (c < 256) {
#pragma unroll
    for (int t = 0; t < 4; t++) {
      cvv[t] = bf2f(inter[(Rs + t) * IW + 1792 + c]);
      rv[8 + t] = cvv[t];
      rv[12 + t] = cvv[t] * cvv[t];
    }
  }
#pragma unroll
  for (int i = 0; i < 16; i++) {
#pragma unroll
    for (int m = 32; m >= 1; m >>= 1) rv[i] += __shfl_xor(rv[i], m);
  }
  if (lane == 0) {
#pragma unroll
    for (int i = 0; i < 16; i++) red[w * 16 + i] = rv[i];
  }
  __syncthreads();
#pragma unroll
  for (int i = 0; i < 16; i++) {
    float s = 0.f;
#pragma unroll
    for (int ww = 0; ww < 8; ww++) s += red[ww * 16 + i];
    rv[i] = s;
  }
  if (c < 384) {
    const float g = p.a_ln_g[l * 384 + c], bb = p.a_ln_b[l * 384 + c];
    const float w0 = p.b_conv_w[(l * 3 + 0) * 384 + c], w1 = p.b_conv_w[(l * 3 + 1) * 384 + c], w2 = p.b_conv_w[(l * 3 + 2) * 384 + c];
#pragma unroll
    for (int t = 0; t < 4; t++) {
      float m_ = rv[t] * (1.f / 384.f);
      float var = rv[4 + t] * (1.f / 384.f) - m_ * m_;
      float rstd = rsqrtf(fmaxf(var, 0.f) + EPS);
      float y = (o[t] - m_) * rstd * g + bb;
      float ya = siluf_(y) * bf2f(inter[(Rs + t) * IW + 384 + c]);
      p.mix[(Rs + t) * DM + c] = f2bf(ya);
      float cv = w0 * zin[t] + w1 * zin[t + 1] + w2 * zin[t + 2];
      float yb = bf2f(inter[(Rs + t) * IW + 1152 + c]) * cv;
      p.mix[(Rs + t) * DM + 384 + c] = f2bf(yb);
    }
    p.out[O_SBS + ((size_t)(l * 128 + n) * 2 + 0) * 384 + c] = zin[4];
    p.out[O_SBS + ((size_t)(l * 128 + n) * 2 + 1) * 384 + c] = zin[5];
  }
  if (c < 256) {
    const float g = p.c_ln_g[l * 256 + c], bb = p.c_ln_b[l * 256 + c];
    const int h = c >> 6;
    float vn[4];
#pragma unroll
    for (int t = 0; t < 4; t++) {
      float m_ = rv[8 + t] * (1.f / 256.f);
      float var = rv[12 + t] * (1.f / 256.f) - m_ * m_;
      float rstd = rsqrtf(fmaxf(var, 0.f) + EPS);
      vn[t] = (cvv[t] - m_) * rstd * g + bb;
      p.out[O_SCV + ((size_t)(l * 128 + n) * 4 + t) * 256 + c] = vn[t];
    }
#pragma unroll
    for (int t = 0; t < 4; t++) {
      float acc = p.c_bs[(l * 4 + h) * 128 + t];
#pragma unroll
      for (int s = 0; s < 4; s++)
        if (s <= t) acc += p.c_ws[((size_t)(l * 4 + h) * 128 + t) * 128 + s] * vn[s];
      float yc = bf2f(inter[(Rs + t) * IW + 1536 + c]) * acc;
      p.mix[(Rs + t) * DM + 768 + c] = f2bf(yc);
    }
  }
  __syncthreads();
}

__device__ void phase2(const Params& p, int l, char* smem) {
  float* red = (float*)(smem + 90112);
  const int nb = gridDim.x, b = blockIdx.x;
  for (int it = b; it < 512; it += nb) {
    asm volatile("" ::: "memory");
    p2_ab(p, l, it, smem);
  }
  for (int it = b; it < 128; it += nb) {
    asm volatile("" ::: "memory");
    p2_c(p, l, it, smem);
  }
  for (int it = (b + nb - (128 % nb)) % nb; it < 128; it += nb) {
    asm volatile("" ::: "memory");
    p2_s(p, l, it, red, (float*)smem);
  }
}

__device__ void phase4(const Params& p) {
  const int tid = otid(), wave = tid >> 6, lane = tid & 63;
  for (int row = blockIdx.x * 8 + wave; row < NTOK; row += gridDim.x * 8) {
    float* xr = p.out + (size_t)row * DM;
    float4 v[4];
    float ss = 0.f;
#pragma unroll
    for (int j = 0; j < 4; j++) {
      v[j] = *(const float4*)(xr + (j * 64 + lane) * 4);
      ss += v[j].x * v[j].x + v[j].y * v[j].y + v[j].z * v[j].z + v[j].w * v[j].w;
    }
#pragma unroll
    for (int m = 32; m >= 1; m >>= 1) ss += __shfl_xor(ss, m);
    float rs = rsqrtf(ss * (1.f / 1024.f) + EPS);
#pragma unroll
    for (int j = 0; j < 4; j++) {
      float4 g = *(const float4*)(p.final_g + (j * 64 + lane) * 4);
      float4 o;
      o.x = v[j].x * rs * g.x; o.y = v[j].y * rs * g.y; o.z = v[j].z * rs * g.z; o.w = v[j].w * rs * g.w;
      *(float4*)(xr + (j * 64 + lane) * 4) = o;
    }
  }
}

__global__ void __launch_bounds__(NT) fwd_megakernel(Params p) {
  extern __shared__ __attribute__((aligned(16))) char smem[];
  __shared__ uint4 xb_words;
  if (threadIdx.x == 0) xb_words = make_uint4(0u, 0u, 0u, 0u);
  __syncthreads();
  XcdBarrier gb = xcd_barrier_post(p.bar, (volatile LAS unsigned*)&xb_words);
  phase0(p, smem);
  xcd_barrier(gb);
#pragma unroll 1
  for (int l = 0; l < 2; l++) {
    phase1(p, l, smem);
    xcd_barrier(gb);
    phase2(p, l, smem);
    xcd_barrier(gb);
    phase3(p, l, smem);
    xcd_barrier(gb);
  }
  phase4(p);
}

extern "C" void kernel_launch(void* const* d_in, const int* in_sizes, int n_in, void* d_out, int out_size, void* d_ws,
                              size_t ws_size, hipStream_t stream) {
  static int grid_blocks = 0;
  if (!grid_blocks) {
    int dev = 0, cus = 0, per_cu = 0;
    hipGetDevice(&dev);
    hipDeviceGetAttribute(&cus, hipDeviceAttributeMultiprocessorCount, dev);
    hipFuncSetAttribute((const void*)fwd_megakernel, hipFuncAttributeMaxDynamicSharedMemorySize, LDS_BYTES);
    hipOccupancyMaxActiveBlocksPerMultiprocessor(&per_cu, (const void*)fwd_megakernel, NT, LDS_BYTES);
    if (per_cu < 1) { fprintf(stderr, "occupancy query returned %d\n", per_cu); per_cu = 1; }
    if (per_cu > 1) per_cu = 1;
    grid_blocks = cus * per_cu;
  }
  Params p{};
  p.x_prompt = (const float*)d_in[0];
  p.x_sample = (const float*)d_in[1];
  p.state_a = (const float*)d_in[2];
  p.state_b = (const float*)d_in[3];
  p.norm_g = (const float*)d_in[4];
  p.w_in = (const float*)d_in[5];
  p.a_conv_w = (const float*)d_in[6];
  p.a_conv_b = (const float*)d_in[7];
  p.a_ln_g = (const float*)d_in[8];
  p.a_ln_b = (const float*)d_in[9];
  p.b_conv_w = (const float*)d_in[10];
  p.c_ln_g = (const float*)d_in[11];
  p.c_ln_b = (const float*)d_in[12];
  p.c_ws = (const float*)d_in[13];
  p.c_bs = (const float*)d_in[14];
  p.w_out = (const float*)d_in[15];
  p.final_g = (const float*)d_in[16];
  p.out = (float*)d_out;
  char* ws = (char*)d_ws;
  size_t off = 0;
  auto take = [&](size_t bytes) { char* r = ws + off; off += (bytes + 255) & ~(size_t)255; return r; };
  p.win_b = (u16*)take((size_t)2 * INW * DM * 2);
  p.wout_b = (u16*)take((size_t)2 * DM * DM * 2);
  p.wc_b = (u16*)take((size_t)2 * 4 * 128 * 128 * 2);
  p.xb = (u16*)take((size_t)NTOK * DM * 2);
  p.inter = (u16*)take((size_t)NTOK * IW * 2);
  p.mix = (u16*)take((size_t)NTOK * DM * 2);
  p.sumsq = (float*)take((size_t)2 * NTOK * 4);
  p.x1 = (float*)take((size_t)NTOK * DM * 4);
  p.bar = (unsigned*)take((size_t)XCD_BAR_WORDS * 4);
  hipMemsetAsync(p.bar, 0, (size_t)XCD_BAR_WORDS * 4, stream);
  void* args[] = {&p};
  hipError_t e = hipLaunchCooperativeKernel((const void*)fwd_megakernel, dim3(grid_blocks), dim3(NT), args, LDS_BYTES, stream);
  if (e != hipSuccess) fprintf(stderr, "cooperative launch failed: %s (grid %d)\n", hipGetErrorString(e), grid_blocks);
}
```

```cpp
#include <hip/hip_runtime.h>
#include <cstdio>
#include <cstdint>

typedef unsigned short u16;
typedef short bf16x8 __attribute__((ext_vector_type(8)));
typedef float f32x16 __attribute__((ext_vector_type(16)));

constexpr int NTOK = 16896, NPR = 16384, DM = 1024, INW = 3456, IW = 2048;
constexpr int NT = 512;
constexpr int LDS_BYTES = 131072;
constexpr float EPS = 1e-6f;

constexpr size_t O_SAP = 17301504, O_SBP = 17485824, O_SAS = 17498112, O_SBS = 20447232, O_SCV = 20643840;

struct Params {
  const float *x_prompt, *x_sample, *state_a, *state_b, *norm_g, *w_in, *a_conv_w, *a_conv_b, *a_ln_g, *a_ln_b,
      *b_conv_w, *c_ln_g, *c_ln_b, *c_ws, *c_bs, *w_out, *final_g;
  float* out;
  u16 *win_b, *wout_b, *wc_b, *xb, *inter, *mix;
  float *sumsq, *rsw;
  unsigned* bar;
};

__device__ __forceinline__ u16 f2bf(float f) {
  unsigned u = __float_as_uint(f);
  u += 0x7fffu + ((u >> 16) & 1u);
  return (u16)(u >> 16);
}
__device__ __forceinline__ float bf2f(u16 h) { return __uint_as_float(((unsigned)h) << 16); }
__device__ __forceinline__ unsigned pack2(float a, float b) { return (unsigned)f2bf(a) | ((unsigned)f2bf(b) << 16); }
__device__ __forceinline__ float sigmoidf_(float x) { return 1.f / (1.f + __expf(-x)); }
__device__ __forceinline__ float siluf_(float x) { return x / (1.f + __expf(-x)); }

__device__ __forceinline__ void unpack8(const uint4& v, float (&f)[8]) {
  f[0] = __uint_as_float(v.x << 16); f[1] = __uint_as_float(v.x & 0xffff0000u);
  f[2] = __uint_as_float(v.y << 16); f[3] = __uint_as_float(v.y & 0xffff0000u);
  f[4] = __uint_as_float(v.z << 16); f[5] = __uint_as_float(v.z & 0xffff0000u);
  f[6] = __uint_as_float(v.w << 16); f[7] = __uint_as_float(v.w & 0xffff0000u);
}
__device__ __forceinline__ uint4 pack8(const float (&f)[8]) {
  uint4 o;
  o.x = pack2(f[0], f[1]); o.y = pack2(f[2], f[3]); o.z = pack2(f[4], f[5]); o.w = pack2(f[6], f[7]);
  return o;
}

__device__ __forceinline__ int otid() {
  int t = threadIdx.x;
  asm volatile("" : "+v"(t));
  return t;
}

__device__ __forceinline__ int vcol_src(int vc) {
  int j = vc >> 7, v = vc & 127;
  int wn = v >> 6, ni = (v >> 5) & 1, l32 = v & 31;
  int chp = wn * 32 + l32;
  if (j < 6) return (ni ? 384 : 0) + j * 64 + chp;
  if (j < 9) return 768 + (j - 6) * 128 + v;
  if (j < 15) return (ni ? 1920 : 1152) + (j - 9) * 64 + chp;
  if (j < 21) return (ni ? 2304 : 1536) + (j - 15) * 64 + chp;
  if (j < 25) return (ni ? 3200 : 2688) + (j - 21) * 64 + chp;
  return 2944 + (j - 25) * 128 + v;
}


#define XB_TMO      128
#define XB_XCNT(j)  (256  + 64 * (j))
#define XB_XSUB(j)  (1280 + 64 * (j))
#define XB_XGEN(j)  (2304 + 64 * (j))
#define XB_TOP      3328
#define XB_TOPGEN   3392
#define XCD_BAR_WORDS 3456
#define XB_SPIN_CAP (1u << 18)
#define LAS __attribute__((address_space(3)))

__device__ __forceinline__ unsigned xb_ld(unsigned* p)              { return __hip_atomic_load(p, __ATOMIC_RELAXED, __HIP_MEMORY_SCOPE_AGENT); }
__device__ __forceinline__ unsigned xb_add(unsigned* p, unsigned v) { return __hip_atomic_fetch_add(p, v, __ATOMIC_RELAXED, __HIP_MEMORY_SCOPE_AGENT); }
__device__ __forceinline__ unsigned xb_xcc_id() { return (unsigned)__builtin_amdgcn_s_getreg((3 << 11) | 20) & 0xFu; }
#define XB_SPIN(cond, bar) do { unsigned _sp = 0; while (cond) { __builtin_amdgcn_s_sleep(1); \
    if ((++_sp & 255u) == 0u) { if (xb_ld(&(bar)[XB_TMO])) break; if (_sp > XB_SPIN_CAP) { atomicAdd(&(bar)[XB_TMO], 1u); break; } } } } while (0)

struct XcdBarrier {
  unsigned* bar; unsigned x;
  volatile LAS unsigned* st;
};
__device__ __forceinline__ XcdBarrier xcd_barrier_post(unsigned* bar, volatile LAS unsigned* st) {
  XcdBarrier b; b.bar = bar; b.x = xb_xcc_id(); b.st = st;
  if (threadIdx.x == 0) (void)xb_add(&bar[XB_XCNT(b.x)], 1u);
  return b;
}
__device__ __forceinline__ void xcd_barrier_complete(unsigned* bar, unsigned x, unsigned& nloc, unsigned& nx) {
  const unsigned G = gridDim.x * gridDim.y * gridDim.z;
  unsigned sum, cnt, mine, sp = 0u;
  for (;;) {
    sum = 0u; cnt = 0u; mine = 0u;
#pragma unroll
    for (unsigned j = 0; j < 16; ++j) { const unsigned c = xb_ld(&bar[XB_XCNT(j)]); sum += c; cnt += (c > 0u) ? 1u : 0u; mine = (j == x) ? c : mine; }
    if (sum == G) break;
    __builtin_amdgcn_s_sleep(1);
    if ((++sp & 255u) == 0u) { if (xb_ld(&bar[XB_TMO])) break; if (sp > XB_SPIN_CAP) { atomicAdd(&bar[XB_TMO], 1u); break; } }
  }
  nloc = mine > 0u ? mine : 1u; nx = cnt > 0u ? cnt : 1u;
}
__device__ __forceinline__ void xcd_barrier(const XcdBarrier& b) {
  asm volatile("s_waitcnt vmcnt(0)" ::: "memory");
  __syncthreads();
  if (threadIdx.x == 0) {
    unsigned* bar = b.bar;
    __builtin_amdgcn_s_waitcnt(0);
    unsigned nloc = b.st[0], nx = b.st[1];
    if (nloc == 0u) { xcd_barrier_complete(bar, b.x, nloc, nx); b.st[0] = nloc; b.st[1] = nx; }
    const unsigned old = xb_add(&bar[XB_XSUB(b.x)], 1u);
    const unsigned gen = old / nloc;
    if (old + 1u == (gen + 1u) * nloc) {
      __builtin_amdgcn_fence(__ATOMIC_RELEASE, "agent");
      asm volatile("s_waitcnt vmcnt(0)" ::: "memory");
      const unsigned og = xb_add(&bar[XB_TOP], 1u);
      const unsigned tg = og / nx;
      if (og + 1u == (tg + 1u) * nx) xb_add(&bar[XB_TOPGEN], 1u);
      else XB_SPIN(xb_ld(&bar[XB_TOPGEN]) == tg, bar);
      __builtin_amdgcn_fence(__ATOMIC_ACQUIRE, "agent");
      xb_add(&bar[XB_XGEN(b.x)], 1u);
      asm volatile("s_waitcnt vmcnt(0)" ::: "memory");
    } else {
      XB_SPIN(xb_ld(&bar[XB_XGEN(b.x)]) == gen, bar);
      __builtin_amdgcn_fence(__ATOMIC_ACQUIRE, "agent");
      asm volatile("s_waitcnt vmcnt(0)" ::: "memory");
    }
  }
  __syncthreads();
}

__device__ void p0_transpose(const float* __restrict__ W, int ncols, const float* __restrict__ g, u16* __restrict__ outp,
                             int k0, int v0, bool mapv, float* tile) {
  int tid = otid();
#pragma unroll
  for (int i = 0; i < 8; i++) {
    int e = tid + i * NT;
    int kk = e >> 6, v = e & 63;
    int src = mapv ? vcol_src(v0 + v) : (v0 + v);
    float val = W[(size_t)(k0 + kk) * ncols + src];
    if (g) val *= g[k0 + kk];
    tile[kk * 65 + v] = val;
  }
  __syncthreads();
  {
    int v = tid >> 3, kq = tid & 7;
    const float* tp = tile + (kq * 8) * 65 + v;
    uint4 o;
    o.x = pack2(tp[0], tp[65]);
    o.y = pack2(tp[2 * 65], tp[3 * 65]);
    o.z = pack2(tp[4 * 65], tp[5 * 65]);
    o.w = pack2(tp[6 * 65], tp[7 * 65]);
    *(uint4*)(outp + (size_t)(v0 + v) * 1024 + k0 + kq * 8) = o;
  }
  __syncthreads();
}

__device__ void phase0(const Params& p, char* smem) {
  float* tile = (float*)smem;
  int nb = gridDim.x, b = blockIdx.x, tid = otid();
  for (int it = b; it < 2 * 16 * 54; it += nb) {
    int l = it / (16 * 54), rem = it % (16 * 54);
    int kb = rem / 54, vb = rem % 54;
    p0_transpose(p.w_in + (size_t)l * DM * INW, INW, p.norm_g + l * DM, p.win_b + (size_t)l * INW * DM, kb * 64, vb * 64, true, tile);
  }
  for (int it = b; it < 2 * 16 * 16; it += nb) {
    int l = it >> 8, rem = it & 255;
    int kb = rem >> 4, vb = rem & 15;
    p0_transpose(p.w_out + (size_t)l * DM * DM, DM, nullptr, p.wout_b + (size_t)l * DM * DM, kb * 64, vb * 64, false, tile);
  }
  for (int e = b * NT + tid; e < 2 * 4 * 128 * 128; e += nb * NT) {
    int s = e & 127, t = (e >> 7) & 127;
    p.wc_b[e] = (s <= t) ? f2bf(p.c_ws[e]) : (u16)0;
  }
  for (int e = b * NT + tid; e < 2 * NTOK; e += nb * NT) p.sumsq[NTOK + e] = 0.f;
  for (int e = b * NT + tid; e < 2 * 4 * 128; e += nb * NT) {
    int t = e & 127;
    const float* wr = p.c_ws + (size_t)e * 128;
    float s = 0.f;
    for (int k = 0; k <= t; k++) s += bf2f(f2bf(wr[k]));
    p.rsw[e] = s;
  }
  int wave = tid >> 6, lane = tid & 63;
  for (int row = b * 8 + wave; row < NTOK; row += nb * 8) {
    const float* xr = (row < NPR) ? (p.x_prompt + (size_t)row * DM) : (p.x_sample + (size_t)(row - NPR) * DM);
    float ss = 0.f;
#pragma unroll
    for (int j = 0; j < 4; j++) {
      float4 v = *(const float4*)(xr + (j * 64 + lane) * 4);
      ss += v.x * v.x + v.y * v.y + v.z * v.z + v.w * v.w;
      uint2 o;
      o.x = pack2(v.x, v.y);
      o.y = pack2(v.z, v.w);
      *(uint2*)(p.xb + (size_t)row * DM + (j * 64 + lane) * 4) = o;
    }
#pragma unroll
    for (int m = 32; m >= 1; m >>= 1) ss += __shfl_xor(ss, m);
    if (lane == 0) p.sumsq[row] = ss;
  }
}

__device__ __forceinline__ void gemm_mainloop(const u16* __restrict__ Ag, const u16* __restrict__ Bg, char* smem,
                                              f32x16 (&acc)[2][2]) {
  const int tid = otid();
  const int lane = tid & 63, w = tid >> 6;
  const int wm = w >> 1, wn = w & 1;
  const int l32 = lane & 31, lh = lane >> 5;
  const int sr = tid >> 3, sc = tid & 7;
  const int st_off = sr * 128 + ((sc ^ ((sr >> 1) & 7)) << 4);
  const u16* ag = Ag + (size_t)sr * DM + sc * 8;
  const u16* bg = Bg + (size_t)sr * DM + sc * 8;
  const int fsw = (l32 >> 1) & 7;
  const int a_off = (wm * 64 + l32) * 128;
  const int b_off = 32768 + (wn * 64 + l32) * 128;

  uint4 ra[4], rb[2];
#pragma unroll
  for (int i = 0; i < 4; i++) ra[i] = *(const uint4*)(ag + (size_t)i * 64 * DM);
#pragma unroll
  for (int i = 0; i < 2; i++) rb[i] = *(const uint4*)(bg + (size_t)i * 64 * DM);
#pragma unroll
  for (int i = 0; i < 4; i++) *(uint4*)(smem + st_off + i * 8192) = ra[i];
#pragma unroll
  for (int i = 0; i < 2; i++) *(uint4*)(smem + 32768 + st_off + i * 8192) = rb[i];
  __syncthreads();

  for (int kt = 0; kt < 16; kt++) {
    char* cur = smem + (kt & 1) * 49152;
    char* nxt = smem + ((kt + 1) & 1) * 49152;
    if (kt < 15) {
#pragma unroll
      for (int i = 0; i < 4; i++) ra[i] = *(const uint4*)(ag + (size_t)i * 64 * DM + (kt + 1) * 64);
#pragma unroll
      for (int i = 0; i < 2; i++) rb[i] = *(const uint4*)(bg + (size_t)i * 64 * DM + (kt + 1) * 64);
    }
#pragma unroll
    for (int kk = 0; kk < 4; kk++) {
      const int co = ((kk * 2 + lh) ^ fsw) << 4;
      bf16x8 a0 = *(const bf16x8*)(cur + a_off + co);
      bf16x8 a1 = *(const bf16x8*)(cur + a_off + 32 * 128 + co);
      bf16x8 b0 = *(const bf16x8*)(cur + b_off + co);
      bf16x8 b1 = *(const bf16x8*)(cur + b_off + 32 * 128 + co);
      acc[0][0] = __builtin_amdgcn_mfma_f32_32x32x16_bf16(b0, a0, acc[0][0], 0, 0, 0);
      acc[0][1] = __builtin_amdgcn_mfma_f32_32x32x16_bf16(b1, a0, acc[0][1], 0, 0, 0);
      acc[1][0] = __builtin_amdgcn_mfma_f32_32x32x16_bf16(b0, a1, acc[1][0], 0, 0, 0);
      acc[1][1] = __builtin_amdgcn_mfma_f32_32x32x16_bf16(b1, a1, acc[1][1], 0, 0, 0);
    }
    if (kt < 15) {
#pragma unroll
      for (int i = 0; i < 4; i++) *(uint4*)(nxt + st_off + i * 8192) = ra[i];
#pragma unroll
      for (int i = 0; i < 2; i++) *(uint4*)(nxt + 32768 + st_off + i * 8192) = rb[i];
    }
    __syncthreads();
  }
}

__device__ __forceinline__ bool next_tile(int& u, int ntiles, int& T) {
  int nb = gridDim.x, b = blockIdx.x;
  if ((nb & 7) == 0) {
    int per = (ntiles + 7) >> 3;
    int x = b & 7, nslots = nb >> 3;
    while (true) {
      if (u >= per) return false;
      T = x * per + u;
      u += nslots;
      if (T < ntiles) return true;
    }
  } else {
    if (u >= ntiles) return false;
    T = u;
    u += nb;
    return true;
  }
}
__device__ __forceinline__ int first_u() {
  return ((gridDim.x & 7) == 0) ? (int)(blockIdx.x >> 3) : (int)blockIdx.x;
}

__device__ void phase1(const Params& p, int l, char* smem) {
  const int tid = otid();
  const int lane = tid & 63, w = tid >> 6;
  const int wm = w >> 1, wn = w & 1;
  const int l32 = lane & 31, lh = lane >> 5;
  const float* ssq = p.sumsq + (size_t)l * NTOK;
  int u = first_u(), T;
  while (next_tile(u, 66 * 27, T)) {
    int rb = T / 27, j = T - rb * 27;
    int row0 = rb * 256;
    f32x16 acc[2][2];
#pragma unroll
    for (int a = 0; a < 2; a++)
#pragma unroll
      for (int c = 0; c < 2; c++)
#pragma unroll
        for (int r = 0; r < 16; r++) acc[a][c][r] = 0.f;
    gemm_mainloop(p.xb + (size_t)row0 * DM, p.win_b + ((size_t)l * INW + (size_t)j * 128) * DM, smem, acc);
    int kind, ob;
    if (j < 6) { kind = 0; ob = j * 64; }
    else if (j < 9) { kind = 1; ob = 384 + (j - 6) * 128; }
    else if (j < 15) { kind = 2; ob = 768 + (j - 9) * 64; }
    else if (j < 21) { kind = 3; ob = 1152 + (j - 15) * 64; }
    else if (j < 25) { kind = 3; ob = 1536 + (j - 21) * 64; }
    else { kind = 4; ob = 1792 + (j - 25) * 128; }
    const bool paired = (kind == 0 || kind == 2 || kind == 3);
    const int rowb = paired ? 144 : 272;
#pragma unroll
    for (int mi = 0; mi < 2; mi++) {
      const int m = wm * 64 + mi * 32 + l32;
      const float rs = rsqrtf(ssq[row0 + m] * (1.f / 1024.f) + EPS);
#pragma unroll
      for (int g = 0; g < 4; g++) {
        float r0[4], r1[4];
#pragma unroll
        for (int i = 0; i < 4; i++) {
          float v0 = acc[mi][0][4 * g + i] * rs, v1 = acc[mi][1][4 * g + i] * rs;
          if (kind == 0) r0[i] = v0 * sigmoidf_(v1);
          else if (kind == 2) r0[i] = v0 * v1;
          else if (kind == 3) r0[i] = v0 * siluf_(v1);
          else if (kind == 1) { r0[i] = siluf_(v0); r1[i] = siluf_(v1); }
          else { r0[i] = v0; r1[i] = v1; }
        }
        const int chl = 8 * g + 4 * lh;
        if (paired) {
          *(uint2*)(smem + m * 144 + (wn * 32 + chl) * 2) = make_uint2(pack2(r0[0], r0[1]), pack2(r0[2], r0[3]));
        } else {
          *(uint2*)(smem + m * 272 + (wn * 64 + chl) * 2) = make_uint2(pack2(r0[0], r0[1]), pack2(r0[2], r0[3]));
          *(uint2*)(smem + m * 272 + (wn * 64 + 32 + chl) * 2) = make_uint2(pack2(r1[0], r1[1]), pack2(r1[2], r1[3]));
        }
      }
    }
    __syncthreads();
    if (paired) {
#pragma unroll
      for (int i = 0; i < 4; i++) {
        int q = tid + i * NT, m = q >> 3, c = q & 7;
        uint4 v = *(const uint4*)(smem + m * 144 + c * 16);
        *(uint4*)(p.inter + (size_t)(row0 + m) * IW + ob + c * 8) = v;
      }
    } else {
#pragma unroll
      for (int i = 0; i < 8; i++) {
        int q = tid + i * NT, m = q >> 4, c = q & 15;
        uint4 v = *(const uint4*)(smem + m * 272 + c * 16);
        *(uint4*)(p.inter + (size_t)(row0 + m) * IW + ob + c * 8) = v;
      }
    }
    (void)rowb;
    __syncthreads();
  }
}

__device__ void phase3(const Params& p, int l, char* smem) {
  const int tid = otid();
  const int lane = tid & 63, w = tid >> 6;
  const int wm = w >> 1, wn = w & 1;
  const int l32 = lane & 31, lh = lane >> 5;
  int u = first_u(), T;
  while (next_tile(u, 66 * 8, T)) {
    int rb = T >> 3, j = T & 7;
    int row0 = rb * 256, col0 = j * 128;
    f32x16 acc[2][2];
#pragma unroll
    for (int a = 0; a < 2; a++)
#pragma unroll
      for (int c = 0; c < 2; c++)
#pragma unroll
        for (int r = 0; r < 16; r++) acc[a][c][r] = 0.f;
    gemm_mainloop(p.mix + (size_t)row0 * DM, p.wout_b + ((size_t)l * DM + col0) * DM, smem, acc);
    float* ssq = p.sumsq + (size_t)(l + 1) * NTOK;
#pragma unroll
    for (int mi = 0; mi < 2; mi++) {
      const int m = wm * 64 + mi * 32 + l32;
      const u16* xr = p.xb + (size_t)(row0 + m) * DM + col0 + wn * 64;
      uint2 xo[2][4];
#pragma unroll
      for (int ni = 0; ni < 2; ni++)
#pragma unroll
        for (int g = 0; g < 4; g++) xo[ni][g] = *(const uint2*)(xr + ni * 32 + 8 * g + 4 * lh);
      float ss = 0.f;
#pragma unroll
      for (int ni = 0; ni < 2; ni++) {
#pragma unroll
        for (int g = 0; g < 4; g++) {
          float v0 = __uint_as_float(xo[ni][g].x << 16) + acc[mi][ni][4 * g + 0];
          float v1 = __uint_as_float(xo[ni][g].x & 0xffff0000u) + acc[mi][ni][4 * g + 1];
          float v2 = __uint_as_float(xo[ni][g].y << 16) + acc[mi][ni][4 * g + 2];
          float v3 = __uint_as_float(xo[ni][g].y & 0xffff0000u) + acc[mi][ni][4 * g + 3];
          ss += v0 * v0 + v1 * v1 + v2 * v2 + v3 * v3;
          *(uint2*)(smem + m * 272 + (wn * 64 + ni * 32 + 8 * g + 4 * lh) * 2) = make_uint2(pack2(v0, v1), pack2(v2, v3));
        }
      }
      ss += __shfl_xor(ss, 32);
      if (lh == 0) atomicAdd(ssq + row0 + m, ss);
    }
    __syncthreads();
#pragma unroll
    for (int i = 0; i < 8; i++) {
      int q = tid + i * NT, m = q >> 4, c = q & 15;
      uint4 v = *(const uint4*)(smem + m * 272 + c * 16);
      *(uint4*)(p.xb + (size_t)(row0 + m) * DM + col0 + c * 8) = v;
    }
    __syncthreads();
  }
}

__device__ void p2_stage_w(const Params& p, int l, char* smem) {
  const int tid = otid();
  const float4* src = (const float4*)(p.a_conv_w + (size_t)l * 31 * 384);
  for (int f = tid; f < 36 * 96; f += NT) {
    int j = f / 96, q = f - j * 96;
    float4 v = make_float4(0.f, 0.f, 0.f, 0.f);
    if (j < 31) v = src[f];
    ((float4*)smem)[(j * 2 + (q & 1)) * 48 + (q >> 1)] = v;
  }
}

__device__ void p2_ab(const Params& p, int l, int it, char* smem) {
  const int tid = otid();
  const int lane = tid & 63, w = tid >> 6;
  const bool active = lane < 48;
  const int o = active ? lane : 47;
  const int R0 = it * 32;
  const int spos = R0 & 2047;
  const int bseq = R0 >> 11;
  const bool last = (spos == 2016);
  const u16* __restrict__ inter = p.inter;
  char* atile = smem + 55296;
  const float4* wts = (const float4*)smem;
  uint4 st[6];
#pragma unroll
  for (int i = 0; i < 6; i++) {
    int e = tid + i * NT;
    st[i] = make_uint4(0, 0, 0, 0);
    {
      int r = e / 48, ch = e - r * 48;
      if (r < 62 && spos - 30 + r >= 0) st[i] = *(const uint4*)(inter + (size_t)(R0 - 30 + r) * IW + ch * 8);
    }
  }
  const size_t rowq = (size_t)R0 + 4 * w;
  uint4 szv[4], gbv[4], zv[6];
#pragma unroll
  for (int t = 0; t < 4; t++) {
    szv[t] = *(const uint4*)(inter + (rowq + t) * IW + 384 + 8 * o);
    gbv[t] = *(const uint4*)(inter + (rowq + t) * IW + 1152 + 8 * o);
  }
#pragma unroll
  for (int s2 = 0; s2 < 6; s2++) {
    zv[s2] = make_uint4(0, 0, 0, 0);
    if (spos + 4 * w - 2 + s2 >= 0) zv[s2] = *(const uint4*)(inter + (rowq - 2 + s2) * IW + 768 + 8 * o);
  }
#pragma unroll
  for (int i = 0; i < 6; i++) {
    int e = tid + i * NT;
    *(uint4*)(atile + e * 16) = st[i];
  }
  __syncthreads();
  float acc[4][8];
  {
    float4 b0 = *(const float4*)(p.a_conv_b + l * 384 + 8 * o), b1 = *(const float4*)(p.a_conv_b + l * 384 + 8 * o + 4);
#pragma unroll
    for (int t = 0; t < 4; t++) {
      acc[t][0] = b0.x; acc[t][1] = b0.y; acc[t][2] = b0.z; acc[t][3] = b0.w;
      acc[t][4] = b1.x; acc[t][5] = b1.y; acc[t][6] = b1.z; acc[t][7] = b1.w;
    }
  }
  float wwin[4][8];
#pragma unroll
  for (int u = 0; u < 4; u++)
#pragma unroll
    for (int c = 0; c < 8; c++) wwin[u][c] = 0.f;
  const char* arow = atile + (4 * w) * 768 + o * 16;
#pragma unroll 1
  for (int s4 = 0; s4 < 36; s4 += 4) {
    const char* ar = arow + s4 * 768;
    const float4* wr = wts + (s4 * 2) * 48 + o;
#pragma unroll
    for (int u = 0; u < 4; u++) {
      uint4 av = *(const uint4*)(ar + u * 768);
      float4 wa = wr[(u * 2) * 48], wb = wr[(u * 2 + 1) * 48];
      float v[8];
      unpack8(av, v);
      wwin[u][0] = wa.x; wwin[u][1] = wa.y; wwin[u][2] = wa.z; wwin[u][3] = wa.w;
      wwin[u][4] = wb.x; wwin[u][5] = wb.y; wwin[u][6] = wb.z; wwin[u][7] = wb.w;
#pragma unroll
      for (int t = 0; t < 4; t++) {
#pragma unroll
        for (int c = 0; c < 8; c++) acc[t][c] += wwin[(u - t) & 3][c] * v[c];
      }
    }
  }
  if (last && active) {
#pragma unroll
    for (int t = 0; t < 4; t++) {
      int pp = spos + 4 * w + t;
      if (pp >= 2018) {
        float v[8];
        unpack8(*(const uint4*)(arow + (30 + t) * 768), v);
        float* so = p.out + O_SAP + ((size_t)(l * 8 + bseq) * 30 + (pp - 2018)) * 384 + 8 * o;
        *(float4*)so = make_float4(v[0], v[1], v[2], v[3]);
        *(float4*)(so + 4) = make_float4(v[4], v[5], v[6], v[7]);
      }
    }
  }
  float s1[4], s2[4];
#pragma unroll
  for (int t = 0; t < 4; t++) {
    float a = 0.f, b = 0.f;
#pragma unroll
    for (int c = 0; c < 8; c++) { a += acc[t][c]; b += acc[t][c] * acc[t][c]; }
    s1[t] = active ? a : 0.f;
    s2[t] = active ? b : 0.f;
  }
#pragma unroll
  for (int t = 0; t < 4; t++) {
#pragma unroll
    for (int m = 32; m >= 1; m >>= 1) { s1[t] += __shfl_xor(s1[t], m); s2[t] += __shfl_xor(s2[t], m); }
  }
  {
    float g8[8], b8[8];
    {
      float4 a0 = *(const float4*)(p.a_ln_g + l * 384 + 8 * o), a1 = *(const float4*)(p.a_ln_g + l * 384 + 8 * o + 4);
      float4 c0 = *(const float4*)(p.a_ln_b + l * 384 + 8 * o), c1 = *(const float4*)(p.a_ln_b + l * 384 + 8 * o + 4);
      g8[0] = a0.x; g8[1] = a0.y; g8[2] = a0.z; g8[3] = a0.w; g8[4] = a1.x; g8[5] = a1.y; g8[6] = a1.z; g8[7] = a1.w;
      b8[0] = c0.x; b8[1] = c0.y; b8[2] = c0.z; b8[3] = c0.w; b8[4] = c1.x; b8[5] = c1.y; b8[6] = c1.z; b8[7] = c1.w;
    }
#pragma unroll
    for (int t = 0; t < 4; t++) {
      float mu = s1[t] * (1.f / 384.f);
      float var = s2[t] * (1.f / 384.f) - mu * mu;
      float rstd = rsqrtf(fmaxf(var, 0.f) + EPS);
      float sz[8], y[8];
      unpack8(szv[t], sz);
#pragma unroll
      for (int c = 0; c < 8; c++) y[c] = siluf_((acc[t][c] - mu) * rstd * g8[c] + b8[c]) * sz[c];
      if (active) *(uint4*)(p.mix + (rowq + t) * DM + 8 * o) = pack8(y);
    }
  }
  {
    float w0[8], w1[8], w2[8];
    {
      const float* bw = p.b_conv_w + (size_t)l * 3 * 384 + 8 * o;
      float4 a0 = *(const float4*)(bw), a1 = *(const float4*)(bw + 4);
      float4 c0 = *(const float4*)(bw + 384), c1 = *(const float4*)(bw + 384 + 4);
      float4 d0 = *(const float4*)(bw + 768), d1 = *(const float4*)(bw + 768 + 4);
      w0[0] = a0.x; w0[1] = a0.y; w0[2] = a0.z; w0[3] = a0.w; w0[4] = a1.x; w0[5] = a1.y; w0[6] = a1.z; w0[7] = a1.w;
      w1[0] = c0.x; w1[1] = c0.y; w1[2] = c0.z; w1[3] = c0.w; w1[4] = c1.x; w1[5] = c1.y; w1[6] = c1.z; w1[7] = c1.w;
      w2[0] = d0.x; w2[1] = d0.y; w2[2] = d0.z; w2[3] = d0.w; w2[4] = d1.x; w2[5] = d1.y; w2[6] = d1.z; w2[7] = d1.w;
    }
    float z[6][8];
#pragma unroll
    for (int s2i = 0; s2i < 6; s2i++) unpack8(zv[s2i], z[s2i]);
#pragma unroll
    for (int t = 0; t < 4; t++) {
      float gb[8], y[8];
      unpack8(gbv[t], gb);
#pragma unroll
      for (int c = 0; c < 8; c++) y[c] = gb[c] * (w0[c] * z[t][c] + w1[c] * z[t + 1][c] + w2[c] * z[t + 2][c]);
      if (active) *(uint4*)(p.mix + (rowq + t) * DM + 384 + 8 * o) = pack8(y);
    }
    if (last && w == 7 && active) {
#pragma unroll
      for (int i = 0; i < 2; i++) {
        float* so = p.out + O_SBP + ((size_t)(l * 8 + bseq) * 2 + i) * 384 + 8 * o;
        *(float4*)so = make_float4(z[4 + i][0], z[4 + i][1], z[4 + i][2], z[4 + i][3]);
        *(float4*)(so + 4) = make_float4(z[4 + i][4], z[4 + i][5], z[4 + i][6], z[4 + i][7]);
      }
    }
  }
  __syncthreads();
}

__device__ void p2_c(const Params& p, int l, int ci, char* smem) {
  const int tid = otid();
  const int lane = tid & 63, w = tid >> 6;
  const int l32 = lane & 31, lh = lane >> 5;
  const int R0 = ci * 128;
  const u16* __restrict__ inter = p.inter;
  {
    const int tok = tid >> 2, qd = tid & 3;
    const u16* src = inter + (size_t)(R0 + tok) * IW + 1792 + qd * 64;
    uint4 xv[8];
#pragma unroll
    for (int i = 0; i < 8; i++) xv[i] = *(const uint4*)(src + i * 8);
    float s1 = 0.f, s2 = 0.f;
#pragma unroll
    for (int i = 0; i < 8; i++) {
      float f[8];
      unpack8(xv[i], f);
#pragma unroll
      for (int k = 0; k < 8; k++) { s1 += f[k]; s2 += f[k] * f[k]; }
    }
    s1 += __shfl_xor(s1, 1); s2 += __shfl_xor(s2, 1);
    s1 += __shfl_xor(s1, 2); s2 += __shfl_xor(s2, 2);
    const float mu = s1 * (1.f / 256.f);
    const float rstd = rsqrtf(fmaxf(s2 * (1.f / 256.f) - mu * mu, 0.f) + EPS);
    const int tch = tok >> 3, tlo = (tok & 7) * 2;
#pragma unroll
    for (int i = 0; i < 8; i++) {
      float f[8];
      unpack8(xv[i], f);
#pragma unroll
      for (int k = 0; k < 8; k++) {
        const int c = qd * 64 + i * 8 + k;
        *(u16*)(smem + c * 256 + ((tch ^ (c & 15)) << 4) + tlo) = f2bf((f[k] - mu) * rstd);
      }
    }
  }
  __syncthreads();
  {
    const int h = w >> 1;
    const int cbase = h * 64 + (w & 1) * 32;
    const int c = cbase + l32;
    f32x16 acc[4];
#pragma unroll
    for (int ti = 0; ti < 4; ti++)
#pragma unroll
      for (int r = 0; r < 16; r++) acc[ti][r] = 0.f;
    const u16* wb = p.wc_b + ((size_t)(l * 4 + h) * 128 + l32) * 128 + lh * 8;
#pragma unroll
    for (int ks = 0; ks < 8; ks++) {
      bf16x8 vfrag = *(const bf16x8*)(smem + c * 256 + (((ks * 2 + lh) ^ (c & 15)) << 4));
#pragma unroll
      for (int ti = 0; ti < 4; ti++) {
        if (ti >= (ks >> 1)) {
          bf16x8 wfrag = *(const bf16x8*)(wb + (size_t)ti * 32 * 128 + ks * 16);
          acc[ti] = __builtin_amdgcn_mfma_f32_32x32x16_bf16(vfrag, wfrag, acc[ti], 0, 0, 0);
        }
      }
    }
    float4 gl[4], bl[4];
#pragma unroll
    for (int g = 0; g < 4; g++) {
      gl[g] = *(const float4*)(p.c_ln_g + l * 256 + cbase + 8 * g + 4 * lh);
      bl[g] = *(const float4*)(p.c_ln_b + l * 256 + cbase + 8 * g + 4 * lh);
    }
#pragma unroll
    for (int ti = 0; ti < 4; ti++) {
      const int t = ti * 32 + l32;
      const size_t row = (size_t)R0 + t;
      const float rsw = p.rsw[(l * 4 + h) * 128 + t];
      const float bs = p.c_bs[(l * 4 + h) * 128 + t];
#pragma unroll
      for (int g = 0; g < 4; g++) {
        const int d0 = cbase + 8 * g + 4 * lh;
        uint2 gc = *(const uint2*)(inter + row * IW + 1536 + d0);
        float y0 = __uint_as_float(gc.x << 16) * (gl[g].x * acc[ti][4 * g + 0] + bl[g].x * rsw + bs);
        float y1 = __uint_as_float(gc.x & 0xffff0000u) * (gl[g].y * acc[ti][4 * g + 1] + bl[g].y * rsw + bs);
        float y2 = __uint_as_float(gc.y << 16) * (gl[g].z * acc[ti][4 * g + 2] + bl[g].z * rsw + bs);
        float y3 = __uint_as_float(gc.y & 0xffff0000u) * (gl[g].w * acc[ti][4 * g + 3] + bl[g].w * rsw + bs);
        *(uint2*)(p.mix + row * DM + 768 + d0) = make_uint2(pack2(y0, y1), pack2(y2, y3));
      }
    }
  }
  __syncthreads();
}

__device__ void p2_s(const Params& p, int l, int n, float* red, float* smem_f) {
  const int tid = otid();
  const int lane = tid & 63, w = tid >> 6;
  const int c = tid;
  const size_t Rs = NPR + (size_t)n * 4;
  const u16* __restrict__ inter = p.inter;
  float rv[16];
#pragma unroll
  for (int i = 0; i < 16; i++) rv[i] = 0.f;
  float o[4] = {0.f, 0.f, 0.f, 0.f};
  float zin[6] = {0.f, 0.f, 0.f, 0.f, 0.f, 0.f};
  float cvv[4] = {0.f, 0.f, 0.f, 0.f};
  if (c < 384) {
    float* inl = (float*)smem_f + tid;
    const float* sa = p.state_a + ((size_t)(l * 128 + n) * 30) * 384 + c;
    float* so = p.out + O_SAS + ((size_t)(l * 128 + n) * 30) * 384 + c;
#pragma unroll 2
    for (int i = 0; i < 30; i++) {
      float v = sa[i * 384];
      inl[i * NT] = v;
      if (i >= 4) so[(i - 4) * 384] = v;
    }
#pragma unroll
    for (int t = 0; t < 4; t++) {
      float v = bf2f(inter[(Rs + t) * IW + c]);
      inl[(30 + t) * NT] = v;
      so[(26 + t) * 384] = v;
    }
    const float bias = p.a_conv_b[l * 384 + c];
#pragma unroll
    for (int t = 0; t < 4; t++) o[t] = bias;
    float i0 = inl[0], i1 = inl[NT], i2 = inl[2 * NT];
#pragma unroll 1
    for (int j = 0; j < 31; j++) {
      float wj = p.a_conv_w[(l * 31 + j) * 384 + c];
      float i3 = inl[(j + 3) * NT];
      o[0] += wj * i0; o[1] += wj * i1; o[2] += wj * i2; o[3] += wj * i3;
      i0 = i1; i1 = i2; i2 = i3;
    }
#pragma unroll
    for (int t = 0; t < 4; t++) { rv[t] = o[t]; rv[4 + t] = o[t] * o[t]; }
    const float* sb = p.state_b + ((size_t)(l * 128 + n) * 2) * 384 + c;
    zin[0] = sb[0]; zin[1] = sb[384];
#pragma unroll
    for (int t = 0; t < 4; t++) zin[2 + t] = bf2f(inter[(Rs + t) * IW + 768 + c]);
  }
  if (c < 256) {
#pragma unroll
    for (int t = 0; t < 4; t++) {
      cvv[t] = bf2f(inter[(Rs + t) * IW + 1792 + c]);
      rv[8 + t] = cvv[t];
      rv[12 + t] = cvv[t] * cvv[t];
    }
  }
#pragma unroll
  for (int i = 0; i < 16; i++) {
#pragma unroll
    for (int m = 32; m >= 1; m >>= 1) rv[i] += __shfl_xor(rv[i], m);
  }
  if (lane == 0) {
#pragma unroll
    for (int i = 0; i < 16; i++) red[w * 16 + i] = rv[i];
  }
  __syncthreads();
#pragma unroll
  for (int i = 0; i < 16; i++) {
    float s = 0.f;
#pragma unroll
    for (int ww = 0; ww < 8; ww++) s += red[ww * 16 + i];
    rv[i] = s;
  }
  if (c < 384) {
    const float g = p.a_ln_g[l * 384 + c], bb = p.a_ln_b[l * 384 + c];
    const float w0 = p.b_conv_w[(l * 3 + 0) * 384 + c], w1 = p.b_conv_w[(l * 3 + 1) * 384 + c], w2 = p.b_conv_w[(l * 3 + 2) * 384 + c];
#pragma unroll
    for (int t = 0; t < 4; t++) {
      float m_ = rv[t] * (1.f / 384.f);
      float var = rv[4 + t] * (1.f / 384.f) - m_ * m_;
      float rstd = rsqrtf(fmaxf(var, 0.f) + EPS);
      float y = (o[t] - m_) * rstd * g + bb;
      float ya = siluf_(y) * bf2f(inter[(Rs + t) * IW + 384 + c]);
      p.mix[(Rs + t) * DM + c] = f2bf(ya);
      float cv = w0 * zin[t] + w1 * zin[t + 1] + w2 * zin[t + 2];
      float yb = bf2f(inter[(Rs + t) * IW + 1152 + c]) * cv;
      p.mix[(Rs + t) * DM + 384 + c] = f2bf(yb);
    }
    p.out[O_SBS + ((size_t)(l * 128 + n) * 2 + 0) * 384 + c] = zin[4];
    p.out[O_SBS + ((size_t)(l * 128 + n) * 2 + 1) * 384 + c] = zin[5];
  }
  if (c < 256) {
    const float g = p.c_ln_g[l * 256 + c], bb = p.c_ln_b[l * 256 + c];
    const int h = c >> 6;
    float vn[4];
#pragma unroll
    for (int t = 0; t < 4; t++) {
      float m_ = rv[8 + t] * (1.f / 256.f);
      float var = rv[12 + t] * (1.f / 256.f) - m_ * m_;
      float rstd = rsqrtf(fmaxf(var, 0.f) + EPS);
      vn[t] = (cvv[t] - m_) * rstd * g + bb;
      p.out[O_SCV + ((size_t)(l * 128 + n) * 4 + t) * 256 + c] = vn[t];
    }
#pragma unroll
    for (int t = 0; t < 4; t++) {
      float acc = p.c_bs[(l * 4 + h) * 128 + t];
#pragma unroll
      for (int s = 0; s < 4; s++)
        if (s <= t) acc += p.c_ws[((size_t)(l * 4 + h) * 128 + t) * 128 + s] * vn[s];
      float yc = bf2f(inter[(Rs + t) * IW + 1536 + c]) * acc;
      p.mix[(Rs + t) * DM + 768 + c] = f2bf(yc);
    }
  }
  __syncthreads();
}

__device__ void phase2(const Params& p, int l, char* smem) {
  float* red = (float*)(smem + 90112);
  const int nb = gridDim.x, b = blockIdx.x;
  p2_stage_w(p, l, smem);
  for (int it = b; it < 512; it += nb) {
    asm volatile("" ::: "memory");
    p2_ab(p, l, it, smem);
  }
  for (int it = b; it < 128; it += nb) {
    asm volatile("" ::: "memory");
    p2_c(p, l, it, smem);
  }
  for (int it = (b + nb - (128 % nb)) % nb; it < 128; it += nb) {
    asm volatile("" ::: "memory");
    p2_s(p, l, it, red, (float*)smem);
  }
}

__device__ void phase4(const Params& p) {
  const int tid = otid();
  const float* ssq = p.sumsq + (size_t)2 * NTOK;
  for (int idx = blockIdx.x * NT + tid; idx < NTOK * 128; idx += gridDim.x * NT) {
    const int row = idx >> 7, c8 = idx & 127;
    uint4 v = *(const uint4*)(p.xb + (size_t)row * DM + c8 * 8);
    const float rs = rsqrtf(ssq[row] * (1.f / 1024.f) + EPS);
    float4 g0 = *(const float4*)(p.final_g + c8 * 8), g1 = *(const float4*)(p.final_g + c8 * 8 + 4);
    float f[8];
    unpack8(v, f);
    float* o = p.out + (size_t)row * DM + c8 * 8;
    *(float4*)o = make_float4(f[0] * rs * g0.x, f[1] * rs * g0.y, f[2] * rs * g0.z, f[3] * rs * g0.w);
    *(float4*)(o + 4) = make_float4(f[4] * rs * g1.x, f[5] * rs * g1.y, f[6] * rs * g1.z, f[7] * rs * g1.w);
  }
}

__global__ void __launch_bounds__(NT) fwd_megakernel(Params p) {
  extern __shared__ __attribute__((aligned(16))) char smem[];
  __shared__ uint4 xb_words;
  if (threadIdx.x == 0) xb_words = make_uint4(0u, 0u, 0u, 0u);
  __syncthreads();
  XcdBarrier gb = xcd_barrier_post(p.bar, (volatile LAS unsigned*)&xb_words);
  phase0(p, smem);
  xcd_barrier(gb);
#pragma unroll 1
  for (int l = 0; l < 2; l++) {
    phase1(p, l, smem);
    xcd_barrier(gb);
    phase2(p, l, smem);
    xcd_barrier(gb);
    phase3(p, l, smem);
    xcd_barrier(gb);
  }
  phase4(p);
}

extern "C" void kernel_launch(void* const* d_in, const int* in_sizes, int n_in, void* d_out, int out_size, void* d_ws,
                              size_t ws_size, hipStream_t stream) {
  static int grid_blocks = 0;
  if (!grid_blocks) {
    int dev = 0, cus = 0, per_cu = 0;
    hipGetDevice(&dev);
    hipDeviceGetAttribute(&cus, hipDeviceAttributeMultiprocessorCount, dev);
    hipFuncSetAttribute((const void*)fwd_megakernel, hipFuncAttributeMaxDynamicSharedMemorySize, LDS_BYTES);
    hipOccupancyMaxActiveBlocksPerMultiprocessor(&per_cu, (const void*)fwd_megakernel, NT, LDS_BYTES);
    if (per_cu < 1) { fprintf(stderr, "occupancy query returned %d\n", per_cu); per_cu = 1; }
    if (per_cu > 1) per_cu = 1;
    grid_blocks = cus * per_cu;
  }
  Params p{};
  p.x_prompt = (const float*)d_in[0];
  p.x_sample = (const float*)d_in[1];
  p.state_a = (const float*)d_in[2];
  p.state_b = (const float*)d_in[3];
  p.norm_g = (const float*)d_in[4];
  p.w_in = (const float*)d_in[5];
  p.a_conv_w = (const float*)d_in[6];
  p.a_conv_b = (const float*)d_in[7];
  p.a_ln_g = (const float*)d_in[8];
  p.a_ln_b = (const float*)d_in[9];
  p.b_conv_w = (const float*)d_in[10];
  p.c_ln_g = (const float*)d_in[11];
  p.c_ln_b = (const float*)d_in[12];
  p.c_ws = (const float*)d_in[13];
  p.c_bs = (const float*)d_in[14];
  p.w_out = (const float*)d_in[15];
  p.final_g = (const float*)d_in[16];
  p.out = (float*)d_out;
  char* ws = (char*)d_ws;
  size_t off = 0;
  auto take = [&](size_t bytes) { char* r = ws + off; off += (bytes + 255) & ~(size_t)255; return r; };
  p.win_b = (u16*)take((size_t)2 * INW * DM * 2);
  p.wout_b = (u16*)take((size_t)2 * DM * DM * 2);
  p.wc_b = (u16*)take((size_t)2 * 4 * 128 * 128 * 2);
  p.xb = (u16*)take((size_t)NTOK * DM * 2);
  p.inter = (u16*)take((size_t)NTOK * IW * 2);
  p.mix = (u16*)take((size_t)NTOK * DM * 2);
  p.sumsq = (float*)take((size_t)3 * NTOK * 4);
  p.rsw = (float*)take((size_t)2 * 4 * 128 * 4);
  p.bar = (unsigned*)take((size_t)XCD_BAR_WORDS * 4);
  hipMemsetAsync(p.bar, 0, (size_t)XCD_BAR_WORDS * 4, stream);
  void* args[] = {&p};
  hipError_t e = hipLaunchCooperativeKernel((const void*)fwd_megakernel, dim3(grid_blocks), dim3(NT), args, LDS_BYTES, stream);
  if (e != hipSuccess) fprintf(stderr, "cooperative launch failed: %s (grid %d)\n", hipGetErrorString(e), grid_blocks);
}
```

```cpp
#include <hip/hip_runtime.h>
#include <cstdio>
#include <cstdint>

typedef unsigned short u16;
typedef short bf16x8 __attribute__((ext_vector_type(8)));
typedef float f32x16 __attribute__((ext_vector_type(16)));
typedef unsigned int u32x4 __attribute__((ext_vector_type(4)));

constexpr int NTOK = 16896, NPR = 16384, DM = 1024, INW = 3456, IW = 2048;
constexpr int NT = 512;
constexpr int LDS_BYTES = 131072;
constexpr float EPS = 1e-6f;

constexpr size_t O_SAP = 17301504, O_SBP = 17485824, O_SAS = 17498112, O_SBS = 20447232, O_SCV = 20643840;

struct Params {
  const float *x_prompt, *x_sample, *state_a, *state_b, *norm_g, *w_in, *a_conv_w, *a_conv_b, *a_ln_g, *a_ln_b,
      *b_conv_w, *c_ln_g, *c_ln_b, *c_ws, *c_bs, *w_out, *final_g;
  float* out;
  u16 *win_b, *wout_b, *wc_b, *xb, *inter, *mix;
  float *sumsq, *rsw;
  unsigned* bar;
};

__device__ __forceinline__ u16 f2bf(float f) {
  unsigned u = __float_as_uint(f);
  u += 0x7fffu + ((u >> 16) & 1u);
  return (u16)(u >> 16);
}
__device__ __forceinline__ float bf2f(u16 h) { return __uint_as_float(((unsigned)h) << 16); }
__device__ __forceinline__ unsigned pack2(float a, float b) { return (unsigned)f2bf(a) | ((unsigned)f2bf(b) << 16); }
__device__ __forceinline__ float sigmoidf_(float x) { return 1.f / (1.f + __expf(-x)); }
__device__ __forceinline__ float siluf_(float x) { return x / (1.f + __expf(-x)); }

__device__ __forceinline__ void unpack8(const uint4& v, float (&f)[8]) {
  f[0] = __uint_as_float(v.x << 16); f[1] = __uint_as_float(v.x & 0xffff0000u);
  f[2] = __uint_as_float(v.y << 16); f[3] = __uint_as_float(v.y & 0xffff0000u);
  f[4] = __uint_as_float(v.z << 16); f[5] = __uint_as_float(v.z & 0xffff0000u);
  f[6] = __uint_as_float(v.w << 16); f[7] = __uint_as_float(v.w & 0xffff0000u);
}
__device__ __forceinline__ uint4 pack8(const float (&f)[8]) {
  uint4 o;
  o.x = pack2(f[0], f[1]); o.y = pack2(f[2], f[3]); o.z = pack2(f[4], f[5]); o.w = pack2(f[6], f[7]);
  return o;
}

__device__ __forceinline__ int otid() {
  int t = threadIdx.x;
  asm volatile("" : "+v"(t));
  return t;
}

__device__ __forceinline__ int vcol_src(int vc) {
  int j = vc >> 7, v = vc & 127;
  int wn = v >> 6, ni = (v >> 5) & 1, l32 = v & 31;
  int chp = wn * 32 + l32;
  if (j < 6) return (ni ? 384 : 0) + j * 64 + chp;
  if (j < 9) return 768 + (j - 6) * 128 + v;
  if (j < 15) return (ni ? 1920 : 1152) + (j - 9) * 64 + chp;
  if (j < 21) return (ni ? 2304 : 1536) + (j - 15) * 64 + chp;
  if (j < 25) return (ni ? 3200 : 2688) + (j - 21) * 64 + chp;
  return 2944 + (j - 25) * 128 + v;
}


#define XB_TMO      128
#define XB_XCNT(j)  (256  + 64 * (j))
#define XB_XSUB(j)  (1280 + 64 * (j))
#define XB_XGEN(j)  (2304 + 64 * (j))
#define XB_TOP      3328
#define XB_TOPGEN   3392
#define XCD_BAR_WORDS 3456
#define XB_SPIN_CAP (1u << 18)
#define LAS __attribute__((address_space(3)))

__device__ __forceinline__ unsigned xb_ld(unsigned* p)              { return __hip_atomic_load(p, __ATOMIC_RELAXED, __HIP_MEMORY_SCOPE_AGENT); }
__device__ __forceinline__ unsigned xb_add(unsigned* p, unsigned v) { return __hip_atomic_fetch_add(p, v, __ATOMIC_RELAXED, __HIP_MEMORY_SCOPE_AGENT); }
__device__ __forceinline__ unsigned xb_xcc_id() { return (unsigned)__builtin_amdgcn_s_getreg((3 << 11) | 20) & 0xFu; }
#define XB_SPIN(cond, bar) do { unsigned _sp = 0; while (cond) { __builtin_amdgcn_s_sleep(1); \
    if ((++_sp & 255u) == 0u) { if (xb_ld(&(bar)[XB_TMO])) break; if (_sp > XB_SPIN_CAP) { atomicAdd(&(bar)[XB_TMO], 1u); break; } } } } while (0)

struct XcdBarrier {
  unsigned* bar; unsigned x;
  volatile LAS unsigned* st;
};
__device__ __forceinline__ XcdBarrier xcd_barrier_post(unsigned* bar, volatile LAS unsigned* st) {
  XcdBarrier b; b.bar = bar; b.x = xb_xcc_id(); b.st = st;
  if (threadIdx.x == 0) (void)xb_add(&bar[XB_XCNT(b.x)], 1u);
  return b;
}
__device__ __forceinline__ void xcd_barrier_complete(unsigned* bar, unsigned x, unsigned& nloc, unsigned& nx) {
  const unsigned G = gridDim.x * gridDim.y * gridDim.z;
  unsigned sum, cnt, mine, sp = 0u;
  for (;;) {
    sum = 0u; cnt = 0u; mine = 0u;
#pragma unroll
    for (unsigned j = 0; j < 16; ++j) { const unsigned c = xb_ld(&bar[XB_XCNT(j)]); sum += c; cnt += (c > 0u) ? 1u : 0u; mine = (j == x) ? c : mine; }
    if (sum == G) break;
    __builtin_amdgcn_s_sleep(1);
    if ((++sp & 255u) == 0u) { if (xb_ld(&bar[XB_TMO])) break; if (sp > XB_SPIN_CAP) { atomicAdd(&bar[XB_TMO], 1u); break; } }
  }
  nloc = mine > 0u ? mine : 1u; nx = cnt > 0u ? cnt : 1u;
}
__device__ __forceinline__ void xcd_barrier(const XcdBarrier& b) {
  asm volatile("s_waitcnt vmcnt(0)" ::: "memory");
  __syncthreads();
  if (threadIdx.x == 0) {
    unsigned* bar = b.bar;
    __builtin_amdgcn_s_waitcnt(0);
    unsigned nloc = b.st[0], nx = b.st[1];
    if (nloc == 0u) { xcd_barrier_complete(bar, b.x, nloc, nx); b.st[0] = nloc; b.st[1] = nx; }
    const unsigned old = xb_add(&bar[XB_XSUB(b.x)], 1u);
    const unsigned gen = old / nloc;
    if (old + 1u == (gen + 1u) * nloc) {
      __builtin_amdgcn_fence(__ATOMIC_RELEASE, "agent");
      asm volatile("s_waitcnt vmcnt(0)" ::: "memory");
      const unsigned og = xb_add(&bar[XB_TOP], 1u);
      const unsigned tg = og / nx;
      if (og + 1u == (tg + 1u) * nx) xb_add(&bar[XB_TOPGEN], 1u);
      else XB_SPIN(xb_ld(&bar[XB_TOPGEN]) == tg, bar);
      __builtin_amdgcn_fence(__ATOMIC_ACQUIRE, "agent");
      xb_add(&bar[XB_XGEN(b.x)], 1u);
      asm volatile("s_waitcnt vmcnt(0)" ::: "memory");
    } else {
      XB_SPIN(xb_ld(&bar[XB_XGEN(b.x)]) == gen, bar);
      __builtin_amdgcn_fence(__ATOMIC_ACQUIRE, "agent");
      asm volatile("s_waitcnt vmcnt(0)" ::: "memory");
    }
  }
  __syncthreads();
}

__device__ void p0_transpose(const float* __restrict__ W, int ncols, const float* __restrict__ g, u16* __restrict__ outp,
                             int k0, int v0, bool mapv, float* tile) {
  int tid = otid();
#pragma unroll
  for (int i = 0; i < 8; i++) {
    int e = tid + i * NT;
    int kk = e >> 6, v = e & 63;
    int src = mapv ? vcol_src(v0 + v) : (v0 + v);
    float val = W[(size_t)(k0 + kk) * ncols + src];
    if (g) val *= g[k0 + kk];
    tile[kk * 65 + v] = val;
  }
  __syncthreads();
  {
    int v = tid >> 3, kq = tid & 7;
    const float* tp = tile + (kq * 8) * 65 + v;
    uint4 o;
    o.x = pack2(tp[0], tp[65]);
    o.y = pack2(tp[2 * 65], tp[3 * 65]);
    o.z = pack2(tp[4 * 65], tp[5 * 65]);
    o.w = pack2(tp[6 * 65], tp[7 * 65]);
    *(uint4*)(outp + (size_t)(v0 + v) * 1024 + k0 + kq * 8) = o;
  }
  __syncthreads();
}

__device__ void phase0(const Params& p, char* smem) {
  float* tile = (float*)smem;
  int nb = gridDim.x, b = blockIdx.x, tid = otid();
  for (int it = b; it < 2 * 16 * 54; it += nb) {
    int l = it / (16 * 54), rem = it % (16 * 54);
    int kb = rem / 54, vb = rem % 54;
    p0_transpose(p.w_in + (size_t)l * DM * INW, INW, p.norm_g + l * DM, p.win_b + (size_t)l * INW * DM, kb * 64, vb * 64, true, tile);
  }
  for (int it = b; it < 2 * 16 * 16; it += nb) {
    int l = it >> 8, rem = it & 255;
    int kb = rem >> 4, vb = rem & 15;
    p0_transpose(p.w_out + (size_t)l * DM * DM, DM, nullptr, p.wout_b + (size_t)l * DM * DM, kb * 64, vb * 64, false, tile);
  }
  for (int e = b * NT + tid; e < 2 * 4 * 128 * 128; e += nb * NT) {
    int s = e & 127, t = (e >> 7) & 127;
    p.wc_b[e] = (s <= t) ? f2bf(p.c_ws[e]) : (u16)0;
  }
  for (int e = b * NT + tid; e < 2 * NTOK; e += nb * NT) p.sumsq[NTOK + e] = 0.f;
  for (int e = b * NT + tid; e < 2 * 4 * 128; e += nb * NT) {
    int t = e & 127;
    const float* wr = p.c_ws + (size_t)e * 128;
    float s = 0.f;
    for (int k = 0; k <= t; k++) s += bf2f(f2bf(wr[k]));
    p.rsw[e] = s;
  }
  int wave = tid >> 6, lane = tid & 63;
  for (int row = b * 8 + wave; row < NTOK; row += nb * 8) {
    const float* xr = (row < NPR) ? (p.x_prompt + (size_t)row * DM) : (p.x_sample + (size_t)(row - NPR) * DM);
    float ss = 0.f;
#pragma unroll
    for (int j = 0; j < 4; j++) {
      float4 v = *(const float4*)(xr + (j * 64 + lane) * 4);
      ss += v.x * v.x + v.y * v.y + v.z * v.z + v.w * v.w;
      uint2 o;
      o.x = pack2(v.x, v.y);
      o.y = pack2(v.z, v.w);
      *(uint2*)(p.xb + (size_t)row * DM + (j * 64 + lane) * 4) = o;
    }
#pragma unroll
    for (int m = 32; m >= 1; m >>= 1) ss += __shfl_xor(ss, m);
    if (lane == 0) p.sumsq[row] = ss;
  }
}

__device__ __forceinline__ void gemm_mainloop(const u16* __restrict__ Ag, const u16* __restrict__ Bg, char* smem,
                                              f32x16 (&acc)[2][2]) {
  const int tid = otid();
  const int lane = tid & 63, w = tid >> 6;
  const int wm = w >> 1, wn = w & 1;
  const int l32 = lane & 31, lh = lane >> 5;
  const int sr = tid >> 3, sc = tid & 7;
  const int st_off = sr * 128 + ((sc ^ ((sr >> 1) & 7)) << 4);
  const u16* ag = Ag + (size_t)sr * DM + sc * 8;
  const u16* bg = Bg + (size_t)sr * DM + sc * 8;
  const int fsw = (l32 >> 1) & 7;
  const int a_off = (wm * 64 + l32) * 128;
  const int b_off = 32768 + (wn * 64 + l32) * 128;

  struct Stage { u32x4 a0, a1, a2, a3, b0, b1; };
  Stage s0, s1;
  auto LOADT = [&](Stage& S, int KT) {
    S.a0 = *(const u32x4*)(ag + KT * 64);
    S.a1 = *(const u32x4*)(ag + (size_t)64 * DM + KT * 64);
    S.a2 = *(const u32x4*)(ag + (size_t)128 * DM + KT * 64);
    S.a3 = *(const u32x4*)(ag + (size_t)192 * DM + KT * 64);
    S.b0 = *(const u32x4*)(bg + KT * 64);
    S.b1 = *(const u32x4*)(bg + (size_t)64 * DM + KT * 64);
  };
  auto STORET = [&](const Stage& S, char* BUF) {
    *(u32x4*)(BUF + st_off) = S.a0;
    *(u32x4*)(BUF + st_off + 8192) = S.a1;
    *(u32x4*)(BUF + st_off + 16384) = S.a2;
    *(u32x4*)(BUF + st_off + 24576) = S.a3;
    *(u32x4*)(BUF + 32768 + st_off) = S.b0;
    *(u32x4*)(BUF + 32768 + st_off + 8192) = S.b1;
  };
  auto COMPUTET = [&](const char* CUR) {
#pragma unroll
    for (int kk = 0; kk < 4; kk++) {
      const int co = ((kk * 2 + lh) ^ fsw) << 4;
      bf16x8 a0 = *(const bf16x8*)(CUR + a_off + co);
      bf16x8 a1 = *(const bf16x8*)(CUR + a_off + 32 * 128 + co);
      bf16x8 b0 = *(const bf16x8*)(CUR + b_off + co);
      bf16x8 b1 = *(const bf16x8*)(CUR + b_off + 32 * 128 + co);
      acc[0][0] = __builtin_amdgcn_mfma_f32_32x32x16_bf16(b0, a0, acc[0][0], 0, 0, 0);
      acc[0][1] = __builtin_amdgcn_mfma_f32_32x32x16_bf16(b1, a0, acc[0][1], 0, 0, 0);
      acc[1][0] = __builtin_amdgcn_mfma_f32_32x32x16_bf16(b0, a1, acc[1][0], 0, 0, 0);
      acc[1][1] = __builtin_amdgcn_mfma_f32_32x32x16_bf16(b1, a1, acc[1][1], 0, 0, 0);
    }
  };
  char* buf0 = smem;
  char* buf1 = smem + 49152;
  LOADT(s0, 0);
  LOADT(s1, 1);
  STORET(s0, buf0);
  __syncthreads();
#pragma unroll 1
  for (int kt = 0; kt < 16; kt += 2) {
    if (kt + 2 < 16) LOADT(s0, kt + 2);
    COMPUTET(buf0);
    STORET(s1, buf1);
    __syncthreads();
    if (kt + 3 < 16) LOADT(s1, kt + 3);
    COMPUTET(buf1);
    if (kt + 2 < 16) STORET(s0, buf0);
    __syncthreads();
  }
}

__device__ __forceinline__ bool next_tile(int& u, int ntiles, int& T) {
  int nb = gridDim.x, b = blockIdx.x;
  if ((nb & 7) == 0) {
    int per = (ntiles + 7) >> 3;
    int x = b & 7, nslots = nb >> 3;
    while (true) {
      if (u >= per) return false;
      T = x * per + u;
      u += nslots;
      if (T < ntiles) return true;
    }
  } else {
    if (u >= ntiles) return false;
    T = u;
    u += nb;
    return true;
  }
}
__device__ __forceinline__ int first_u() {
  return ((gridDim.x & 7) == 0) ? (int)(blockIdx.x >> 3) : (int)blockIdx.x;
}

__device__ void phase1(const Params& p, int l, char* smem) {
  const int tid = otid();
  const int lane = tid & 63, w = tid >> 6;
  const int wm = w >> 1, wn = w & 1;
  const int l32 = lane & 31, lh = lane >> 5;
  const float* ssq = p.sumsq + (size_t)l * NTOK;
  int u = first_u(), T;
  while (next_tile(u, 66 * 27, T)) {
    int rb = T / 27, j = T - rb * 27;
    int row0 = rb * 256;
    f32x16 acc[2][2];
#pragma unroll
    for (int a = 0; a < 2; a++)
#pragma unroll
      for (int c = 0; c < 2; c++)
#pragma unroll
        for (int r = 0; r < 16; r++) acc[a][c][r] = 0.f;
    gemm_mainloop(p.xb + (size_t)row0 * DM, p.win_b + ((size_t)l * INW + (size_t)j * 128) * DM, smem, acc);
    int kind, ob;
    if (j < 6) { kind = 0; ob = j * 64; }
    else if (j < 9) { kind = 1; ob = 384 + (j - 6) * 128; }
    else if (j < 15) { kind = 2; ob = 768 + (j - 9) * 64; }
    else if (j < 21) { kind = 3; ob = 1152 + (j - 15) * 64; }
    else if (j < 25) { kind = 3; ob = 1536 + (j - 21) * 64; }
    else { kind = 4; ob = 1792 + (j - 25) * 128; }
    const bool paired = (kind == 0 || kind == 2 || kind == 3);
    const int rowb = paired ? 144 : 272;
#pragma unroll
    for (int mi = 0; mi < 2; mi++) {
      const int m = wm * 64 + mi * 32 + l32;
      const float rs = rsqrtf(ssq[row0 + m] * (1.f / 1024.f) + EPS);
#pragma unroll
      for (int g = 0; g < 4; g++) {
        float r0[4], r1[4];
#pragma unroll
        for (int i = 0; i < 4; i++) {
          float v0 = acc[mi][0][4 * g + i] * rs, v1 = acc[mi][1][4 * g + i] * rs;
          if (kind == 0) r0[i] = v0 * sigmoidf_(v1);
          else if (kind == 2) r0[i] = v0 * v1;
          else if (kind == 3) r0[i] = v0 * siluf_(v1);
          else if (kind == 1) { r0[i] = siluf_(v0); r1[i] = siluf_(v1); }
          else { r0[i] = v0; r1[i] = v1; }
        }
        const int chl = 8 * g + 4 * lh;
        if (paired) {
          *(uint2*)(smem + m * 144 + (wn * 32 + chl) * 2) = make_uint2(pack2(r0[0], r0[1]), pack2(r0[2], r0[3]));
        } else {
          *(uint2*)(smem + m * 272 + (wn * 64 + chl) * 2) = make_uint2(pack2(r0[0], r0[1]), pack2(r0[2], r0[3]));
          *(uint2*)(smem + m * 272 + (wn * 64 + 32 + chl) * 2) = make_uint2(pack2(r1[0], r1[1]), pack2(r1[2], r1[3]));
        }
      }
    }
    __syncthreads();
    if (paired) {
#pragma unroll
      for (int i = 0; i < 4; i++) {
        int q = tid + i * NT, m = q >> 3, c = q & 7;
        uint4 v = *(const uint4*)(smem + m * 144 + c * 16);
        *(uint4*)(p.inter + (size_t)(row0 + m) * IW + ob + c * 8) = v;
      }
    } else {
#pragma unroll
      for (int i = 0; i < 8; i++) {
        int q = tid + i * NT, m = q >> 4, c = q & 15;
        uint4 v = *(const uint4*)(smem + m * 272 + c * 16);
        *(uint4*)(p.inter + (size_t)(row0 + m) * IW + ob + c * 8) = v;
      }
    }
    (void)rowb;
    __syncthreads();
  }
}

__device__ void phase3(const Params& p, int l, char* smem) {
  const int tid = otid();
  const int lane = tid & 63, w = tid >> 6;
  const int wm = w >> 1, wn = w & 1;
  const int l32 = lane & 31, lh = lane >> 5;
  int u = first_u(), T;
  while (next_tile(u, 66 * 8, T)) {
    int rb = T >> 3, j = T & 7;
    int row0 = rb * 256, col0 = j * 128;
    f32x16 acc[2][2];
#pragma unroll
    for (int a = 0; a < 2; a++)
#pragma unroll
      for (int c = 0; c < 2; c++)
#pragma unroll
        for (int r = 0; r < 16; r++) acc[a][c][r] = 0.f;
    gemm_mainloop(p.mix + (size_t)row0 * DM, p.wout_b + ((size_t)l * DM + col0) * DM, smem, acc);
    float* ssq = p.sumsq + (size_t)(l + 1) * NTOK;
#pragma unroll
    for (int mi = 0; mi < 2; mi++) {
      const int m = wm * 64 + mi * 32 + l32;
      const u16* xr = p.xb + (size_t)(row0 + m) * DM + col0 + wn * 64;
      uint2 xo[2][4];
#pragma unroll
      for (int ni = 0; ni < 2; ni++)
#pragma unroll
        for (int g = 0; g < 4; g++) xo[ni][g] = *(const uint2*)(xr + ni * 32 + 8 * g + 4 * lh);
      float ss = 0.f;
#pragma unroll
      for (int ni = 0; ni < 2; ni++) {
#pragma unroll
        for (int g = 0; g < 4; g++) {
          float v0 = __uint_as_float(xo[ni][g].x << 16) + acc[mi][ni][4 * g + 0];
          float v1 = __uint_as_float(xo[ni][g].x & 0xffff0000u) + acc[mi][ni][4 * g + 1];
          float v2 = __uint_as_float(xo[ni][g].y << 16) + acc[mi][ni][4 * g + 2];
          float v3 = __uint_as_float(xo[ni][g].y & 0xffff0000u) + acc[mi][ni][4 * g + 3];
          ss += v0 * v0 + v1 * v1 + v2 * v2 + v3 * v3;
          *(uint2*)(smem + m * 272 + (wn * 64 + ni * 32 + 8 * g + 4 * lh) * 2) = make_uint2(pack2(v0, v1), pack2(v2, v3));
        }
      }
      ss += __shfl_xor(ss, 32);
      if (lh == 0) atomicAdd(ssq + row0 + m, ss);
    }
    __syncthreads();
#pragma unroll
    for (int i = 0; i < 8; i++) {
      int q = tid + i * NT, m = q >> 4, c = q & 15;
      uint4 v = *(const uint4*)(smem + m * 272 + c * 16);
      *(uint4*)(p.xb + (size_t)(row0 + m) * DM + col0 + c * 8) = v;
    }
    __syncthreads();
  }
}

__device__ void p2_stage_w(const Params& p, int l, char* smem) {
  const int tid = otid();
  const float4* src = (const float4*)(p.a_conv_w + (size_t)l * 31 * 384);
  for (int f = tid; f < 36 * 96; f += NT) {
    int j = f / 96, q = f - j * 96;
    float4 v = make_float4(0.f, 0.f, 0.f, 0.f);
    if (j < 31) v = src[f];
    ((float4*)smem)[(j * 2 + (q & 1)) * 48 + (q >> 1)] = v;
  }
}

__device__ void p2_ab(const Params& p, int l, int it, char* smem) {
  const int tid = otid();
  const int lane = tid & 63, w = tid >> 6;
  const bool active = lane < 48;
  const int o = active ? lane : 47;
  const int R0 = it * 32;
  const int spos = R0 & 2047;
  const int bseq = R0 >> 11;
  const bool last = (spos == 2016);
  const u16* __restrict__ inter = p.inter;
  char* atile = smem + 55296;
  const float4* wts = (const float4*)smem;
  uint4 st[6];
#pragma unroll
  for (int i = 0; i < 6; i++) {
    int e = tid + i * NT;
    st[i] = make_uint4(0, 0, 0, 0);
    {
      int r = e / 48, ch = e - r * 48;
      if (r < 62 && spos - 30 + r >= 0) st[i] = *(const uint4*)(inter + (size_t)(R0 - 30 + r) * IW + ch * 8);
    }
  }
  const size_t rowq = (size_t)R0 + 4 * w;
  uint4 szv[4], gbv[4], zv[6];
#pragma unroll
  for (int t = 0; t < 4; t++) {
    szv[t] = *(const uint4*)(inter + (rowq + t) * IW + 384 + 8 * o);
    gbv[t] = *(const uint4*)(inter + (rowq + t) * IW + 1152 + 8 * o);
  }
#pragma unroll
  for (int s2 = 0; s2 < 6; s2++) {
    zv[s2] = make_uint4(0, 0, 0, 0);
    if (spos + 4 * w - 2 + s2 >= 0) zv[s2] = *(const uint4*)(inter + (rowq - 2 + s2) * IW + 768 + 8 * o);
  }
#pragma unroll
  for (int i = 0; i < 6; i++) {
    int e = tid + i * NT;
    *(uint4*)(atile + e * 16) = st[i];
  }
  __syncthreads();
  float acc[4][8];
  {
    float4 b0 = *(const float4*)(p.a_conv_b + l * 384 + 8 * o), b1 = *(const float4*)(p.a_conv_b + l * 384 + 8 * o + 4);
#pragma unroll
    for (int t = 0; t < 4; t++) {
      acc[t][0] = b0.x; acc[t][1] = b0.y; acc[t][2] = b0.z; acc[t][3] = b0.w;
      acc[t][4] = b1.x; acc[t][5] = b1.y; acc[t][6] = b1.z; acc[t][7] = b1.w;
    }
  }
  float wwin[4][8];
#pragma unroll
  for (int u = 0; u < 4; u++)
#pragma unroll
    for (int c = 0; c < 8; c++) wwin[u][c] = 0.f;
  const char* arow = atile + (4 * w) * 768 + o * 16;
#pragma unroll 1
  for (int s4 = 0; s4 < 36; s4 += 4) {
    const char* ar = arow + s4 * 768;
    const float4* wr = wts + (s4 * 2) * 48 + o;
#pragma unroll
    for (int u = 0; u < 4; u++) {
      uint4 av = *(const uint4*)(ar + u * 768);
      float4 wa = wr[(u * 2) * 48], wb = wr[(u * 2 + 1) * 48];
      float v[8];
      unpack8(av, v);
      wwin[u][0] = wa.x; wwin[u][1] = wa.y; wwin[u][2] = wa.z; wwin[u][3] = wa.w;
      wwin[u][4] = wb.x; wwin[u][5] = wb.y; wwin[u][6] = wb.z; wwin[u][7] = wb.w;
#pragma unroll
      for (int t = 0; t < 4; t++) {
#pragma unroll
        for (int c = 0; c < 8; c++) acc[t][c] += wwin[(u - t) & 3][c] * v[c];
      }
    }
  }
  if (last && active) {
#pragma unroll
    for (int t = 0; t < 4; t++) {
      int pp = spos + 4 * w + t;
      if (pp >= 2018) {
        float v[8];
        unpack8(*(const uint4*)(arow + (30 + t) * 768), v);
        float* so = p.out + O_SAP + ((size_t)(l * 8 + bseq) * 30 + (pp - 2018)) * 384 + 8 * o;
        *(float4*)so = make_float4(v[0], v[1], v[2], v[3]);
        *(float4*)(so + 4) = make_float4(v[4], v[5], v[6], v[7]);
      }
    }
  }
  float s1[4], s2[4];
#pragma unroll
  for (int t = 0; t < 4; t++) {
    float a = 0.f, b = 0.f;
#pragma unroll
    for (int c = 0; c < 8; c++) { a += acc[t][c]; b += acc[t][c] * acc[t][c]; }
    s1[t] = active ? a : 0.f;
    s2[t] = active ? b : 0.f;
  }
#pragma unroll
  for (int t = 0; t < 4; t++) {
#pragma unroll
    for (int m = 32; m >= 1; m >>= 1) { s1[t] += __shfl_xor(s1[t], m); s2[t] += __shfl_xor(s2[t], m); }
  }
  {
    float g8[8], b8[8];
    {
      float4 a0 = *(const float4*)(p.a_ln_g + l * 384 + 8 * o), a1 = *(const float4*)(p.a_ln_g + l * 384 + 8 * o + 4);
      float4 c0 = *(const float4*)(p.a_ln_b + l * 384 + 8 * o), c1 = *(const float4*)(p.a_ln_b + l * 384 + 8 * o + 4);
      g8[0] = a0.x; g8[1] = a0.y; g8[2] = a0.z; g8[3] = a0.w; g8[4] = a1.x; g8[5] = a1.y; g8[6] = a1.z; g8[7] = a1.w;
      b8[0] = c0.x; b8[1] = c0.y; b8[2] = c0.z; b8[3] = c0.w; b8[4] = c1.x; b8[5] = c1.y; b8[6] = c1.z; b8[7] = c1.w;
    }
#pragma unroll
    for (int t = 0; t < 4; t++) {
      float mu = s1[t] * (1.f / 384.f);
      float var = s2[t] * (1.f / 384.f) - mu * mu;
      float rstd = rsqrtf(fmaxf(var, 0.f) + EPS);
      float sz[8], y[8];
      unpack8(szv[t], sz);
#pragma unroll
      for (int c = 0; c < 8; c++) y[c] = siluf_((acc[t][c] - mu) * rstd * g8[c] + b8[c]) * sz[c];
      if (active) *(uint4*)(p.mix + (rowq + t) * DM + 8 * o) = pack8(y);
    }
  }
  {
    float w0[8], w1[8], w2[8];
    {
      const float* bw = p.b_conv_w + (size_t)l * 3 * 384 + 8 * o;
      float4 a0 = *(const float4*)(bw), a1 = *(const float4*)(bw + 4);
      float4 c0 = *(const float4*)(bw + 384), c1 = *(const float4*)(bw + 384 + 4);
      float4 d0 = *(const float4*)(bw + 768), d1 = *(const float4*)(bw + 768 + 4);
      w0[0] = a0.x; w0[1] = a0.y; w0[2] = a0.z; w0[3] = a0.w; w0[4] = a1.x; w0[5] = a1.y; w0[6] = a1.z; w0[7] = a1.w;
      w1[0] = c0.x; w1[1] = c0.y; w1[2] = c0.z; w1[3] = c0.w; w1[4] = c1.x; w1[5] = c1.y; w1[6] = c1.z; w1[7] = c1.w;
      w2[0] = d0.x; w2[1] = d0.y; w2[2] = d0.z; w2[3] = d0.w; w2[4] = d1.x; w2[5] = d1.y; w2[6] = d1.z; w2[7] = d1.w;
    }
    float z[6][8];
#pragma unroll
    for (int s2i = 0; s2i < 6; s2i++) unpack8(zv[s2i], z[s2i]);
#pragma unroll
    for (int t = 0; t < 4; t++) {
      float gb[8], y[8];
      unpack8(gbv[t], gb);
#pragma unroll
      for (int c = 0; c < 8; c++) y[c] = gb[c] * (w0[c] * z[t][c] + w1[c] * z[t + 1][c] + w2[c] * z[t + 2][c]);
      if (active) *(uint4*)(p.mix + (rowq + t) * DM + 384 + 8 * o) = pack8(y);
    }
    if (last && w == 7 && active) {
#pragma unroll
      for (int i = 0; i < 2; i++) {
        float* so = p.out + O_SBP + ((size_t)(l * 8 + bseq) * 2 + i) * 384 + 8 * o;
        *(float4*)so = make_float4(z[4 + i][0], z[4 + i][1], z[4 + i][2], z[4 + i][3]);
        *(float4*)(so + 4) = make_float4(z[4 + i][4], z[4 + i][5], z[4 + i][6], z[4 + i][7]);
      }
    }
  }
  __syncthreads();
}

__device__ void p2_c(const Params& p, int l, int ci, char* smem) {
  const int tid = otid();
  const int lane = tid & 63, w = tid >> 6;
  const int l32 = lane & 31, lh = lane >> 5;
  const int R0 = ci * 128;
  const u16* __restrict__ inter = p.inter;
  {
    const int tok = tid >> 2, qd = tid & 3;
    const u16* src = inter + (size_t)(R0 + tok) * IW + 1792 + qd * 64;
    uint4 xv[8];
#pragma unroll
    for (int i = 0; i < 8; i++) xv[i] = *(const uint4*)(src + i * 8);
    float s1 = 0.f, s2 = 0.f;
#pragma unroll
    for (int i = 0; i < 8; i++) {
      float f[8];
      unpack8(xv[i], f);
#pragma unroll
      for (int k = 0; k < 8; k++) { s1 += f[k]; s2 += f[k] * f[k]; }
    }
    s1 += __shfl_xor(s1, 1); s2 += __shfl_xor(s2, 1);
    s1 += __shfl_xor(s1, 2); s2 += __shfl_xor(s2, 2);
    const float mu = s1 * (1.f / 256.f);
    const float rstd = rsqrtf(fmaxf(s2 * (1.f / 256.f) - mu * mu, 0.f) + EPS);
    const int tch = tok >> 3, tlo = (tok & 7) * 2;
#pragma unroll
    for (int i = 0; i < 8; i++) {
      float f[8];
      unpack8(xv[i], f);
#pragma unroll
      for (int k = 0; k < 8; k++) {
        const int c = qd * 64 + i * 8 + k;
        *(u16*)(smem + c * 256 + ((tch ^ (c & 15)) << 4) + tlo) = f2bf((f[k] - mu) * rstd);
      }
    }
  }
  __syncthreads();
  {
    const int h = w >> 1;
    const int cbase = h * 64 + (w & 1) * 32;
    const int c = cbase + l32;
    f32x16 acc[4];
#pragma unroll
    for (int ti = 0; ti < 4; ti++)
#pragma unroll
      for (int r = 0; r < 16; r++) acc[ti][r] = 0.f;
    const u16* wb = p.wc_b + ((size_t)(l * 4 + h) * 128 + l32) * 128 + lh * 8;
#pragma unroll
    for (int ks = 0; ks < 8; ks++) {
      bf16x8 vfrag = *(const bf16x8*)(smem + c * 256 + (((ks * 2 + lh) ^ (c & 15)) << 4));
#pragma unroll
      for (int ti = 0; ti < 4; ti++) {
        if (ti >= (ks >> 1)) {
          bf16x8 wfrag = *(const bf16x8*)(wb + (size_t)ti * 32 * 128 + ks * 16);
          acc[ti] = __builtin_amdgcn_mfma_f32_32x32x16_bf16(vfrag, wfrag, acc[ti], 0, 0, 0);
        }
      }
    }
    float4 gl[4], bl[4];
#pragma unroll
    for (int g = 0; g < 4; g++) {
      gl[g] = *(const float4*)(p.c_ln_g + l * 256 + cbase + 8 * g + 4 * lh);
      bl[g] = *(const float4*)(p.c_ln_b + l * 256 + cbase + 8 * g + 4 * lh);
    }
#pragma unroll
    for (int ti = 0; ti < 4; ti++) {
      const int t = ti * 32 + l32;
      const size_t row = (size_t)R0 + t;
      const float rsw = p.rsw[(l * 4 + h) * 128 + t];
      const float bs = p.c_bs[(l * 4 + h) * 128 + t];
#pragma unroll
      for (int g = 0; g < 4; g++) {
        const int d0 = cbase + 8 * g + 4 * lh;
        uint2 gc = *(const uint2*)(inter + row * IW + 1536 + d0);
        float y0 = __uint_as_float(gc.x << 16) * (gl[g].x * acc[ti][4 * g + 0] + bl[g].x * rsw + bs);
        float y1 = __uint_as_float(gc.x & 0xffff0000u) * (gl[g].y * acc[ti][4 * g + 1] + bl[g].y * rsw + bs);
        float y2 = __uint_as_float(gc.y << 16) * (gl[g].z * acc[ti][4 * g + 2] + bl[g].z * rsw + bs);
        float y3 = __uint_as_float(gc.y & 0xffff0000u) * (gl[g].w * acc[ti][4 * g + 3] + bl[g].w * rsw + bs);
        *(uint2*)(p.mix + row * DM + 768 + d0) = make_uint2(pack2(y0, y1), pack2(y2, y3));
      }
    }
  }
  __syncthreads();
}

__device__ void p2_s(const Params& p, int l, int n, float* red, float* smem_f) {
  const int tid = otid();
  const int lane = tid & 63, w = tid >> 6;
  const int c = tid;
  const size_t Rs = NPR + (size_t)n * 4;
  const u16* __restrict__ inter = p.inter;
  float rv[16];
#pragma unroll
  for (int i = 0; i < 16; i++) rv[i] = 0.f;
  float o[4] = {0.f, 0.f, 0.f, 0.f};
  float zin[6] = {0.f, 0.f, 0.f, 0.f, 0.f, 0.f};
  float cvv[4] = {0.f, 0.f, 0.f, 0.f};
  if (c < 384) {
    float in[34], wv[31];
    const float* sa = p.state_a + ((size_t)(l * 128 + n) * 30) * 384 + c;
    float* so = p.out + O_SAS + ((size_t)(l * 128 + n) * 30) * 384 + c;
#pragma unroll
    for (int i = 0; i < 30; i++) in[i] = sa[i * 384];
#pragma unroll
    for (int t = 0; t < 4; t++) in[30 + t] = bf2f(inter[(Rs + t) * IW + c]);
#pragma unroll
    for (int j = 0; j < 31; j++) wv[j] = p.a_conv_w[(l * 31 + j) * 384 + c];
    const float bias = p.a_conv_b[l * 384 + c];
#pragma unroll
    for (int i = 0; i < 30; i++) so[i * 384] = in[4 + i];
#pragma unroll
    for (int t = 0; t < 4; t++) o[t] = bias;
#pragma unroll
    for (int j = 0; j < 31; j++) {
#pragma unroll
      for (int t = 0; t < 4; t++) o[t] += wv[j] * in[t + j];
    }
#pragma unroll
    for (int t = 0; t < 4; t++) { rv[t] = o[t]; rv[4 + t] = o[t] * o[t]; }
    const float* sb = p.state_b + ((size_t)(l * 128 + n) * 2) * 384 + c;
    zin[0] = sb[0]; zin[1] = sb[384];
#pragma unroll
    for (int t = 0; t < 4; t++) zin[2 + t] = bf2f(inter[(Rs + t) * IW + 768 + c]);
  }
  if (c < 256) {
#pragma unroll
    for (int t = 0; t < 4; t++) {
      cvv[t] = bf2f(inter[(Rs + t) * IW + 1792 + c]);
      rv[8 + t] = cvv[t];
      rv[12 + t] = cvv[t] * cvv[t];
    }
  }
#pragma unroll
  for (int i = 0; i < 16; i++) {
#pragma unroll
    for (int m = 32; m >= 1; m >>= 1) rv[i] += __shfl_xor(rv[i], m);
  }
  if (lane == 0) {
#pragma unroll
    for (int i = 0; i < 16; i++) red[w * 16 + i] = rv[i];
  }
  __syncthreads();
#pragma unroll
  for (int i = 0; i < 16; i++) {
    float s = 0.f;
#pragma unroll
    for (int ww = 0; ww < 8; ww++) s += red[ww * 16 + i];
    rv[i] = s;
  }
  if (c < 384) {
    const float g = p.a_ln_g[l * 384 + c], bb = p.a_ln_b[l * 384 + c];
    const float w0 = p.b_conv_w[(l * 3 + 0) * 384 + c], w1 = p.b_conv_w[(l * 3 + 1) * 384 + c], w2 = p.b_conv_w[(l * 3 + 2) * 384 + c];
#pragma unroll
    for (int t = 0; t < 4; t++) {
      float m_ = rv[t] * (1.f / 384.f);
      float var = rv[4 + t] * (1.f / 384.f) - m_ * m_;
      float rstd = rsqrtf(fmaxf(var, 0.f) + EPS);
      float y = (o[t] - m_) * rstd * g + bb;
      float ya = siluf_(y) * bf2f(inter[(Rs + t) * IW + 384 + c]);
      p.mix[(Rs + t) * DM + c] = f2bf(ya);
      float cv = w0 * zin[t] + w1 * zin[t + 1] + w2 * zin[t + 2];
      float yb = bf2f(inter[(Rs + t) * IW + 1152 + c]) * cv;
      p.mix[(Rs + t) * DM + 384 + c] = f2bf(yb);
    }
    p.out[O_SBS + ((size_t)(l * 128 + n) * 2 + 0) * 384 + c] = zin[4];
    p.out[O_SBS + ((size_t)(l * 128 + n) * 2 + 1) * 384 + c] = zin[5];
  }
  if (c < 256) {
    const float g = p.c_ln_g[l * 256 + c], bb = p.c_ln_b[l * 256 + c];
    const int h = c >> 6;
    float vn[4];
#pragma unroll
    for (int t = 0; t < 4; t++) {
      float m_ = rv[8 + t] * (1.f / 256.f);
      float var = rv[12 + t] * (1.f / 256.f) - m_ * m_;
      float rstd = rsqrtf(fmaxf(var, 0.f) + EPS);
      vn[t] = (cvv[t] - m_) * rstd * g + bb;
      p.out[O_SCV + ((size_t)(l * 128 + n) * 4 + t) * 256 + c] = vn[t];
    }
#pragma unroll
    for (int t = 0; t < 4; t++) {
      float acc = p.c_bs[(l * 4 + h) * 128 + t];
#pragma unroll
      for (int s = 0; s < 4; s++)
        if (s <= t) acc += p.c_ws[((size_t)(l * 4 + h) * 128 + t) * 128 + s] * vn[s];
      float yc = bf2f(inter[(Rs + t) * IW + 1536 + c]) * acc;
      p.mix[(Rs + t) * DM + 768 + c] = f2bf(yc);
    }
  }
  __syncthreads();
}

__device__ void phase2(const Params& p, int l, char* smem) {
  float* red = (float*)(smem + 90112);
  const int nb = gridDim.x, b = blockIdx.x;
  p2_stage_w(p, l, smem);
  for (int it = b; it < 512; it += nb) {
    asm volatile("" ::: "memory");
    p2_ab(p, l, it, smem);
  }
  for (int it = b; it < 128; it += nb) {
    asm volatile("" ::: "memory");
    p2_c(p, l, it, smem);
  }
  for (int it = (b + nb - (128 % nb)) % nb; it < 128; it += nb) {
    asm volatile("" ::: "memory");
    p2_s(p, l, it, red, (float*)smem);
  }
}

__device__ void phase4(const Params& p) {
  const int tid = otid();
  const float* ssq = p.sumsq + (size_t)2 * NTOK;
  for (int idx = blockIdx.x * NT + tid; idx < NTOK * 128; idx += gridDim.x * NT) {
    const int row = idx >> 7, c8 = idx & 127;
    uint4 v = *(const uint4*)(p.xb + (size_t)row * DM + c8 * 8);
    const float rs = rsqrtf(ssq[row] * (1.f / 1024.f) + EPS);
    float4 g0 = *(const float4*)(p.final_g + c8 * 8), g1 = *(const float4*)(p.final_g + c8 * 8 + 4);
    float f[8];
    unpack8(v, f);
    float* o = p.out + (size_t)row * DM + c8 * 8;
    *(float4*)o = make_float4(f[0] * rs * g0.x, f[1] * rs * g0.y, f[2] * rs * g0.z, f[3] * rs * g0.w);
    *(float4*)(o + 4) = make_float4(f[4] * rs * g1.x, f[5] * rs * g1.y, f[6] * rs * g1.z, f[7] * rs * g1.w);
  }
}

__global__ void __launch_bounds__(NT) fwd_megakernel(Params p) {
  extern __shared__ __attribute__((aligned(16))) char smem[];
  __shared__ uint4 xb_words;
  if (threadIdx.x == 0) xb_words = make_uint4(0u, 0u, 0u, 0u);
  __syncthreads();
  XcdBarrier gb = xcd_barrier_post(p.bar, (volatile LAS unsigned*)&xb_words);
  phase0(p, smem);
  xcd_barrier(gb);
#pragma unroll 1
  for (int l = 0; l < 2; l++) {
    phase1(p, l, smem);
    xcd_barrier(gb);
    phase2(p, l, smem);
    xcd_barrier(gb);
    phase3(p, l, smem);
    xcd_barrier(gb);
  }
  phase4(p);
}

extern "C" void kernel_launch(void* const* d_in, const int* in_sizes, int n_in, void* d_out, int out_size, void* d_ws,
                              size_t ws_size, hipStream_t stream) {
  static int grid_blocks = 0;
  if (!grid_blocks) {
    int dev = 0, cus = 0, per_cu = 0;
    hipGetDevice(&dev);
    hipDeviceGetAttribute(&cus, hipDeviceAttributeMultiprocessorCount, dev);
    hipFuncSetAttribute((const void*)fwd_megakernel, hipFuncAttributeMaxDynamicSharedMemorySize, LDS_BYTES);
    hipOccupancyMaxActiveBlocksPerMultiprocessor(&per_cu, (const void*)fwd_megakernel, NT, LDS_BYTES);
    if (per_cu < 1) { fprintf(stderr, "occupancy query returned %d\n", per_cu); per_cu = 1; }
    if (per_cu > 1) per_cu = 1;
    grid_blocks = cus * per_cu;
  }
  Params p{};
  p.x_prompt = (const float*)d_in[0];
  p.x_sample = (const float*)d_in[1];
  p.state_a = (const float*)d_in[2];
  p.state_b = (const float*)d_in[3];
  p.norm_g = (const float*)d_in[4];
  p.w_in = (const float*)d_in[5];
  p.a_conv_w = (const float*)d_in[6];
  p.a_conv_b = (const float*)d_in[7];
  p.a_ln_g = (const float*)d_in[8];
  p.a_ln_b = (const float*)d_in[9];
  p.b_conv_w = (const float*)d_in[10];
  p.c_ln_g = (const float*)d_in[11];
  p.c_ln_b = (const float*)d_in[12];
  p.c_ws = (const float*)d_in[13];
  p.c_bs = (const float*)d_in[14];
  p.w_out = (const float*)d_in[15];
  p.final_g = (const float*)d_in[16];
  p.out = (float*)d_out;
  char* ws = (char*)d_ws;
  size_t off = 0;
  auto take = [&](size_t bytes) { char* r = ws + off; off += (bytes + 255) & ~(size_t)255; return r; };
  p.win_b = (u16*)take((size_t)2 * INW * DM * 2);
  p.wout_b = (u16*)take((size_t)2 * DM * DM * 2);
  p.wc_b = (u16*)take((size_t)2 * 4 * 128 * 128 * 2);
  p.xb = (u16*)take((size_t)NTOK * DM * 2);
  p.inter = (u16*)take((size_t)NTOK * IW * 2);
  p.mix = (u16*)take((size_t)NTOK * DM * 2);
  p.sumsq = (float*)take((size_t)3 * NTOK * 4);
  p.rsw = (float*)take((size_t)2 * 4 * 128 * 4);
  p.bar = (unsigned*)take((size_t)XCD_BAR_WORDS * 4);
  hipMemsetAsync(p.bar, 0, (size_t)XCD_BAR_WORDS * 4, stream);
  void* args[] = {&p};
  hipError_t e = hipLaunchCooperativeKernel((const void*)fwd_megakernel, dim3(grid_blocks), dim3(NT), args, LDS_BYTES, stream);
  if (e != hipSuccess) fprintf(stderr, "cooperative launch failed: %s (grid %d)\n", hipGetErrorString(e), grid_blocks);
}
```

```cpp
#include <hip/hip_runtime.h>
#include <cstdio>
#include <cstdint>

typedef unsigned short u16;
typedef short bf16x8 __attribute__((ext_vector_type(8)));
typedef float f32x16 __attribute__((ext_vector_type(16)));
typedef unsigned int u32x4 __attribute__((ext_vector_type(4)));

constexpr int NTOK = 16896, NPR = 16384, DM = 1024, INW = 3456, IW = 2048;
constexpr int NT = 512;
constexpr int LDS_BYTES = 131072;
constexpr float EPS = 1e-6f;

constexpr size_t O_SAP = 17301504, O_SBP = 17485824, O_SAS = 17498112, O_SBS = 20447232, O_SCV = 20643840;

struct Params {
  const float *x_prompt, *x_sample, *state_a, *state_b, *norm_g, *w_in, *a_conv_w, *a_conv_b, *a_ln_g, *a_ln_b,
      *b_conv_w, *c_ln_g, *c_ln_b, *c_ws, *c_bs, *w_out, *final_g;
  float* out;
  u16 *win_b, *wout_b, *wc_b, *xb, *inter, *mix;
  float *sumsq, *rsw;
  unsigned* bar;
};

__device__ __forceinline__ u16 f2bf(float f) {
  unsigned u = __float_as_uint(f);
  u += 0x7fffu + ((u >> 16) & 1u);
  return (u16)(u >> 16);
}
__device__ __forceinline__ float bf2f(u16 h) { return __uint_as_float(((unsigned)h) << 16); }
__device__ __forceinline__ unsigned pack2(float a, float b) { return (unsigned)f2bf(a) | ((unsigned)f2bf(b) << 16); }
__device__ __forceinline__ float sigmoidf_(float x) { return 1.f / (1.f + __expf(-x)); }
__device__ __forceinline__ float siluf_(float x) { return x / (1.f + __expf(-x)); }

__device__ __forceinline__ void unpack8(const uint4& v, float (&f)[8]) {
  f[0] = __uint_as_float(v.x << 16); f[1] = __uint_as_float(v.x & 0xffff0000u);
  f[2] = __uint_as_float(v.y << 16); f[3] = __uint_as_float(v.y & 0xffff0000u);
  f[4] = __uint_as_float(v.z << 16); f[5] = __uint_as_float(v.z & 0xffff0000u);
  f[6] = __uint_as_float(v.w << 16); f[7] = __uint_as_float(v.w & 0xffff0000u);
}
__device__ __forceinline__ uint4 pack8(const float (&f)[8]) {
  uint4 o;
  o.x = pack2(f[0], f[1]); o.y = pack2(f[2], f[3]); o.z = pack2(f[4], f[5]); o.w = pack2(f[6], f[7]);
  return o;
}

__device__ __forceinline__ int otid() {
  int t = threadIdx.x;
  asm volatile("" : "+v"(t));
  return t;
}

__device__ __forceinline__ int vcol_src(int vc) {
  int j = vc >> 7, v = vc & 127;
  int wn = v >> 6, ni = (v >> 5) & 1, l32 = v & 31;
  int chp = wn * 32 + l32;
  if (j < 6) return (ni ? 384 : 0) + j * 64 + chp;
  if (j < 9) return 768 + (j - 6) * 128 + v;
  if (j < 15) return (ni ? 1920 : 1152) + (j - 9) * 64 + chp;
  if (j < 21) return (ni ? 2304 : 1536) + (j - 15) * 64 + chp;
  if (j < 25) return (ni ? 3200 : 2688) + (j - 21) * 64 + chp;
  return 2944 + (j - 25) * 128 + v;
}


#define XB_TMO      128
#define XB_XCNT(j)  (256  + 64 * (j))
#define XB_XSUB(j)  (1280 + 64 * (j))
#define XB_XGEN(j)  (2304 + 64 * (j))
#define XB_TOP      3328
#define XB_TOPGEN   3392
#define XCD_BAR_WORDS 3456
#define XB_SPIN_CAP (1u << 18)
#define LAS __attribute__((address_space(3)))

__device__ __forceinline__ unsigned xb_ld(unsigned* p)              { return __hip_atomic_load(p, __ATOMIC_RELAXED, __HIP_MEMORY_SCOPE_AGENT); }
__device__ __forceinline__ unsigned xb_add(unsigned* p, unsigned v) { return __hip_atomic_fetch_add(p, v, __ATOMIC_RELAXED, __HIP_MEMORY_SCOPE_AGENT); }
__device__ __forceinline__ unsigned xb_xcc_id() { return (unsigned)__builtin_amdgcn_s_getreg((3 << 11) | 20) & 0xFu; }
#define XB_SPIN(cond, bar) do { unsigned _sp = 0; while (cond) { __builtin_amdgcn_s_sleep(1); \
    if ((++_sp & 255u) == 0u) { if (xb_ld(&(bar)[XB_TMO])) break; if (_sp > XB_SPIN_CAP) { atomicAdd(&(bar)[XB_TMO], 1u); break; } } } } while (0)

struct XcdBarrier {
  unsigned* bar; unsigned x;
  volatile LAS unsigned* st;
};
__device__ __forceinline__ XcdBarrier xcd_barrier_post(unsigned* bar, volatile LAS unsigned* st) {
  XcdBarrier b; b.bar = bar; b.x = xb_xcc_id(); b.st = st;
  if (threadIdx.x == 0) (void)xb_add(&bar[XB_XCNT(b.x)], 1u);
  return b;
}
__device__ __forceinline__ void xcd_barrier_complete(unsigned* bar, unsigned x, unsigned& nloc, unsigned& nx) {
  const unsigned G = gridDim.x * gridDim.y * gridDim.z;
  unsigned sum, cnt, mine, sp = 0u;
  for (;;) {
    sum = 0u; cnt = 0u; mine = 0u;
#pragma unroll
    for (unsigned j = 0; j < 16; ++j) { const unsigned c = xb_ld(&bar[XB_XCNT(j)]); sum += c; cnt += (c > 0u) ? 1u : 0u; mine = (j == x) ? c : mine; }
    if (sum == G) break;
    __builtin_amdgcn_s_sleep(1);
    if ((++sp & 255u) == 0u) { if (xb_ld(&bar[XB_TMO])) break; if (sp > XB_SPIN_CAP) { atomicAdd(&bar[XB_TMO], 1u); break; } }
  }
  nloc = mine > 0u ? mine : 1u; nx = cnt > 0u ? cnt : 1u;
}
__device__ __forceinline__ void xcd_barrier(const XcdBarrier& b) {
  asm volatile("s_waitcnt vmcnt(0)" ::: "memory");
  __syncthreads();
  if (threadIdx.x == 0) {
    unsigned* bar = b.bar;
    __builtin_amdgcn_s_waitcnt(0);
    unsigned nloc = b.st[0], nx = b.st[1];
    if (nloc == 0u) { xcd_barrier_complete(bar, b.x, nloc, nx); b.st[0] = nloc; b.st[1] = nx; }
    const unsigned old = xb_add(&bar[XB_XSUB(b.x)], 1u);
    const unsigned gen = old / nloc;
    if (old + 1u == (gen + 1u) * nloc) {
      __builtin_amdgcn_fence(__ATOMIC_RELEASE, "agent");
      asm volatile("s_waitcnt vmcnt(0)" ::: "memory");
      const unsigned og = xb_add(&bar[XB_TOP], 1u);
      const unsigned tg = og / nx;
      if (og + 1u == (tg + 1u) * nx) xb_add(&bar[XB_TOPGEN], 1u);
      else XB_SPIN(xb_ld(&bar[XB_TOPGEN]) == tg, bar);
      __builtin_amdgcn_fence(__ATOMIC_ACQUIRE, "agent");
      xb_add(&bar[XB_XGEN(b.x)], 1u);
      asm volatile("s_waitcnt vmcnt(0)" ::: "memory");
    } else {
      XB_SPIN(xb_ld(&bar[XB_XGEN(b.x)]) == gen, bar);
      __builtin_amdgcn_fence(__ATOMIC_ACQUIRE, "agent");
      asm volatile("s_waitcnt vmcnt(0)" ::: "memory");
    }
  }
  __syncthreads();
}

__device__ void p0_transpose(const float* __restrict__ W, int ncols, const float* __restrict__ g, u16* __restrict__ outp,
                             int k0, int v0, bool mapv, float* tile) {
  int tid = otid();
#pragma unroll
  for (int i = 0; i < 8; i++) {
    int e = tid + i * NT;
    int kk = e >> 6, v = e & 63;
    int src = mapv ? vcol_src(v0 + v) : (v0 + v);
    float val = W[(size_t)(k0 + kk) * ncols + src];
    if (g) val *= g[k0 + kk];
    tile[kk * 65 + v] = val;
  }
  __syncthreads();
  {
    int v = tid >> 3, kq = tid & 7;
    const float* tp = tile + (kq * 8) * 65 + v;
    uint4 o;
    o.x = pack2(tp[0], tp[65]);
    o.y = pack2(tp[2 * 65], tp[3 * 65]);
    o.z = pack2(tp[4 * 65], tp[5 * 65]);
    o.w = pack2(tp[6 * 65], tp[7 * 65]);
    *(uint4*)(outp + (size_t)(v0 + v) * 1024 + k0 + kq * 8) = o;
  }
  __syncthreads();
}

__device__ void phase0(const Params& p, char* smem) {
  float* tile = (float*)smem;
  int nb = gridDim.x, b = blockIdx.x, tid = otid();
  for (int it = b; it < 2 * 16 * 54; it += nb) {
    int l = it / (16 * 54), rem = it % (16 * 54);
    int kb = rem / 54, vb = rem % 54;
    p0_transpose(p.w_in + (size_t)l * DM * INW, INW, p.norm_g + l * DM, p.win_b + (size_t)l * INW * DM, kb * 64, vb * 64, true, tile);
  }
  for (int it = b; it < 2 * 16 * 16; it += nb) {
    int l = it >> 8, rem = it & 255;
    int kb = rem >> 4, vb = rem & 15;
    p0_transpose(p.w_out + (size_t)l * DM * DM, DM, nullptr, p.wout_b + (size_t)l * DM * DM, kb * 64, vb * 64, false, tile);
  }
  for (int e = b * NT + tid; e < 2 * 4 * 128 * 128; e += nb * NT) {
    int s = e & 127, t = (e >> 7) & 127;
    p.wc_b[e] = (s <= t) ? f2bf(p.c_ws[e]) : (u16)0;
  }
  for (int e = b * NT + tid; e < 2 * NTOK; e += nb * NT) p.sumsq[NTOK + e] = 0.f;
  for (int e = b * NT + tid; e < 2 * 4 * 128; e += nb * NT) {
    int t = e & 127;
    const float* wr = p.c_ws + (size_t)e * 128;
    float s = 0.f;
    for (int k = 0; k <= t; k++) s += bf2f(f2bf(wr[k]));
    p.rsw[e] = s;
  }
  int wave = tid >> 6, lane = tid & 63;
  for (int row = b * 8 + wave; row < NTOK; row += nb * 8) {
    const float* xr = (row < NPR) ? (p.x_prompt + (size_t)row * DM) : (p.x_sample + (size_t)(row - NPR) * DM);
    float ss = 0.f;
#pragma unroll
    for (int j = 0; j < 4; j++) {
      float4 v = *(const float4*)(xr + (j * 64 + lane) * 4);
      ss += v.x * v.x + v.y * v.y + v.z * v.z + v.w * v.w;
      uint2 o;
      o.x = pack2(v.x, v.y);
      o.y = pack2(v.z, v.w);
      *(uint2*)(p.xb + (size_t)row * DM + (j * 64 + lane) * 4) = o;
    }
#pragma unroll
    for (int m = 32; m >= 1; m >>= 1) ss += __shfl_xor(ss, m);
    if (lane == 0) p.sumsq[row] = ss;
  }
}

__device__ __forceinline__ void gemm_mainloop(const u16* __restrict__ Ag, const u16* __restrict__ Bg, char* smem,
                                              f32x16 (&acc)[2][2]) {
  const int tid = otid();
  const int lane = tid & 63, w = tid >> 6;
  const int wm = w >> 1, wn = w & 1;
  const int l32 = lane & 31, lh = lane >> 5;
  const int sr = tid >> 3, sc = tid & 7;
  const int st_off = sr * 128 + ((sc ^ ((sr >> 1) & 7)) << 4);
  const u16* ag = Ag + (size_t)sr * DM + sc * 8;
  const u16* bg = Bg + (size_t)sr * DM + sc * 8;
  const int fsw = (l32 >> 1) & 7;
  const int a_off = (wm * 64 + l32) * 128;
  const int b_off = 32768 + (wn * 64 + l32) * 128;

  struct Stage { u32x4 a0, a1, a2, a3, b0, b1; };
  Stage s0, s1;
  auto LOADT = [&](Stage& S, int KT) {
    S.a0 = *(const u32x4*)(ag + KT * 64);
    S.a1 = *(const u32x4*)(ag + (size_t)64 * DM + KT * 64);
    S.a2 = *(const u32x4*)(ag + (size_t)128 * DM + KT * 64);
    S.a3 = *(const u32x4*)(ag + (size_t)192 * DM + KT * 64);
    S.b0 = *(const u32x4*)(bg + KT * 64);
    S.b1 = *(const u32x4*)(bg + (size_t)64 * DM + KT * 64);
  };
  auto STORET = [&](const Stage& S, char* BUF) {
    *(u32x4*)(BUF + st_off) = S.a0;
    *(u32x4*)(BUF + st_off + 8192) = S.a1;
    *(u32x4*)(BUF + st_off + 16384) = S.a2;
    *(u32x4*)(BUF + st_off + 24576) = S.a3;
    *(u32x4*)(BUF + 32768 + st_off) = S.b0;
    *(u32x4*)(BUF + 32768 + st_off + 8192) = S.b1;
  };
  auto COMPUTET = [&](const char* CUR) {
#pragma unroll
    for (int kk = 0; kk < 4; kk++) {
      const int co = ((kk * 2 + lh) ^ fsw) << 4;
      bf16x8 a0 = *(const bf16x8*)(CUR + a_off + co);
      bf16x8 a1 = *(const bf16x8*)(CUR + a_off + 32 * 128 + co);
      bf16x8 b0 = *(const bf16x8*)(CUR + b_off + co);
      bf16x8 b1 = *(const bf16x8*)(CUR + b_off + 32 * 128 + co);
      acc[0][0] = __builtin_amdgcn_mfma_f32_32x32x16_bf16(b0, a0, acc[0][0], 0, 0, 0);
      acc[0][1] = __builtin_amdgcn_mfma_f32_32x32x16_bf16(b1, a0, acc[0][1], 0, 0, 0);
      acc[1][0] = __builtin_amdgcn_mfma_f32_32x32x16_bf16(b0, a1, acc[1][0], 0, 0, 0);
      acc[1][1] = __builtin_amdgcn_mfma_f32_32x32x16_bf16(b1, a1, acc[1][1], 0, 0, 0);
    }
  };
  char* buf0 = smem;
  char* buf1 = smem + 49152;
  LOADT(s0, 0);
  LOADT(s1, 1);
  STORET(s0, buf0);
  __syncthreads();
#pragma unroll 1
  for (int kt = 0; kt < 16; kt += 2) {
    LOADT(s0, (kt + 2 < 16) ? kt + 2 : 15);
    COMPUTET(buf0);
    STORET(s1, buf1);
    __syncthreads();
    LOADT(s1, (kt + 3 < 16) ? kt + 3 : 15);
    COMPUTET(buf1);
    STORET(s0, buf0);
    __syncthreads();
  }
}

struct TileIter { int T, t1, step; };
__device__ __forceinline__ TileIter tile_begin(const volatile LAS unsigned* sched, int ntiles) {
  const int slot = (int)sched[0], nloc = (int)sched[1], prefix = (int)sched[2], G = (int)sched[3];
  TileIter it;
  const int t0 = (int)(((long long)ntiles * prefix) / G);
  it.t1 = (int)(((long long)ntiles * (prefix + nloc)) / G);
  it.T = t0 + slot;
  it.step = nloc;
  return it;
}

__device__ void phase1(const Params& p, int l, char* smem, const volatile LAS unsigned* sched) {
  const int tid = otid();
  const int lane = tid & 63, w = tid >> 6;
  const int wm = w >> 1, wn = w & 1;
  const int l32 = lane & 31, lh = lane >> 5;
  const float* ssq = p.sumsq + (size_t)l * NTOK;
  TileIter ti_ = tile_begin(sched, 66 * 27);
  for (int T = ti_.T; T < ti_.t1; T += ti_.step) {
    int rb = T / 27, j = T - rb * 27;
    int row0 = rb * 256;
    f32x16 acc[2][2];
#pragma unroll
    for (int a = 0; a < 2; a++)
#pragma unroll
      for (int c = 0; c < 2; c++)
#pragma unroll
        for (int r = 0; r < 16; r++) acc[a][c][r] = 0.f;
    gemm_mainloop(p.xb + (size_t)row0 * DM, p.win_b + ((size_t)l * INW + (size_t)j * 128) * DM, smem, acc);
    int kind, ob;
    if (j < 6) { kind = 0; ob = j * 64; }
    else if (j < 9) { kind = 1; ob = 384 + (j - 6) * 128; }
    else if (j < 15) { kind = 2; ob = 768 + (j - 9) * 64; }
    else if (j < 21) { kind = 3; ob = 1152 + (j - 15) * 64; }
    else if (j < 25) { kind = 3; ob = 1536 + (j - 21) * 64; }
    else { kind = 4; ob = 1792 + (j - 25) * 128; }
    const bool paired = (kind == 0 || kind == 2 || kind == 3);
    const int rowb = paired ? 144 : 272;
#pragma unroll
    for (int mi = 0; mi < 2; mi++) {
      const int m = wm * 64 + mi * 32 + l32;
      const float rs = rsqrtf(ssq[row0 + m] * (1.f / 1024.f) + EPS);
#pragma unroll
      for (int g = 0; g < 4; g++) {
        float r0[4], r1[4];
#pragma unroll
        for (int i = 0; i < 4; i++) {
          float v0 = acc[mi][0][4 * g + i] * rs, v1 = acc[mi][1][4 * g + i] * rs;
          if (kind == 0) r0[i] = v0 * sigmoidf_(v1);
          else if (kind == 2) r0[i] = v0 * v1;
          else if (kind == 3) r0[i] = v0 * siluf_(v1);
          else if (kind == 1) { r0[i] = siluf_(v0); r1[i] = siluf_(v1); }
          else { r0[i] = v0; r1[i] = v1; }
        }
        const int chl = 8 * g + 4 * lh;
        if (paired) {
          *(uint2*)(smem + m * 144 + (wn * 32 + chl) * 2) = make_uint2(pack2(r0[0], r0[1]), pack2(r0[2], r0[3]));
        } else {
          *(uint2*)(smem + m * 272 + (wn * 64 + chl) * 2) = make_uint2(pack2(r0[0], r0[1]), pack2(r0[2], r0[3]));
          *(uint2*)(smem + m * 272 + (wn * 64 + 32 + chl) * 2) = make_uint2(pack2(r1[0], r1[1]), pack2(r1[2], r1[3]));
        }
      }
    }
    __syncthreads();
    if (paired) {
#pragma unroll
      for (int i = 0; i < 4; i++) {
        int q = tid + i * NT, m = q >> 3, c = q & 7;
        uint4 v = *(const uint4*)(smem + m * 144 + c * 16);
        *(uint4*)(p.inter + (size_t)(row0 + m) * IW + ob + c * 8) = v;
      }
    } else {
#pragma unroll
      for (int i = 0; i < 8; i++) {
        int q = tid + i * NT, m = q >> 4, c = q & 15;
        uint4 v = *(const uint4*)(smem + m * 272 + c * 16);
        *(uint4*)(p.inter + (size_t)(row0 + m) * IW + ob + c * 8) = v;
      }
    }
    (void)rowb;
    __syncthreads();
  }
}

__device__ void phase3(const Params& p, int l, char* smem, const volatile LAS unsigned* sched) {
  const int tid = otid();
  const int lane = tid & 63, w = tid >> 6;
  const int wm = w >> 1, wn = w & 1;
  const int l32 = lane & 31, lh = lane >> 5;
  TileIter ti_ = tile_begin(sched, 66 * 8);
  for (int T = ti_.T; T < ti_.t1; T += ti_.step) {
    int rb = T >> 3, j = T & 7;
    int row0 = rb * 256, col0 = j * 128;
    f32x16 acc[2][2];
#pragma unroll
    for (int a = 0; a < 2; a++)
#pragma unroll
      for (int c = 0; c < 2; c++)
#pragma unroll
        for (int r = 0; r < 16; r++) acc[a][c][r] = 0.f;
    gemm_mainloop(p.mix + (size_t)row0 * DM, p.wout_b + ((size_t)l * DM + col0) * DM, smem, acc);
    float* ssq = p.sumsq + (size_t)(l + 1) * NTOK;
#pragma unroll
    for (int mi = 0; mi < 2; mi++) {
      const int m = wm * 64 + mi * 32 + l32;
      const u16* xr = p.xb + (size_t)(row0 + m) * DM + col0 + wn * 64;
      uint2 xo[2][4];
#pragma unroll
      for (int ni = 0; ni < 2; ni++)
#pragma unroll
        for (int g = 0; g < 4; g++) xo[ni][g] = *(const uint2*)(xr + ni * 32 + 8 * g + 4 * lh);
      float ss = 0.f;
#pragma unroll
      for (int ni = 0; ni < 2; ni++) {
#pragma unroll
        for (int g = 0; g < 4; g++) {
          float v0 = __uint_as_float(xo[ni][g].x << 16) + acc[mi][ni][4 * g + 0];
          float v1 = __uint_as_float(xo[ni][g].x & 0xffff0000u) + acc[mi][ni][4 * g + 1];
          float v2 = __uint_as_float(xo[ni][g].y << 16) + acc[mi][ni][4 * g + 2];
          float v3 = __uint_as_float(xo[ni][g].y & 0xffff0000u) + acc[mi][ni][4 * g + 3];
          ss += v0 * v0 + v1 * v1 + v2 * v2 + v3 * v3;
          *(uint2*)(smem + m * 272 + (wn * 64 + ni * 32 + 8 * g + 4 * lh) * 2) = make_uint2(pack2(v0, v1), pack2(v2, v3));
        }
      }
      ss += __shfl_xor(ss, 32);
      if (lh == 0) atomicAdd(ssq + row0 + m, ss);
    }
    __syncthreads();
#pragma unroll
    for (int i = 0; i < 8; i++) {
      int q = tid + i * NT, m = q >> 4, c = q & 15;
      uint4 v = *(const uint4*)(smem + m * 272 + c * 16);
      *(uint4*)(p.xb + (size_t)(row0 + m) * DM + col0 + c * 8) = v;
    }
    __syncthreads();
  }
}

__device__ void p2_stage_w(const Params& p, int l, char* smem) {
  const int tid = otid();
  const float4* src = (const float4*)(p.a_conv_w + (size_t)l * 31 * 384);
  for (int f = tid; f < 36 * 96; f += NT) {
    int j = f / 96, q = f - j * 96;
    float4 v = make_float4(0.f, 0.f, 0.f, 0.f);
    if (j < 31) v = src[f];
    ((float4*)smem)[(j * 2 + (q & 1)) * 48 + (q >> 1)] = v;
  }
}

__device__ void p2_ab(const Params& p, int l, int it, char* smem) {
  const int tid = otid();
  const int lane = tid & 63, w = tid >> 6;
  const bool active = lane < 48;
  const int o = active ? lane : 47;
  const int R0 = it * 32;
  const int spos = R0 & 2047;
  const int bseq = R0 >> 11;
  const bool last = (spos == 2016);
  const u16* __restrict__ inter = p.inter;
  char* atile = smem + 55296;
  const float4* wts = (const float4*)smem;
  uint4 st[6];
#pragma unroll
  for (int i = 0; i < 6; i++) {
    int e = tid + i * NT;
    st[i] = make_uint4(0, 0, 0, 0);
    {
      int r = e / 48, ch = e - r * 48;
      if (r < 62 && spos - 30 + r >= 0) st[i] = *(const uint4*)(inter + (size_t)(R0 - 30 + r) * IW + ch * 8);
    }
  }
  const size_t rowq = (size_t)R0 + 4 * w;
  uint4 szv[4], gbv[4], zv[6];
#pragma unroll
  for (int t = 0; t < 4; t++) {
    szv[t] = *(const uint4*)(inter + (rowq + t) * IW + 384 + 8 * o);
    gbv[t] = *(const uint4*)(inter + (rowq + t) * IW + 1152 + 8 * o);
  }
#pragma unroll
  for (int s2 = 0; s2 < 6; s2++) {
    zv[s2] = make_uint4(0, 0, 0, 0);
    if (spos + 4 * w - 2 + s2 >= 0) zv[s2] = *(const uint4*)(inter + (rowq - 2 + s2) * IW + 768 + 8 * o);
  }
#pragma unroll
  for (int i = 0; i < 6; i++) {
    int e = tid + i * NT;
    *(uint4*)(atile + e * 16) = st[i];
  }
  __syncthreads();
  float acc[4][8];
  {
    float4 b0 = *(const float4*)(p.a_conv_b + l * 384 + 8 * o), b1 = *(const float4*)(p.a_conv_b + l * 384 + 8 * o + 4);
#pragma unroll
    for (int t = 0; t < 4; t++) {
      acc[t][0] = b0.x; acc[t][1] = b0.y; acc[t][2] = b0.z; acc[t][3] = b0.w;
      acc[t][4] = b1.x; acc[t][5] = b1.y; acc[t][6] = b1.z; acc[t][7] = b1.w;
    }
  }
  float wwin[4][8];
#pragma unroll
  for (int u = 0; u < 4; u++)
#pragma unroll
    for (int c = 0; c < 8; c++) wwin[u][c] = 0.f;
  const char* arow = atile + (4 * w) * 768 + o * 16;
#pragma unroll 1
  for (int s4 = 0; s4 < 36; s4 += 4) {
    const char* ar = arow + s4 * 768;
    const float4* wr = wts + (s4 * 2) * 48 + o;
#pragma unroll
    for (int u = 0; u < 4; u++) {
      uint4 av = *(const uint4*)(ar + u * 768);
      float4 wa = wr[(u * 2) * 48], wb = wr[(u * 2 + 1) * 48];
      float v[8];
      unpack8(av, v);
      wwin[u][0] = wa.x; wwin[u][1] = wa.y; wwin[u][2] = wa.z; wwin[u][3] = wa.w;
      wwin[u][4] = wb.x; wwin[u][5] = wb.y; wwin[u][6] = wb.z; wwin[u][7] = wb.w;
#pragma unroll
      for (int t = 0; t < 4; t++) {
#pragma unroll
        for (int c = 0; c < 8; c++) acc[t][c] += wwin[(u - t) & 3][c] * v[c];
      }
    }
  }
  if (last && active) {
#pragma unroll
    for (int t = 0; t < 4; t++) {
      int pp = spos + 4 * w + t;
      if (pp >= 2018) {
        float v[8];
        unpack8(*(const uint4*)(arow + (30 + t) * 768), v);
        float* so = p.out + O_SAP + ((size_t)(l * 8 + bseq) * 30 + (pp - 2018)) * 384 + 8 * o;
        *(float4*)so = make_float4(v[0], v[1], v[2], v[3]);
        *(float4*)(so + 4) = make_float4(v[4], v[5], v[6], v[7]);
      }
    }
  }
  float s1[4], s2[4];
#pragma unroll
  for (int t = 0; t < 4; t++) {
    float a = 0.f, b = 0.f;
#pragma unroll
    for (int c = 0; c < 8; c++) { a += acc[t][c]; b += acc[t][c] * acc[t][c]; }
    s1[t] = active ? a : 0.f;
    s2[t] = active ? b : 0.f;
  }
#pragma unroll
  for (int t = 0; t < 4; t++) {
#pragma unroll
    for (int m = 32; m >= 1; m >>= 1) { s1[t] += __shfl_xor(s1[t], m); s2[t] += __shfl_xor(s2[t], m); }
  }
  {
    float g8[8], b8[8];
    {
      float4 a0 = *(const float4*)(p.a_ln_g + l * 384 + 8 * o), a1 = *(const float4*)(p.a_ln_g + l * 384 + 8 * o + 4);
      float4 c0 = *(const float4*)(p.a_ln_b + l * 384 + 8 * o), c1 = *(const float4*)(p.a_ln_b + l * 384 + 8 * o + 4);
      g8[0] = a0.x; g8[1] = a0.y; g8[2] = a0.z; g8[3] = a0.w; g8[4] = a1.x; g8[5] = a1.y; g8[6] = a1.z; g8[7] = a1.w;
      b8[0] = c0.x; b8[1] = c0.y; b8[2] = c0.z; b8[3] = c0.w; b8[4] = c1.x; b8[5] = c1.y; b8[6] = c1.z; b8[7] = c1.w;
    }
#pragma unroll
    for (int t = 0; t < 4; t++) {
      float mu = s1[t] * (1.f / 384.f);
      float var = s2[t] * (1.f / 384.f) - mu * mu;
      float rstd = rsqrtf(fmaxf(var, 0.f) + EPS);
      float sz[8], y[8];
      unpack8(szv[t], sz);
#pragma unroll
      for (int c = 0; c < 8; c++) y[c] = siluf_((acc[t][c] - mu) * rstd * g8[c] + b8[c]) * sz[c];
      if (active) *(uint4*)(p.mix + (rowq + t) * DM + 8 * o) = pack8(y);
    }
  }
  {
    float w0[8], w1[8], w2[8];
    {
      const float* bw = p.b_conv_w + (size_t)l * 3 * 384 + 8 * o;
      float4 a0 = *(const float4*)(bw), a1 = *(const float4*)(bw + 4);
      float4 c0 = *(const float4*)(bw + 384), c1 = *(const float4*)(bw + 384 + 4);
      float4 d0 = *(const float4*)(bw + 768), d1 = *(const float4*)(bw + 768 + 4);
      w0[0] = a0.x; w0[1] = a0.y; w0[2] = a0.z; w0[3] = a0.w; w0[4] = a1.x; w0[5] = a1.y; w0[6] = a1.z; w0[7] = a1.w;
      w1[0] = c0.x; w1[1] = c0.y; w1[2] = c0.z; w1[3] = c0.w; w1[4] = c1.x; w1[5] = c1.y; w1[6] = c1.z; w1[7] = c1.w;
      w2[0] = d0.x; w2[1] = d0.y; w2[2] = d0.z; w2[3] = d0.w; w2[4] = d1.x; w2[5] = d1.y; w2[6] = d1.z; w2[7] = d1.w;
    }
    float z[6][8];
#pragma unroll
    for (int s2i = 0; s2i < 6; s2i++) unpack8(zv[s2i], z[s2i]);
#pragma unroll
    for (int t = 0; t < 4; t++) {
      float gb[8], y[8];
      unpack8(gbv[t], gb);
#pragma unroll
      for (int c = 0; c < 8; c++) y[c] = gb[c] * (w0[c] * z[t][c] + w1[c] * z[t + 1][c] + w2[c] * z[t + 2][c]);
      if (active) *(uint4*)(p.mix + (rowq + t) * DM + 384 + 8 * o) = pack8(y);
    }
    if (last && w == 7 && active) {
#pragma unroll
      for (int i = 0; i < 2; i++) {
        float* so = p.out + O_SBP + ((size_t)(l * 8 + bseq) * 2 + i) * 384 + 8 * o;
        *(float4*)so = make_float4(z[4 + i][0], z[4 + i][1], z[4 + i][2], z[4 + i][3]);
        *(float4*)(so + 4) = make_float4(z[4 + i][4], z[4 + i][5], z[4 + i][6], z[4 + i][7]);
      }
    }
  }
  __syncthreads();
}

__device__ void p2_c(const Params& p, int l, int ci, char* smem) {
  const int tid = otid();
  const int lane = tid & 63, w = tid >> 6;
  const int l32 = lane & 31, lh = lane >> 5;
  const int R0 = ci * 128;
  const u16* __restrict__ inter = p.inter;
  {
    const int tok = tid >> 2, qd = tid & 3;
    const u16* src = inter + (size_t)(R0 + tok) * IW + 1792 + qd * 64;
    uint4 xv[8];
#pragma unroll
    for (int i = 0; i < 8; i++) xv[i] = *(const uint4*)(src + i * 8);
    float s1 = 0.f, s2 = 0.f;
#pragma unroll
    for (int i = 0; i < 8; i++) {
      float f[8];
      unpack8(xv[i], f);
#pragma unroll
      for (int k = 0; k < 8; k++) { s1 += f[k]; s2 += f[k] * f[k]; }
    }
    s1 += __shfl_xor(s1, 1); s2 += __shfl_xor(s2, 1);
    s1 += __shfl_xor(s1, 2); s2 += __shfl_xor(s2, 2);
    const float mu = s1 * (1.f / 256.f);
    const float rstd = rsqrtf(fmaxf(s2 * (1.f / 256.f) - mu * mu, 0.f) + EPS);
    const int tch = tok >> 3, tlo = (tok & 7) * 2;
#pragma unroll
    for (int i = 0; i < 8; i++) {
      float f[8];
      unpack8(xv[i], f);
#pragma unroll
      for (int k = 0; k < 8; k++) {
        const int c = qd * 64 + i * 8 + k;
        *(u16*)(smem + c * 256 + ((tch ^ (c & 15)) << 4) + tlo) = f2bf((f[k] - mu) * rstd);
      }
    }
  }
  __syncthreads();
  {
    const int h = w >> 1;
    const int cbase = h * 64 + (w & 1) * 32;
    const int c = cbase + l32;
    f32x16 acc[4];
#pragma unroll
    for (int ti = 0; ti < 4; ti++)
#pragma unroll
      for (int r = 0; r < 16; r++) acc[ti][r] = 0.f;
    const u16* wb = p.wc_b + ((size_t)(l * 4 + h) * 128 + l32) * 128 + lh * 8;
#pragma unroll
    for (int ks = 0; ks < 8; ks++) {
      bf16x8 vfrag = *(const bf16x8*)(smem + c * 256 + (((ks * 2 + lh) ^ (c & 15)) << 4));
#pragma unroll
      for (int ti = 0; ti < 4; ti++) {
        if (ti >= (ks >> 1)) {
          bf16x8 wfrag = *(const bf16x8*)(wb + (size_t)ti * 32 * 128 + ks * 16);
          acc[ti] = __builtin_amdgcn_mfma_f32_32x32x16_bf16(vfrag, wfrag, acc[ti], 0, 0, 0);
        }
      }
    }
    float4 gl[4], bl[4];
#pragma unroll
    for (int g = 0; g < 4; g++) {
      gl[g] = *(const float4*)(p.c_ln_g + l * 256 + cbase + 8 * g + 4 * lh);
      bl[g] = *(const float4*)(p.c_ln_b + l * 256 + cbase + 8 * g + 4 * lh);
    }
#pragma unroll
    for (int ti = 0; ti < 4; ti++) {
      const int t = ti * 32 + l32;
      const size_t row = (size_t)R0 + t;
      const float rsw = p.rsw[(l * 4 + h) * 128 + t];
      const float bs = p.c_bs[(l * 4 + h) * 128 + t];
#pragma unroll
      for (int g = 0; g < 4; g++) {
        const int d0 = cbase + 8 * g + 4 * lh;
        uint2 gc = *(const uint2*)(inter + row * IW + 1536 + d0);
        float y0 = __uint_as_float(gc.x << 16) * (gl[g].x * acc[ti][4 * g + 0] + bl[g].x * rsw + bs);
        float y1 = __uint_as_float(gc.x & 0xffff0000u) * (gl[g].y * acc[ti][4 * g + 1] + bl[g].y * rsw + bs);
        float y2 = __uint_as_float(gc.y << 16) * (gl[g].z * acc[ti][4 * g + 2] + bl[g].z * rsw + bs);
        float y3 = __uint_as_float(gc.y & 0xffff0000u) * (gl[g].w * acc[ti][4 * g + 3] + bl[g].w * rsw + bs);
        *(uint2*)(p.mix + row * DM + 768 + d0) = make_uint2(pack2(y0, y1), pack2(y2, y3));
      }
    }
  }
  __syncthreads();
}

__device__ void p2_s(const Params& p, int l, int n, float* red, float* smem_f) {
  const int tid = otid();
  const int lane = tid & 63, w = tid >> 6;
  const int c = tid;
  const size_t Rs = NPR + (size_t)n * 4;
  const u16* __restrict__ inter = p.inter;
  float rv[16];
#pragma unroll
  for (int i = 0; i < 16; i++) rv[i] = 0.f;
  float o[4] = {0.f, 0.f, 0.f, 0.f};
  float zin[6] = {0.f, 0.f, 0.f, 0.f, 0.f, 0.f};
  float cvv[4] = {0.f, 0.f, 0.f, 0.f};
  if (c < 384) {
    float in[34], wv[31];
    const float* sa = p.state_a + ((size_t)(l * 128 + n) * 30) * 384 + c;
    float* so = p.out + O_SAS + ((size_t)(l * 128 + n) * 30) * 384 + c;
#pragma unroll
    for (int i = 0; i < 30; i++) in[i] = sa[i * 384];
#pragma unroll
    for (int t = 0; t < 4; t++) in[30 + t] = bf2f(inter[(Rs + t) * IW + c]);
#pragma unroll
    for (int j = 0; j < 31; j++) wv[j] = p.a_conv_w[(l * 31 + j) * 384 + c];
    const float bias = p.a_conv_b[l * 384 + c];
#pragma unroll
    for (int i = 0; i < 30; i++) so[i * 384] = in[4 + i];
#pragma unroll
    for (int t = 0; t < 4; t++) o[t] = bias;
#pragma unroll
    for (int j = 0; j < 31; j++) {
#pragma unroll
      for (int t = 0; t < 4; t++) o[t] += wv[j] * in[t + j];
    }
#pragma unroll
    for (int t = 0; t < 4; t++) { rv[t] = o[t]; rv[4 + t] = o[t] * o[t]; }
    const float* sb = p.state_b + ((size_t)(l * 128 + n) * 2) * 384 + c;
    zin[0] = sb[0]; zin[1] = sb[384];
#pragma unroll
    for (int t = 0; t < 4; t++) zin[2 + t] = bf2f(inter[(Rs + t) * IW + 768 + c]);
  }
  if (c < 256) {
#pragma unroll
    for (int t = 0; t < 4; t++) {
      cvv[t] = bf2f(inter[(Rs + t) * IW + 1792 + c]);
      rv[8 + t] = cvv[t];
      rv[12 + t] = cvv[t] * cvv[t];
    }
  }
#pragma unroll
  for (int i = 0; i < 16; i++) {
#pragma unroll
    for (int m = 32; m >= 1; m >>= 1) rv[i] += __shfl_xor(rv[i], m);
  }
  if (lane == 0) {
#pragma unroll
    for (int i = 0; i < 16; i++) red[w * 16 + i] = rv[i];
  }
  __syncthreads();
#pragma unroll
  for (int i = 0; i < 16; i++) {
    float s = 0.f;
#pragma unroll
    for (int ww = 0; ww < 8; ww++) s += red[ww * 16 + i];
    rv[i] = s;
  }
  if (c < 384) {
    const float g = p.a_ln_g[l * 384 + c], bb = p.a_ln_b[l * 384 + c];
    const float w0 = p.b_conv_w[(l * 3 + 0) * 384 + c], w1 = p.b_conv_w[(l * 3 + 1) * 384 + c], w2 = p.b_conv_w[(l * 3 + 2) * 384 + c];
#pragma unroll
    for (int t = 0; t < 4; t++) {
      float m_ = rv[t] * (1.f / 384.f);
      float var = rv[4 + t] * (1.f / 384.f) - m_ * m_;
      float rstd = rsqrtf(fmaxf(var, 0.f) + EPS);
      float y = (o[t] - m_) * rstd * g + bb;
      float ya = siluf_(y) * bf2f(inter[(Rs + t) * IW + 384 + c]);
      p.mix[(Rs + t) * DM + c] = f2bf(ya);
      float cv = w0 * zin[t] + w1 * zin[t + 1] + w2 * zin[t + 2];
      float yb = bf2f(inter[(Rs + t) * IW + 1152 + c]) * cv;
      p.mix[(Rs + t) * DM + 384 + c] = f2bf(yb);
    }
    p.out[O_SBS + ((size_t)(l * 128 + n) * 2 + 0) * 384 + c] = zin[4];
    p.out[O_SBS + ((size_t)(l * 128 + n) * 2 + 1) * 384 + c] = zin[5];
  }
  if (c < 256) {
    const float g = p.c_ln_g[l * 256 + c], bb = p.c_ln_b[l * 256 + c];
    const int h = c >> 6;
    float vn[4];
#pragma unroll
    for (int t = 0; t < 4; t++) {
      float m_ = rv[8 + t] * (1.f / 256.f);
      float var = rv[12 + t] * (1.f / 256.f) - m_ * m_;
      float rstd = rsqrtf(fmaxf(var, 0.f) + EPS);
      vn[t] = (cvv[t] - m_) * rstd * g + bb;
      p.out[O_SCV + ((size_t)(l * 128 + n) * 4 + t) * 256 + c] = vn[t];
    }
#pragma unroll
    for (int t = 0; t < 4; t++) {
      float acc = p.c_bs[(l * 4 + h) * 128 + t];
#pragma unroll
      for (int s = 0; s < 4; s++)
        if (s <= t) acc += p.c_ws[((size_t)(l * 4 + h) * 128 + t) * 128 + s] * vn[s];
      float yc = bf2f(inter[(Rs + t) * IW + 1536 + c]) * acc;
      p.mix[(Rs + t) * DM + 768 + c] = f2bf(yc);
    }
  }
  __syncthreads();
}

__device__ void phase2(const Params& p, int l, char* smem) {
  float* red = (float*)(smem + 90112);
  const int nb = gridDim.x, b = blockIdx.x;
  p2_stage_w(p, l, smem);
  for (int it = b; it < 512; it += nb) {
    asm volatile("" ::: "memory");
    p2_ab(p, l, it, smem);
  }
  for (int it = b; it < 128; it += nb) {
    asm volatile("" ::: "memory");
    p2_c(p, l, it, smem);
  }
  for (int it = (b + nb - (128 % nb)) % nb; it < 128; it += nb) {
    asm volatile("" ::: "memory");
    p2_s(p, l, it, red, (float*)smem);
  }
}

__device__ void phase4(const Params& p) {
  const int tid = otid();
  const float* ssq = p.sumsq + (size_t)2 * NTOK;
  for (int idx = blockIdx.x * NT + tid; idx < NTOK * 128; idx += gridDim.x * NT) {
    const int row = idx >> 7, c8 = idx & 127;
    uint4 v = *(const uint4*)(p.xb + (size_t)row * DM + c8 * 8);
    const float rs = rsqrtf(ssq[row] * (1.f / 1024.f) + EPS);
    float4 g0 = *(const float4*)(p.final_g + c8 * 8), g1 = *(const float4*)(p.final_g + c8 * 8 + 4);
    float f[8];
    unpack8(v, f);
    float* o = p.out + (size_t)row * DM + c8 * 8;
    *(float4*)o = make_float4(f[0] * rs * g0.x, f[1] * rs * g0.y, f[2] * rs * g0.z, f[3] * rs * g0.w);
    *(float4*)(o + 4) = make_float4(f[4] * rs * g1.x, f[5] * rs * g1.y, f[6] * rs * g1.z, f[7] * rs * g1.w);
  }
}

#define CEN_WORD(j) (XCD_BAR_WORDS + 64 * (j))
#define BAR_TOTAL_WORDS (XCD_BAR_WORDS + 64 * 16)
__global__ void __launch_bounds__(NT) fwd_megakernel(Params p) {
  extern __shared__ __attribute__((aligned(16))) char smem[];
  __shared__ uint4 xb_words;
  __shared__ uint4 sched_words;
  if (threadIdx.x == 0) {
    xb_words = make_uint4(0u, 0u, 0u, 0u);
    const unsigned x = xb_xcc_id();
    const unsigned slot = xb_add(&p.bar[CEN_WORD(x)], 1u);
    sched_words = make_uint4(slot, 1u, 0u, gridDim.x);
  }
  __syncthreads();
  XcdBarrier gb = xcd_barrier_post(p.bar, (volatile LAS unsigned*)&xb_words);
  const volatile LAS unsigned* sched = (const volatile LAS unsigned*)&sched_words;
  phase0(p, smem);
  xcd_barrier(gb);
  if (threadIdx.x == 0) {
    const unsigned x = xb_xcc_id();
    unsigned prefix = 0u, mine = 1u;
#pragma unroll
    for (unsigned j = 0; j < 16; ++j) {
      const unsigned c = xb_ld(&p.bar[CEN_WORD(j)]);
      prefix += (j < x) ? c : 0u;
      mine = (j == x) ? c : mine;
    }
    volatile LAS unsigned* sw = (volatile LAS unsigned*)&sched_words;
    sw[1] = mine;
    sw[2] = prefix;
  }
  __syncthreads();
#pragma unroll 1
  for (int l = 0; l < 2; l++) {
    phase1(p, l, smem, sched);
    xcd_barrier(gb);
    phase2(p, l, smem);
    xcd_barrier(gb);
    phase3(p, l, smem, sched);
    xcd_barrier(gb);
  }
  phase4(p);
}

extern "C" void kernel_launch(void* const* d_in, const int* in_sizes, int n_in, void* d_out, int out_size, void* d_ws,
                              size_t ws_size, hipStream_t stream) {
  static int grid_blocks = 0;
  if (!grid_blocks) {
    int dev = 0, cus = 0, per_cu = 0;
    hipGetDevice(&dev);
    hipDeviceGetAttribute(&cus, hipDeviceAttributeMultiprocessorCount, dev);
    hipFuncSetAttribute((const void*)fwd_megakernel, hipFuncAttributeMaxDynamicSharedMemorySize, LDS_BYTES);
    hipOccupancyMaxActiveBlocksPerMultiprocessor(&per_cu, (const void*)fwd_megakernel, NT, LDS_BYTES);
    if (per_cu < 1) { fprintf(stderr, "occupancy query returned %d\n", per_cu); per_cu = 1; }
    if (per_cu > 1) per_cu = 1;
    grid_blocks = cus * per_cu;
  }
  Params p{};
  p.x_prompt = (const float*)d_in[0];
  p.x_sample = (const float*)d_in[1];
  p.state_a = (const float*)d_in[2];
  p.state_b = (const float*)d_in[3];
  p.norm_g = (const float*)d_in[4];
  p.w_in = (const float*)d_in[5];
  p.a_conv_w = (const float*)d_in[6];
  p.a_conv_b = (const float*)d_in[7];
  p.a_ln_g = (const float*)d_in[8];
  p.a_ln_b = (const float*)d_in[9];
  p.b_conv_w = (const float*)d_in[10];
  p.c_ln_g = (const float*)d_in[11];
  p.c_ln_b = (const float*)d_in[12];
  p.c_ws = (const float*)d_in[13];
  p.c_bs = (const float*)d_in[14];
  p.w_out = (const float*)d_in[15];
  p.final_g = (const float*)d_in[16];
  p.out = (float*)d_out;
  char* ws = (char*)d_ws;
  size_t off = 0;
  auto take = [&](size_t bytes) { char* r = ws + off; off += (bytes + 255) & ~(size_t)255; return r; };
  p.win_b = (u16*)take((size_t)2 * INW * DM * 2);
  p.wout_b = (u16*)take((size_t)2 * DM * DM * 2);
  p.wc_b = (u16*)take((size_t)2 * 4 * 128 * 128 * 2);
  p.xb = (u16*)take((size_t)NTOK * DM * 2);
  p.inter = (u16*)take((size_t)NTOK * IW * 2);
  p.mix = (u16*)take((size_t)NTOK * DM * 2);
  p.sumsq = (float*)take((size_t)3 * NTOK * 4);
  p.rsw = (float*)take((size_t)2 * 4 * 128 * 4);
  p.bar = (unsigned*)take((size_t)BAR_TOTAL_WORDS * 4);
  hipMemsetAsync(p.bar, 0, (size_t)BAR_TOTAL_WORDS * 4, stream);
  void* args[] = {&p};
  hipError_t e = hipLaunchCooperativeKernel((const void*)fwd_megakernel, dim3(grid_blocks), dim3(NT), args, LDS_BYTES, stream);
  if (e != hipSuccess) fprintf(stderr, "cooperative launch failed: %s (grid %d)\n", hipGetErrorString(e), grid_blocks);
}
```

```cpp
#include <hip/hip_runtime.h>
#include <cstdio>
#include <cstdint>
#include <type_traits>

typedef unsigned short u16;
typedef short bf16x8 __attribute__((ext_vector_type(8)));
typedef float f32x16 __attribute__((ext_vector_type(16)));
typedef unsigned int u32x4 __attribute__((ext_vector_type(4)));

constexpr int NTOK = 16896, NPR = 16384, DM = 1024, INW = 3456, IW = 2048;
constexpr int NT = 512;
constexpr int INWP = 3584;
constexpr int LDS_BYTES = 131072;
constexpr float EPS = 1e-6f;

constexpr size_t O_SAP = 17301504, O_SBP = 17485824, O_SAS = 17498112, O_SBS = 20447232, O_SCV = 20643840;

struct Params {
  const float *x_prompt, *x_sample, *state_a, *state_b, *norm_g, *w_in, *a_conv_w, *a_conv_b, *a_ln_g, *a_ln_b,
      *b_conv_w, *c_ln_g, *c_ln_b, *c_ws, *c_bs, *w_out, *final_g;
  float* out;
  u16 *win_b, *wout_b, *wc_b, *xb, *inter, *mix;
  float *sumsq, *rsw;
  unsigned* bar;
};

__device__ __forceinline__ u16 f2bf(float f) {
  unsigned u = __float_as_uint(f);
  u += 0x7fffu + ((u >> 16) & 1u);
  return (u16)(u >> 16);
}
__device__ __forceinline__ float bf2f(u16 h) { return __uint_as_float(((unsigned)h) << 16); }
__device__ __forceinline__ unsigned pack2(float a, float b) {
  unsigned r;
  asm volatile("v_cvt_pk_bf16_f32 %0, %1, %2" : "=v"(r) : "v"(a), "v"(b));
  return r;
}
__device__ __forceinline__ float sigmoidf_(float x) { return __builtin_amdgcn_rcpf(1.f + __builtin_amdgcn_exp2f(-1.44269504f * x)); }
__device__ __forceinline__ float siluf_(float x) { return x * __builtin_amdgcn_rcpf(1.f + __builtin_amdgcn_exp2f(-1.44269504f * x)); }

__device__ __forceinline__ void unpack8(const uint4& v, float (&f)[8]) {
  f[0] = __uint_as_float(v.x << 16); f[1] = __uint_as_float(v.x & 0xffff0000u);
  f[2] = __uint_as_float(v.y << 16); f[3] = __uint_as_float(v.y & 0xffff0000u);
  f[4] = __uint_as_float(v.z << 16); f[5] = __uint_as_float(v.z & 0xffff0000u);
  f[6] = __uint_as_float(v.w << 16); f[7] = __uint_as_float(v.w & 0xffff0000u);
}
__device__ __forceinline__ uint4 pack8(const float (&f)[8]) {
  uint4 o;
  o.x = pack2(f[0], f[1]); o.y = pack2(f[2], f[3]); o.z = pack2(f[4], f[5]); o.w = pack2(f[6], f[7]);
  return o;
}

__device__ __forceinline__ int otid() {
  int t = threadIdx.x;
  asm volatile("" : "+v"(t));
  return t;
}

__device__ __forceinline__ int vcol_src(int vc);

#define XB_TMO      128
#define XB_XCNT(j)  (256  + 64 * (j))
#define XB_XSUB(j)  (1280 + 64 * (j))
#define XB_XGEN(j)  (2304 + 64 * (j))
#define XB_TOP      3328
#define XB_TOPGEN   3392
#define XCD_BAR_WORDS 3456
#define XB_SPIN_CAP (1u << 18)
#define LAS __attribute__((address_space(3)))

__device__ __forceinline__ unsigned xb_ld(unsigned* p)              { return __hip_atomic_load(p, __ATOMIC_RELAXED, __HIP_MEMORY_SCOPE_AGENT); }
__device__ __forceinline__ unsigned xb_add(unsigned* p, unsigned v) { return __hip_atomic_fetch_add(p, v, __ATOMIC_RELAXED, __HIP_MEMORY_SCOPE_AGENT); }
__device__ __forceinline__ unsigned xb_xcc_id() { return (unsigned)__builtin_amdgcn_s_getreg((3 << 11) | 20) & 0xFu; }
#define XB_SPIN(cond, bar) do { unsigned _sp = 0; while (cond) { __builtin_amdgcn_s_sleep(1); \
    if ((++_sp & 255u) == 0u) { if (xb_ld(&(bar)[XB_TMO])) break; if (_sp > XB_SPIN_CAP) { atomicAdd(&(bar)[XB_TMO], 1u); break; } } } } while (0)

struct XcdBarrier {
  unsigned* bar; unsigned x;
  volatile LAS unsigned* st;
};
__device__ __forceinline__ XcdBarrier xcd_barrier_post(unsigned* bar, volatile LAS unsigned* st) {
  XcdBarrier b; b.bar = bar; b.x = xb_xcc_id(); b.st = st;
  if (threadIdx.x == 0) (void)xb_add(&bar[XB_XCNT(b.x)], 1u);
  return b;
}
__device__ __forceinline__ void xcd_barrier_complete(unsigned* bar, unsigned x, unsigned& nloc, unsigned& nx) {
  const unsigned G = gridDim.x * gridDim.y * gridDim.z;
  unsigned sum, cnt, mine, sp = 0u;
  for (;;) {
    sum = 0u; cnt = 0u; mine = 0u;
#pragma unroll
    for (unsigned j = 0; j < 16; ++j) { const unsigned c = xb_ld(&bar[XB_XCNT(j)]); sum += c; cnt += (c > 0u) ? 1u : 0u; mine = (j == x) ? c : mine; }
    if (sum == G) break;
    __builtin_amdgcn_s_sleep(1);
    if ((++sp & 255u) == 0u) { if (xb_ld(&bar[XB_TMO])) break; if (sp > XB_SPIN_CAP) { atomicAdd(&bar[XB_TMO], 1u); break; } }
  }
  nloc = mine > 0u ? mine : 1u; nx = cnt > 0u ? cnt : 1u;
}
__device__ __forceinline__ void xcd_barrier(const XcdBarrier& b) {
  asm volatile("s_waitcnt vmcnt(0)" ::: "memory");
  __syncthreads();
  if (threadIdx.x == 0) {
    unsigned* bar = b.bar;
    __builtin_amdgcn_s_waitcnt(0);
    unsigned nloc = b.st[0], nx = b.st[1];
    if (nloc == 0u) { xcd_barrier_complete(bar, b.x, nloc, nx); b.st[0] = nloc; b.st[1] = nx; }
    const unsigned old = xb_add(&bar[XB_XSUB(b.x)], 1u);
    const unsigned gen = old / nloc;
    if (old + 1u == (gen + 1u) * nloc) {
      __builtin_amdgcn_fence(__ATOMIC_RELEASE, "agent");
      asm volatile("s_waitcnt vmcnt(0)" ::: "memory");
      const unsigned og = xb_add(&bar[XB_TOP], 1u);
      const unsigned tg = og / nx;
      if (og + 1u == (tg + 1u) * nx) xb_add(&bar[XB_TOPGEN], 1u);
      else XB_SPIN(xb_ld(&bar[XB_TOPGEN]) == tg, bar);
      __builtin_amdgcn_fence(__ATOMIC_ACQUIRE, "agent");
      xb_add(&bar[XB_XGEN(b.x)], 1u);
      asm volatile("s_waitcnt vmcnt(0)" ::: "memory");
    } else {
      XB_SPIN(xb_ld(&bar[XB_XGEN(b.x)]) == gen, bar);
      __builtin_amdgcn_fence(__ATOMIC_ACQUIRE, "agent");
      asm volatile("s_waitcnt vmcnt(0)" ::: "memory");
    }
  }
  __syncthreads();
}

__device__ void p0_transpose(const float* __restrict__ W, int ncols, const float* __restrict__ g, u16* __restrict__ outp,
                             int k0, int v0, bool mapv, float* tile) {
  int tid = otid();
  float vals[16];
#pragma unroll
  for (int i = 0; i < 16; i++) {
    int e = tid + i * NT;
    int kk = e >> 7, v = e & 127;
    int src = mapv ? vcol_src(v0 + v) : (v0 + v);
    float val = 0.f;
    if (src >= 0) val = W[(size_t)(k0 + kk) * ncols + src];
    vals[i] = val;
  }
#pragma unroll
  for (int i = 0; i < 16; i++) {
    int e = tid + i * NT;
    int kk = e >> 7, v = e & 127;
    float val = vals[i];
    if (g) val *= g[k0 + kk];
    tile[kk * 129 + v] = val;
  }
  __syncthreads();
#pragma unroll
  for (int h = 0; h < 2; h++) {
    int v = (tid >> 3) + h * 64, kq = tid & 7;
    const float* tp = tile + (kq * 8) * 129 + v;
    uint4 o;
    o.x = pack2(tp[0], tp[129]);
    o.y = pack2(tp[2 * 129], tp[3 * 129]);
    o.z = pack2(tp[4 * 129], tp[5 * 129]);
    o.w = pack2(tp[6 * 129], tp[7 * 129]);
    *(uint4*)(outp + (size_t)(v0 + v) * 1024 + k0 + kq * 8) = o;
  }
  __syncthreads();
}

__device__ void p0_weights(const Params& p, int l, int rank, int nranks, float* tile) {
  for (int it = rank; it < 16 * 28; it += nranks) {
    int kb = it / 28, vb = it % 28;
    p0_transpose(p.w_in + (size_t)l * DM * INW, INW, p.norm_g + l * DM, p.win_b + (size_t)l * INWP * DM, kb * 64, vb * 128, true, tile);
  }
  for (int it = rank; it < 16 * 8; it += nranks) {
    int kb = it >> 3, vb = it & 7;
    p0_transpose(p.w_out + (size_t)l * DM * DM, DM, nullptr, p.wout_b + (size_t)l * DM * DM, kb * 64, vb * 128, false, tile);
  }
}

__device__ void phase0(const Params& p, char* smem) {
  float* tile = (float*)smem;
  int nb = gridDim.x, b = blockIdx.x, tid = otid();
  const int wave = tid >> 6, lane = tid & 63;
  for (int e = b * NT + tid; e < 2 * NTOK; e += nb * NT) p.sumsq[NTOK + e] = 0.f;
  for (int e = b * NT + tid; e < 2 * 4 * 128 * 128; e += nb * NT) {
    int s = e & 127, t = (e >> 7) & 127;
    p.wc_b[e] = (s <= t) ? f2bf(p.c_ws[e]) : (u16)0;
  }
  for (int r = b * 8 + wave; r < 2 * 4 * 128; r += nb * 8) {
    const int t = r & 127;
    const float* wr = p.c_ws + (size_t)r * 128;
    float s = 0.f;
    if (lane <= t) s += bf2f(f2bf(wr[lane]));
    if (lane + 64 <= t) s += bf2f(f2bf(wr[lane + 64]));
#pragma unroll
    for (int m = 32; m >= 1; m >>= 1) s += __shfl_xor(s, m);
    if (lane == 0) p.rsw[r] = s;
  }
  for (int row = (b * 8 + wave) * 2; row < NTOK; row += nb * 16) {
    const float* xr0 = (row < NPR) ? (p.x_prompt + (size_t)row * DM) : (p.x_sample + (size_t)(row - NPR) * DM);
    const float* xr1 = xr0 + DM;
    float4 v0[4], v1[4];
#pragma unroll
    for (int j = 0; j < 4; j++) { v0[j] = *(const float4*)(xr0 + (j * 64 + lane) * 4); v1[j] = *(const float4*)(xr1 + (j * 64 + lane) * 4); }
    float s0 = 0.f, s1 = 0.f;
#pragma unroll
    for (int j = 0; j < 4; j++) {
      s0 += v0[j].x * v0[j].x + v0[j].y * v0[j].y + v0[j].z * v0[j].z + v0[j].w * v0[j].w;
      s1 += v1[j].x * v1[j].x + v1[j].y * v1[j].y + v1[j].z * v1[j].z + v1[j].w * v1[j].w;
      *(uint2*)(p.xb + (size_t)row * DM + (j * 64 + lane) * 4) = make_uint2(pack2(v0[j].x, v0[j].y), pack2(v0[j].z, v0[j].w));
      *(uint2*)(p.xb + (size_t)(row + 1) * DM + (j * 64 + lane) * 4) = make_uint2(pack2(v1[j].x, v1[j].y), pack2(v1[j].z, v1[j].w));
    }
#pragma unroll
    for (int m = 32; m >= 1; m >>= 1) { s0 += __shfl_xor(s0, m); s1 += __shfl_xor(s1, m); }
    if (lane == 0) { p.sumsq[row] = s0; p.sumsq[row + 1] = s1; }
  }
  p0_weights(p, 0, b, nb, tile);
}

namespace pg8 {
#define PG8_LAS __attribute__((address_space(3)))
typedef unsigned short bf16_t;
typedef short bf16x8 __attribute__((ext_vector_type(8)));
typedef float f32x4 __attribute__((ext_vector_type(4)));
typedef unsigned u32x4 __attribute__((ext_vector_type(4)));
constexpr int BM = 256, BK = 64, HALF = 128, HTB = HALF * BK * 2  , STAGE_BYTES = 8 * HTB, NXCD = 8, WGM = 8;

__host__ __device__ __forceinline__ int lds_byte(int r, int c) { const int st = (r >> 4) * 2 + (c >> 5), rr = r & 15, cc = c & 31, ob = rr * 64 + cc * 2; return st * 1024 + (ob ^ (((ob >> 9) & 1) << 5)); }
__host__ __device__ __forceinline__ void stage_rc(int b, int& R, int& C) { const int st = b / 1024, sb = b % 1024, swz = sb ^ (((sb >> 9) & 1) << 5); R = (st >> 1) * 16 + swz / 64; C = (st & 1) * 32 + (swz % 64) / 2; }
__host__ __device__ __forceinline__ int perm32(int rho) { const int n = rho >> 4, i = rho & 15; return 8 * (i >> 2) + 4 * n + (i & 3); }

struct Unit { int pm, pn; };
struct Gemm { const bf16_t* A; const bf16_t* Bt; int M, N, K; };

struct StaticOrder {
    int nM, nN, nwg, G, c;
    __host__ __device__ void init(int M, int N, int G_, int c_) { nM = M / BM; nN = N / BM; nwg = nM * nN; G = G_; c = c_; }
    __host__ __device__ bool next(int i, Unit& u) const {
        const long L = (long)i * G + c; if (L >= nwg) return false;
        int wgid = (int)L; { const int q = nwg / NXCD, r = nwg % NXCD, xcd = wgid % NXCD, off = wgid / NXCD; wgid = (xcd < r ? xcd * (q + 1) : r * (q + 1) + (xcd - r) * q) + off; }
        const int nig = WGM * nN, gid = wgid / nig, fm = gid * WGM, gsz = (nM - fm) < WGM ? (nM - fm) : WGM;
        u.pm = fm + ((wgid % nig) % gsz); u.pn = (wgid % nig) / gsz; return true;
    }
    __device__ __forceinline__ void a_ready(const Unit&) const {}
    __device__ __forceinline__ void done(const Unit&) const {}
};
__device__ __forceinline__ unsigned cvt_pk_bf16(float lo, float hi) { unsigned r; asm volatile("v_cvt_pk_bf16_f32 %0, %1, %2" : "=v"(r) : "v"(lo), "v"(hi)); return r; }
template <class Epi, class Sched, bool STAMP = false>
__device__ __forceinline__ void gemm_phase(PG8_LAS unsigned char* lds, const Gemm g, const Sched& S, const Epi& E, unsigned long long* stamps) {
    const int tid = otid(), wid = __builtin_amdgcn_readfirstlane(tid >> 6), lane = tid & 63, wr = wid >> 2, wc = wid & 3, fr = lane & 15, fq = lane >> 4;
    const int K = g.K, nt = K / BK;
    int ts_lo = 0, ts_hi = 0, nts = 0; const unsigned long long rt_entry = STAMP ? (unsigned long long)wall_clock64() : 0ull;
#define PG8_STAMP() do { if (STAMP && wid == 0 && nts < 64) { const unsigned long long _c = (unsigned long long)clock64(); \
        ts_lo = (lane == nts) ? (int)(unsigned)_c : ts_lo; ts_hi = (lane == nts) ? (int)(unsigned)(_c >> 32) : ts_hi; ++nts; } } while (0)
    PG8_STAMP();
    unsigned voffA[2], voffB[2];
#pragma unroll
    for (int i = 0; i < 2; ++i) { int R, C; stage_rc(tid * 16 + i * 8192, R, C); const int Rb = Epi::PERM ? ((R & ~31) + perm32(R & 31)) : R;
        voffA[i] = (unsigned)(R * K + C) * 2u; voffB[i] = (unsigned)(Rb * K + C) * 2u; }
    const size_t kstep = (size_t)(BK * 2);
    const size_t hstep = (size_t)HALF * K * 2;
    const size_t tstep = 2 * hstep;
    const unsigned ldsw = (unsigned)wid * 1024u;
    const int aoff = lds_byte(wr * 64 + fr, fq * 8), boff = lds_byte(wc * 32 + fr, fq * 8);
#define PG8_SA(b, h) (((b) * 2 + (h)) * HTB)
#define PG8_SB(b, h) ((4 + (b) * 2 + (h)) * HTB)
#define PG8_STAGE(bufoff, gbase, voff) do { _Pragma("unroll") for (int _i = 0; _i < 2; ++_i) \
        __builtin_amdgcn_global_load_lds((const unsigned*)((const char*)(gbase) + (voff)[_i]), (PG8_LAS unsigned*)(lds + (bufoff) + ldsw + _i * 8192), 16, 0, 0); } while (0)
#define PG8_LDA(dst, b, h) do { _Pragma("unroll") for (int m = 0; m < 4; ++m) _Pragma("unroll") for (int k = 0; k < 2; ++k) dst[m][k] = *(const PG8_LAS bf16x8*)(lds + PG8_SA(b, h) + aoff + m * 2048 + k * 1024); } while (0)
#define PG8_LDB(dst, b, h) do { _Pragma("unroll") for (int n = 0; n < 2; ++n) _Pragma("unroll") for (int k = 0; k < 2; ++k) dst[n][k] = *(const PG8_LAS bf16x8*)(lds + PG8_SB(b, h) + boff + n * 2048 + k * 1024); } while (0)
#define PG8_MMA(ai, bj, At, Bt) do { __builtin_amdgcn_s_setprio(1); _Pragma("unroll") for (int m = 0; m < 4; ++m) _Pragma("unroll") for (int n = 0; n < 2; ++n) _Pragma("unroll") for (int k = 0; k < 2; ++k) \
        acc[ai][bj][m][n] = __builtin_amdgcn_mfma_f32_16x16x32_bf16(Bt[n][k], At[m][k], acc[ai][bj][m][n], 0, 0, 0); __builtin_amdgcn_s_setprio(0); } while (0)
#define PG8_WAIT_V(n) asm volatile("s_waitcnt vmcnt(" #n ")" ::: "memory")
#define PG8_WAIT_L(n) asm volatile("s_waitcnt lgkmcnt(" #n ")" ::: "memory")
#define PG8_BAR __builtin_amdgcn_s_barrier()
#define PG8_SCHED __builtin_amdgcn_sched_barrier(0)
    Unit cur, nxt; int ui = 0;
    if (!S.next(0, cur)) return;
    f32x4 acc[2][2][4][2];
#pragma unroll
    for (int a = 0; a < 2; ++a)
#pragma unroll
        for (int b = 0; b < 2; ++b)
#pragma unroll
            for (int m = 0; m < 4; ++m)
#pragma unroll
                for (int n = 0; n < 2; ++n) acc[a][b][m][n] = (f32x4){0.f, 0.f, 0.f, 0.f};
    bf16x8 At[4][2], B0[2][2], B1[2][2];
    const char* cA = (const char*)g.A + (size_t)cur.pm * tstep; const char* cB = (const char*)g.Bt + (size_t)cur.pn * tstep;
    typename Epi::Pre pre;
    E.preload(cur, wr, fr, pre);
    S.a_ready(cur);
    PG8_STAGE(PG8_SB(0, 0), cB, voffB); PG8_STAGE(PG8_SA(0, 0), cA, voffA); PG8_STAGE(PG8_SB(0, 1), cB + hstep, voffB); PG8_STAGE(PG8_SA(0, 1), cA + hstep, voffA);
    if (wr == 1) PG8_BAR;
    PG8_WAIT_V(4); PG8_BAR;
    PG8_STAGE(PG8_SB(1, 0), cB + kstep, voffB); PG8_STAGE(PG8_SA(1, 0), cA + kstep, voffA); PG8_STAGE(PG8_SB(1, 1), cB + hstep + kstep, voffB);
    PG8_WAIT_V(6); PG8_BAR;
    PG8_STAMP();
    for (;;) {
        const bool has_next = S.next(ui + 1, nxt);
        const char* nA = has_next ? (const char*)g.A + (size_t)nxt.pm * tstep : cA; const char* nB = has_next ? (const char*)g.Bt + (size_t)nxt.pn * tstep : cB;
        for (int t = 0; t < nt; t += 2) {
            const bool last = (t == nt - 2);
            const char* a1 = cA + (size_t)(t + 1) * kstep;
            const char* a2 = last ? nA : cA + (size_t)(t + 2) * kstep; const char* b2 = last ? nB : cB + (size_t)(t + 2) * kstep;
            const char* a3 = a2 + kstep; const char* b3 = b2 + kstep;
            if (last && has_next) S.a_ready(nxt);
            PG8_LDB(B0, 0, 0); PG8_SCHED; PG8_LDA(At, 0, 0); PG8_STAGE(PG8_SA(1, 1), a1 + hstep, voffA);
            PG8_WAIT_L(8); PG8_BAR; PG8_WAIT_L(0); PG8_MMA(0, 0, At, B0); PG8_BAR; PG8_SCHED;
            PG8_LDB(B1, 0, 1); PG8_STAGE(PG8_SB(0, 0), b2, voffB);
            PG8_BAR; PG8_WAIT_L(0); PG8_MMA(0, 1, At, B1); PG8_BAR;
            PG8_LDA(At, 0, 1); PG8_STAGE(PG8_SA(0, 0), a2, voffA);
            PG8_BAR; PG8_WAIT_L(0); PG8_MMA(1, 0, At, B0); PG8_BAR; PG8_SCHED;
            PG8_STAGE(PG8_SB(0, 1), b2 + hstep, voffB);
            PG8_WAIT_V(6); PG8_BAR; PG8_MMA(1, 1, At, B1); PG8_BAR;
            PG8_LDB(B0, 1, 0); PG8_SCHED; PG8_LDA(At, 1, 0); PG8_STAGE(PG8_SA(0, 1), a2 + hstep, voffA);
            PG8_WAIT_L(8); PG8_BAR; PG8_WAIT_L(0); PG8_MMA(0, 0, At, B0); PG8_BAR; PG8_SCHED;
            PG8_LDB(B1, 1, 1); PG8_STAGE(PG8_SB(1, 0), b3, voffB);
            PG8_BAR; PG8_WAIT_L(0); PG8_MMA(0, 1, At, B1); PG8_BAR;
            PG8_LDA(At, 1, 1); PG8_STAGE(PG8_SA(1, 0), a3, voffA);
            PG8_BAR; PG8_WAIT_L(0); PG8_MMA(1, 0, At, B0); PG8_BAR; PG8_SCHED;
            PG8_STAGE(PG8_SB(1, 1), b3 + hstep, voffB);
            PG8_WAIT_V(6); PG8_BAR; PG8_MMA(1, 1, At, B1); PG8_BAR;
        }
        PG8_STAMP();
        if constexpr (!Epi::AFTER_DRAIN) { E(acc, cur, wr, wc, fr, fq, pre); S.done(cur); }
        PG8_STAMP();
        if (!has_next) break;
#pragma unroll
        for (int a = 0; a < 2; ++a)
#pragma unroll
            for (int b = 0; b < 2; ++b)
#pragma unroll
                for (int m = 0; m < 4; ++m)
#pragma unroll
                    for (int n = 0; n < 2; ++n) acc[a][b][m][n] = (f32x4){0.f, 0.f, 0.f, 0.f};
        cur = nxt; cA = nA; cB = nB; ++ui;
        E.preload(cur, wr, fr, pre);
    }
    PG8_WAIT_V(0);
    if (wr == 0) PG8_BAR;
    PG8_BAR;
    if constexpr (Epi::AFTER_DRAIN) { E.fused(acc, cur, wr, wc, fr, fq, lds, wid, lane); S.done(cur); }
    PG8_STAMP();
    if (STAMP && wid == 0) { stamps[lane] = lane < nts ? (((unsigned long long)(unsigned)ts_hi << 32) | (unsigned)ts_lo) : 0ull;
        if (lane == 62) stamps[62] = rt_entry; if (lane == 63) stamps[63] = (unsigned long long)wall_clock64(); }
#undef PG8_STAMP
#undef PG8_SA
#undef PG8_SB
#undef PG8_STAGE
#undef PG8_LDA
#undef PG8_LDB
#undef PG8_MMA
#undef PG8_WAIT_V
#undef PG8_WAIT_L
#undef PG8_BAR
#undef PG8_SCHED
}
}


__device__ __forceinline__ int vcol_src(int vc) {
  const int un = vc >> 8, h = (vc >> 7) & 1, i = vc & 127;
  if (un < 3) return (h ? 384 : 0) + 128 * un + i;
  if (un < 6) return (h ? 1920 : 1152) + 128 * (un - 3) + i;
  if (un < 9) return (h ? 2304 : 1536) + 128 * (un - 6) + i;
  if (un < 11) return (h ? 3200 : 2688) + 128 * (un - 9) + i;
  if (un == 11) return 768 + 128 * h + i;
  if (un == 12) return h ? (2944 + i) : (768 + 256 + i);
  return h ? -1 : (2944 + 128 + i);
}

typedef float f32x4_ __attribute__((ext_vector_type(4)));
struct Epi1 {
  static constexpr bool PERM = true, AFTER_DRAIN = false;
  u16* inter; const float* ssq;
  struct Pre { float s[8]; };
  __device__ __forceinline__ void preload(const pg8::Unit& u, int wr, int fr, Pre& P) const {
#pragma unroll
    for (int ai = 0; ai < 2; ++ai)
#pragma unroll
      for (int m = 0; m < 4; ++m) P.s[ai * 4 + m] = ssq[u.pm * 256 + 64 * wr + fr + 128 * ai + 16 * m];
  }
  __device__ __forceinline__ void operator()(const pg8::f32x4 (&acc)[2][2][4][2], const pg8::Unit& u, int wr, int wc, int fr, int fq, const Pre& P) const {
    const int un = u.pn;
    int k0, ob0, k1 = -1, ob1 = 0;
    if (un < 3) { k0 = 0; ob0 = 128 * un; }
    else if (un < 6) { k0 = 2; ob0 = 768 + 128 * (un - 3); }
    else if (un < 9) { k0 = 3; ob0 = 1152 + 128 * (un - 6); }
    else if (un < 11) { k0 = 3; ob0 = 1536 + 128 * (un - 9); }
    else if (un == 11) { k0 = 1; ob0 = 384; k1 = 1; ob1 = 384 + 128; }
    else if (un == 12) { k0 = 1; ob0 = 384 + 256; k1 = 4; ob1 = 1792; }
    else { k0 = 4; ob0 = 1792 + 128; k1 = -2; }
    const int cl = 32 * wc + 8 * fq;
    const int rbase = u.pm * 256 + 64 * wr + fr;
    auto body = [&](auto K0c, auto K1c) {
      constexpr int K0 = decltype(K0c)::value, K1 = decltype(K1c)::value;
#pragma unroll
      for (int ai = 0; ai < 2; ++ai)
#pragma unroll
        for (int m = 0; m < 4; ++m) {
          const int row = rbase + 128 * ai + 16 * m;
          const float rs = rsqrtf(P.s[ai * 4 + m] * (1.f / 1024.f) + EPS);
          float a[8], b[8], o[8];
#pragma unroll
          for (int i = 0; i < 4; i++) {
            a[i] = acc[ai][0][m][0][i] * rs; a[4 + i] = acc[ai][0][m][1][i] * rs;
            b[i] = acc[ai][1][m][0][i] * rs; b[4 + i] = acc[ai][1][m][1][i] * rs;
          }
          u16* rp = inter + (size_t)row * IW + cl;
          if (K1 == -1) {
#pragma unroll
            for (int i = 0; i < 8; i++) o[i] = (K0 == 0) ? a[i] * sigmoidf_(b[i]) : (K0 == 2) ? a[i] * b[i] : a[i] * siluf_(b[i]);
            *(uint4*)(rp + ob0) = pack8(o);
          } else {
#pragma unroll
            for (int i = 0; i < 8; i++) o[i] = (K0 == 1) ? siluf_(a[i]) : a[i];
            *(uint4*)(rp + ob0) = pack8(o);
            if (K1 != -2) {
#pragma unroll
              for (int i = 0; i < 8; i++) o[i] = (K1 == 1) ? siluf_(b[i]) : b[i];
              *(uint4*)(rp + ob1) = pack8(o);
            }
          }
        }
    };
    using std::integral_constant;
    if (k1 == -1) {
      if (k0 == 0) body(integral_constant<int, 0>{}, integral_constant<int, -1>{});
      else if (k0 == 2) body(integral_constant<int, 2>{}, integral_constant<int, -1>{});
      else body(integral_constant<int, 3>{}, integral_constant<int, -1>{});
    } else if (k1 == 1) body(integral_constant<int, 1>{}, integral_constant<int, 1>{});
    else if (k1 == 4) body(integral_constant<int, 1>{}, integral_constant<int, 4>{});
    else body(integral_constant<int, 4>{}, integral_constant<int, -2>{});
  }
};
struct Epi2 {
  static constexpr bool PERM = true, AFTER_DRAIN = false;
  u16* xb; float* ssq;
  struct Pre {};
  __device__ __forceinline__ void preload(const pg8::Unit&, int, int, Pre&) const {}
  __device__ __forceinline__ void operator()(const pg8::f32x4 (&acc)[2][2][4][2], const pg8::Unit& u, int wr, int wc, int fr, int fq, const Pre&) const {
    const int cl = u.pn * 256 + 32 * wc + 8 * fq;
#pragma unroll
    for (int ai = 0; ai < 2; ++ai)
#pragma unroll
      for (int m = 0; m < 4; ++m) {
        const int row = u.pm * 256 + 128 * ai + 64 * wr + 16 * m + fr;
        u16* rp = xb + (size_t)row * DM + cl;
        uint4 o0 = *(const uint4*)(rp), o1 = *(const uint4*)(rp + 128);
        float x0[8], x1[8];
        unpack8(o0, x0);
        unpack8(o1, x1);
        float ss = 0.f;
#pragma unroll
        for (int i = 0; i < 4; i++) {
          x0[i] += acc[ai][0][m][0][i]; x0[4 + i] += acc[ai][0][m][1][i];
          x1[i] += acc[ai][1][m][0][i]; x1[4 + i] += acc[ai][1][m][1][i];
        }
#pragma unroll
        for (int i = 0; i < 8; i++) ss += x0[i] * x0[i] + x1[i] * x1[i];
        *(uint4*)(rp) = pack8(x0);
        *(uint4*)(rp + 128) = pack8(x1);
        ss += __shfl_xor(ss, 16);
        ss += __shfl_xor(ss, 32);
        if (fq == 0) atomicAdd(ssq + row, ss);
      }
  }
};

__device__ void phase1(const Params& p, int l, char* smem) {
  pg8::Gemm g{p.xb, p.win_b + (size_t)l * INWP * DM, NTOK, INWP, DM};
  pg8::StaticOrder S;
  S.init(NTOK, INWP, (int)gridDim.x, (int)blockIdx.x);
  Epi1 E{p.inter, p.sumsq + (size_t)l * NTOK};
  pg8::gemm_phase<Epi1, pg8::StaticOrder, false>((PG8_LAS unsigned char*)smem, g, S, E, nullptr);
  if (l == 0) {
    const int G = (int)gridDim.x, c = (int)blockIdx.x;
    const int rem = ((NTOK / 256) * (INWP / 256)) % G;
    const int nidle = (rem == 0) ? G : G - rem;
    const int rank = (rem == 0) ? c : c - rem;
    if (rank >= 0) p0_weights(p, 1, rank, nidle, (float*)smem);
  }
}
__device__ void phase3_sample(const Params& p, int l, char* smem) {
  const int tid = otid();
  const int lane = tid & 63, w = tid >> 6;
  const int l32 = lane & 31, lh = lane >> 5;
  float* part = (float*)smem;
  float* ssq = p.sumsq + (size_t)(l + 1) * NTOK;
  for (int T = blockIdx.x; T < 256; T += gridDim.x) {
    const int row0 = NPR + (T >> 4) * 32, col0 = (T & 15) * 64;
    const u16* ap = p.mix + (size_t)(row0 + l32) * DM + w * 128 + lh * 8;
    const u16* bp = p.wout_b + ((size_t)l * DM + col0 + l32) * DM + w * 128 + lh * 8;
    bf16x8 af[8], b0[8], b1[8];
#pragma unroll
    for (int s = 0; s < 8; s++) {
      af[s] = *(const bf16x8*)(ap + s * 16);
      b0[s] = *(const bf16x8*)(bp + s * 16);
      b1[s] = *(const bf16x8*)(bp + (size_t)32 * DM + s * 16);
    }
    f32x16 acc0, acc1;
#pragma unroll
    for (int r = 0; r < 16; r++) { acc0[r] = 0.f; acc1[r] = 0.f; }
#pragma unroll
    for (int s = 0; s < 8; s++) {
      acc0 = __builtin_amdgcn_mfma_f32_32x32x16_bf16(b0[s], af[s], acc0, 0, 0, 0);
      acc1 = __builtin_amdgcn_mfma_f32_32x32x16_bf16(b1[s], af[s], acc1, 0, 0, 0);
    }
#pragma unroll
    for (int r = 0; r < 16; r++) {
      part[((w * 2 + 0) * 16 + r) * 64 + lane] = acc0[r];
      part[((w * 2 + 1) * 16 + r) * 64 + lane] = acc1[r];
    }
    __syncthreads();
    float ss = 0.f;
    const int row = row0 + l32;
#pragma unroll
    for (int ni = 0; ni < 2; ni++) {
#pragma unroll
      for (int rr = 0; rr < 2; rr++) {
        const int r = 2 * w + rr;
        float v = 0.f;
#pragma unroll
        for (int pw = 0; pw < 8; pw++) v += part[((pw * 2 + ni) * 16 + r) * 64 + lane];
        const int col = col0 + ni * 32 + (r & 3) + 8 * (r >> 2) + 4 * lh;
        u16* xp = p.xb + (size_t)row * DM + col;
        v += bf2f(*xp);
        ss += v * v;
        *xp = f2bf(v);
      }
    }
    ss += __shfl_xor(ss, 32);
    if (lh == 0) atomicAdd(ssq + row, ss);
    __syncthreads();
  }
}

__device__ void phase3(const Params& p, int l, char* smem) {
  phase3_sample(p, l, smem);
  pg8::Gemm g{p.mix, p.wout_b + (size_t)l * DM * DM, NPR, DM, DM};
  pg8::StaticOrder S;
  S.init(NPR, DM, (int)gridDim.x, (int)blockIdx.x);
  Epi2 E{p.xb, p.sumsq + (size_t)(l + 1) * NTOK};
  pg8::gemm_phase<Epi2, pg8::StaticOrder, false>((PG8_LAS unsigned char*)smem, g, S, E, nullptr);
}

__device__ void p2_stage_w(const Params& p, int l, char* smem) {
  const int tid = otid();
  const float4* src = (const float4*)(p.a_conv_w + (size_t)l * 31 * 384);
  for (int f = tid; f < 36 * 96; f += NT) {
    int j = f / 96, q = f - j * 96;
    float4 v = make_float4(0.f, 0.f, 0.f, 0.f);
    if (j < 31) v = src[f];
    ((float4*)smem)[(j * 2 + (q & 1)) * 48 + (q >> 1)] = v;
  }
}

struct ATileRegs { u32x4 r0, r1, r2, r3, r4, r5; };
__device__ __forceinline__ void p2_ab_load(const Params& p, int it, ATileRegs& A) {
  const int tid = otid();
  const int R0 = it * 32;
  const int spos = R0 & 2047;
  const u16* __restrict__ inter = p.inter;
  auto ld = [&](int i) -> u32x4 {
    const int e = tid + i * NT;
    const int r = e / 48, ch = e - r * 48;
    u32x4 v = {0u, 0u, 0u, 0u};
    if (r < 62 && spos - 30 + r >= 0) v = *(const u32x4*)(inter + (size_t)(R0 - 30 + r) * IW + ch * 8);
    return v;
  };
  A.r0 = ld(0); A.r1 = ld(1); A.r2 = ld(2); A.r3 = ld(3); A.r4 = ld(4); A.r5 = ld(5);
}
__device__ __forceinline__ void p2_ab_store(const ATileRegs& A, char* smem) {
  const int tid = otid();
  char* atile = smem + 55296 + tid * 16;
  *(u32x4*)(atile) = A.r0;
  *(u32x4*)(atile + 1 * NT * 16) = A.r1;
  *(u32x4*)(atile + 2 * NT * 16) = A.r2;
  *(u32x4*)(atile + 3 * NT * 16) = A.r3;
  *(u32x4*)(atile + 4 * NT * 16) = A.r4;
  *(u32x4*)(atile + 5 * NT * 16) = A.r5;
}

typedef float f32x2 __attribute__((ext_vector_type(2)));
__device__ void p2_ab(const Params& p, int l, int it, char* smem) {
  const int tid = otid();
  const int lane = tid & 63, w = tid >> 6;
  const bool active = lane < 48;
  const int o = active ? lane : 47;
  const int R0 = it * 32;
  const int spos = R0 & 2047;
  const int bseq = R0 >> 11;
  const bool last = (spos == 2016);
  const u16* __restrict__ inter = p.inter;
  char* atile = smem + 55296;
  const float4* wts = (const float4*)smem;
  const size_t rowq = (size_t)R0 + 4 * w;
  uint4 szv[4], gbv[4], zv[6];
#pragma unroll
  for (int t = 0; t < 4; t++) {
    szv[t] = *(const uint4*)(inter + (rowq + t) * IW + 384 + 8 * o);
    gbv[t] = *(const uint4*)(inter + (rowq + t) * IW + 1152 + 8 * o);
  }
#pragma unroll
  for (int s2 = 0; s2 < 6; s2++) {
    zv[s2] = make_uint4(0, 0, 0, 0);
    if (spos + 4 * w - 2 + s2 >= 0) zv[s2] = *(const uint4*)(inter + (rowq - 2 + s2) * IW + 768 + 8 * o);
  }
  f32x2 acc2[4][4];
  {
    float4 b0 = *(const float4*)(p.a_conv_b + l * 384 + 8 * o), b1 = *(const float4*)(p.a_conv_b + l * 384 + 8 * o + 4);
#pragma unroll
    for (int t = 0; t < 4; t++) {
      acc2[t][0] = (f32x2){b0.x, b0.y}; acc2[t][1] = (f32x2){b0.z, b0.w};
      acc2[t][2] = (f32x2){b1.x, b1.y}; acc2[t][3] = (f32x2){b1.z, b1.w};
    }
  }
  f32x2 wwin[4][4];
#pragma unroll
  for (int u = 0; u < 4; u++)
#pragma unroll
    for (int c = 0; c < 4; c++) wwin[u][c] = (f32x2){0.f, 0.f};
  const char* arow = atile + (4 * w) * 768 + o * 16;
#pragma unroll 1
  for (int s4 = 0; s4 < 36; s4 += 4) {
    const char* ar = arow + s4 * 768;
    const float4* wr = wts + (s4 * 2) * 48 + o;
#pragma unroll
    for (int u = 0; u < 4; u++) {
      uint4 av = *(const uint4*)(ar + u * 768);
      float4 wa = wr[(u * 2) * 48], wb = wr[(u * 2 + 1) * 48];
      f32x2 v[4];
      v[0] = (f32x2){__uint_as_float(av.x << 16), __uint_as_float(av.x & 0xffff0000u)};
      v[1] = (f32x2){__uint_as_float(av.y << 16), __uint_as_float(av.y & 0xffff0000u)};
      v[2] = (f32x2){__uint_as_float(av.z << 16), __uint_as_float(av.z & 0xffff0000u)};
      v[3] = (f32x2){__uint_as_float(av.w << 16), __uint_as_float(av.w & 0xffff0000u)};
      wwin[u][0] = (f32x2){wa.x, wa.y}; wwin[u][1] = (f32x2){wa.z, wa.w};
      wwin[u][2] = (f32x2){wb.x, wb.y}; wwin[u][3] = (f32x2){wb.z, wb.w};
#pragma unroll
      for (int t = 0; t < 4; t++) {
#pragma unroll
        for (int c = 0; c < 4; c++) acc2[t][c] = __builtin_elementwise_fma(wwin[(u - t) & 3][c], v[c], acc2[t][c]);
      }
    }
  }
  if (last && active) {
#pragma unroll
    for (int t = 0; t < 4; t++) {
      int pp = spos + 4 * w + t;
      if (pp >= 2018) {
        float v[8];
        unpack8(*(const uint4*)(arow + (30 + t) * 768), v);
        float* so = p.out + O_SAP + ((size_t)(l * 8 + bseq) * 30 + (pp - 2018)) * 384 + 8 * o;
        *(float4*)so = make_float4(v[0], v[1], v[2], v[3]);
        *(float4*)(so + 4) = make_float4(v[4], v[5], v[6], v[7]);
      }
    }
  }
  float acc[4][8];
#pragma unroll
  for (int t = 0; t < 4; t++)
#pragma unroll
    for (int c = 0; c < 4; c++) { acc[t][2 * c] = acc2[t][c].x; acc[t][2 * c + 1] = acc2[t][c].y; }
  float s1[4], s2[4];
#pragma unroll
  for (int t = 0; t < 4; t++) {
    float a = 0.f, b = 0.f;
#pragma unroll
    for (int c = 0; c < 8; c++) { a += acc[t][c]; b += acc[t][c] * acc[t][c]; }
    s1[t] = active ? a : 0.f;
    s2[t] = active ? b : 0.f;
  }
#pragma unroll
  for (int t = 0; t < 4; t++) {
#pragma unroll
    for (int m = 32; m >= 1; m >>= 1) { s1[t] += __shfl_xor(s1[t], m); s2[t] += __shfl_xor(s2[t], m); }
  }
  {
    float g8[8], b8[8];
    {
      float4 a0 = *(const float4*)(p.a_ln_g + l * 384 + 8 * o), a1 = *(const float4*)(p.a_ln_g + l * 384 + 8 * o + 4);
      float4 c0 = *(const float4*)(p.a_ln_b + l * 384 + 8 * o), c1 = *(const float4*)(p.a_ln_b + l * 384 + 8 * o + 4);
      g8[0] = a0.x; g8[1] = a0.y; g8[2] = a0.z; g8[3] = a0.w; g8[4] = a1.x; g8[5] = a1.y; g8[6] = a1.z; g8[7] = a1.w;
      b8[0] = c0.x; b8[1] = c0.y; b8[2] = c0.z; b8[3] = c0.w; b8[4] = c1.x; b8[5] = c1.y; b8[6] = c1.z; b8[7] = c1.w;
    }
#pragma unroll
    for (int t = 0; t < 4; t++) {
      float mu = s1[t] * (1.f / 384.f);
      float var = s2[t] * (1.f / 384.f) - mu * mu;
      float rstd = rsqrtf(fmaxf(var, 0.f) + EPS);
      float sz[8], y[8];
      unpack8(szv[t], sz);
#pragma unroll
      for (int c = 0; c < 8; c++) y[c] = siluf_((acc[t][c] - mu) * rstd * g8[c] + b8[c]) * sz[c];
      if (active) *(uint4*)(p.mix + (rowq + t) * DM + 8 * o) = pack8(y);
    }
  }
  {
    float w0[8], w1[8], w2[8];
    {
      const float* bw = p.b_conv_w + (size_t)l * 3 * 384 + 8 * o;
      float4 a0 = *(const float4*)(bw), a1 = *(const float4*)(bw + 4);
      float4 c0 = *(const float4*)(bw + 384), c1 = *(const float4*)(bw + 384 + 4);
      float4 d0 = *(const float4*)(bw + 768), d1 = *(const float4*)(bw + 768 + 4);
      w0[0] = a0.x; w0[1] = a0.y; w0[2] = a0.z; w0[3] = a0.w; w0[4] = a1.x; w0[5] = a1.y; w0[6] = a1.z; w0[7] = a1.w;
      w1[0] = c0.x; w1[1] = c0.y; w1[2] = c0.z; w1[3] = c0.w; w1[4] = c1.x; w1[5] = c1.y; w1[6] = c1.z; w1[7] = c1.w;
      w2[0] = d0.x; w2[1] = d0.y; w2[2] = d0.z; w2[3] = d0.w; w2[4] = d1.x; w2[5] = d1.y; w2[6] = d1.z; w2[7] = d1.w;
    }
    float z[6][8];
#pragma unroll
    for (int s2i = 0; s2i < 6; s2i++) unpack8(zv[s2i], z[s2i]);
#pragma unroll
    for (int t = 0; t < 4; t++) {
      float gb[8], y[8];
      unpack8(gbv[t], gb);
#pragma unroll
      for (int c = 0; c < 8; c++) y[c] = gb[c] * (w0[c] * z[t][c] + w1[c] * z[t + 1][c] + w2[c] * z[t + 2][c]);
      if (active) *(uint4*)(p.mix + (rowq + t) * DM + 384 + 8 * o) = pack8(y);
    }
    if (last && w == 7 && active) {
#pragma unroll
      for (int i = 0; i < 2; i++) {
        float* so = p.out + O_SBP + ((size_t)(l * 8 + bseq) * 2 + i) * 384 + 8 * o;
        *(float4*)so = make_float4(z[4 + i][0], z[4 + i][1], z[4 + i][2], z[4 + i][3]);
        *(float4*)(so + 4) = make_float4(z[4 + i][4], z[4 + i][5], z[4 + i][6], z[4 + i][7]);
      }
    }
  }
  __syncthreads();
}

__device__ void p2_c(const Params& p, int l, int ci, char* smem) {
  const int tid = otid();
  const int lane = tid & 63, w = tid >> 6;
  const int l32 = lane & 31, lh = lane >> 5;
  const int R0 = ci * 128;
  const u16* __restrict__ inter = p.inter;
  bf16x8 wf[4][8];
  {
    const u16* wb = p.wc_b + ((size_t)(l * 4 + (w >> 1)) * 128 + l32) * 128 + lh * 8;
#pragma unroll
    for (int ks = 0; ks < 8; ks++)
#pragma unroll
      for (int ti = 0; ti < 4; ti++)
        if (ti >= (ks >> 1)) wf[ti][ks] = *(const bf16x8*)(wb + (size_t)ti * 32 * 128 + ks * 16);
  }
  {
    const int tok = tid >> 2, qd = tid & 3;
    const u16* src = inter + (size_t)(R0 + tok) * IW + 1792 + qd * 64;
    uint4 xv[8];
#pragma unroll
    for (int i = 0; i < 8; i++) xv[i] = *(const uint4*)(src + i * 8);
    float s1 = 0.f, s2 = 0.f;
#pragma unroll
    for (int i = 0; i < 8; i++) {
      float f[8];
      unpack8(xv[i], f);
#pragma unroll
      for (int k = 0; k < 8; k++) { s1 += f[k]; s2 += f[k] * f[k]; }
    }
    s1 += __shfl_xor(s1, 1); s2 += __shfl_xor(s2, 1);
    s1 += __shfl_xor(s1, 2); s2 += __shfl_xor(s2, 2);
    const float mu = s1 * (1.f / 256.f);
    const float rstd = rsqrtf(fmaxf(s2 * (1.f / 256.f) - mu * mu, 0.f) + EPS);
    const int tch = tok >> 3, tlo = (tok & 7) * 2;
#pragma unroll
    for (int i = 0; i < 8; i++) {
      float f[8];
      unpack8(xv[i], f);
#pragma unroll
      for (int k = 0; k < 8; k++) {
        const int c = qd * 64 + i * 8 + k;
        *(u16*)(smem + c * 256 + ((tch ^ (c & 15)) << 4) + tlo) = f2bf((f[k] - mu) * rstd);
      }
    }
  }
  __syncthreads();
  {
    const int h = w >> 1;
    const int cbase = h * 64 + (w & 1) * 32;
    const int c = cbase + l32;
    f32x16 acc[4];
#pragma unroll
    for (int ti = 0; ti < 4; ti++)
#pragma unroll
      for (int r = 0; r < 16; r++) acc[ti][r] = 0.f;
#pragma unroll
    for (int ks = 0; ks < 8; ks++) {
      bf16x8 vfrag = *(const bf16x8*)(smem + c * 256 + (((ks * 2 + lh) ^ (c & 15)) << 4));
#pragma unroll
      for (int ti = 0; ti < 4; ti++) {
        if (ti >= (ks >> 1)) acc[ti] = __builtin_amdgcn_mfma_f32_32x32x16_bf16(vfrag, wf[ti][ks], acc[ti], 0, 0, 0);
      }
    }
    float4 gl[4], bl[4];
#pragma unroll
    for (int g = 0; g < 4; g++) {
      gl[g] = *(const float4*)(p.c_ln_g + l * 256 + cbase + 8 * g + 4 * lh);
      bl[g] = *(const float4*)(p.c_ln_b + l * 256 + cbase + 8 * g + 4 * lh);
    }
#pragma unroll
    for (int ti = 0; ti < 4; ti++) {
      const int t = ti * 32 + l32;
      const size_t row = (size_t)R0 + t;
      const float rsw = p.rsw[(l * 4 + h) * 128 + t];
      const float bs = p.c_bs[(l * 4 + h) * 128 + t];
#pragma unroll
      for (int g = 0; g < 4; g++) {
        const int d0 = cbase + 8 * g + 4 * lh;
        uint2 gc = *(const uint2*)(inter + row * IW + 1536 + d0);
        float y0 = __uint_as_float(gc.x << 16) * (gl[g].x * acc[ti][4 * g + 0] + bl[g].x * rsw + bs);
        float y1 = __uint_as_float(gc.x & 0xffff0000u) * (gl[g].y * acc[ti][4 * g + 1] + bl[g].y * rsw + bs);
        float y2 = __uint_as_float(gc.y << 16) * (gl[g].z * acc[ti][4 * g + 2] + bl[g].z * rsw + bs);
        float y3 = __uint_as_float(gc.y & 0xffff0000u) * (gl[g].w * acc[ti][4 * g + 3] + bl[g].w * rsw + bs);
        *(uint2*)(p.mix + row * DM + 768 + d0) = make_uint2(pack2(y0, y1), pack2(y2, y3));
      }
    }
  }
  __syncthreads();
}

__device__ void p2_s(const Params& p, int l, int n, float* red, float* smem_f) {
  const int tid = otid();
  const int lane = tid & 63, w = tid >> 6;
  const int c = tid;
  const size_t Rs = NPR + (size_t)n * 4;
  const u16* __restrict__ inter = p.inter;
  float rv[16];
#pragma unroll
  for (int i = 0; i < 16; i++) rv[i] = 0.f;
  float o[4] = {0.f, 0.f, 0.f, 0.f};
  float zin[6] = {0.f, 0.f, 0.f, 0.f, 0.f, 0.f};
  float cvv[4] = {0.f, 0.f, 0.f, 0.f};
  if (c < 384) {
    float in[34], wv[31];
    const float* sa = p.state_a + ((size_t)(l * 128 + n) * 30) * 384 + c;
    float* so = p.out + O_SAS + ((size_t)(l * 128 + n) * 30) * 384 + c;
#pragma unroll
    for (int i = 0; i < 30; i++) in[i] = sa[i * 384];
#pragma unroll
    for (int t = 0; t < 4; t++) in[30 + t] = bf2f(inter[(Rs + t) * IW + c]);
#pragma unroll
    for (int j = 0; j < 31; j++) wv[j] = p.a_conv_w[(l * 31 + j) * 384 + c];
    const float bias = p.a_conv_b[l * 384 + c];
#pragma unroll
    for (int i = 0; i < 30; i++) so[i * 384] = in[4 + i];
#pragma unroll
    for (int t = 0; t < 4; t++) o[t] = bias;
#pragma unroll
    for (int j = 0; j < 31; j++) {
#pragma unroll
      for (int t = 0; t < 4; t++) o[t] += wv[j] * in[t + j];
    }
#pragma unroll
    for (int t = 0; t < 4; t++) { rv[t] = o[t]; rv[4 + t] = o[t] * o[t]; }
    const float* sb = p.state_b + ((size_t)(l * 128 + n) * 2) * 384 + c;
    zin[0] = sb[0]; zin[1] = sb[384];
#pragma unroll
    for (int t = 0; t < 4; t++) zin[2 + t] = bf2f(inter[(Rs + t) * IW + 768 + c]);
  }
  if (c < 256) {
#pragma unroll
    for (int t = 0; t < 4; t++) {
      cvv[t] = bf2f(inter[(Rs + t) * IW + 1792 + c]);
      rv[8 + t] = cvv[t];
      rv[12 + t] = cvv[t] * cvv[t];
    }
  }
#pragma unroll
  for (int i = 0; i < 16; i++) {
#pragma unroll
    for (int m = 32; m >= 1; m >>= 1) rv[i] += __shfl_xor(rv[i], m);
  }
  if (lane == 0) {
#pragma unroll
    for (int i = 0; i < 16; i++) red[w * 16 + i] = rv[i];
  }
  __syncthreads();
#pragma unroll
  for (int i = 0; i < 16; i++) {
    float s = 0.f;
#pragma unroll
    for (int ww = 0; ww < 8; ww++) s += red[ww * 16 + i];
    rv[i] = s;
  }
  if (c < 384) {
    const float g = p.a_ln_g[l * 384 + c], bb = p.a_ln_b[l * 384 + c];
    const float w0 = p.b_conv_w[(l * 3 + 0) * 384 + c], w1 = p.b_conv_w[(l * 3 + 1) * 384 + c], w2 = p.b_conv_w[(l * 3 + 2) * 384 + c];
#pragma unroll
    for (int t = 0; t < 4; t++) {
      float m_ = rv[t] * (1.f / 384.f);
      float var = rv[4 + t] * (1.f / 384.f) - m_ * m_;
      float rstd = rsqrtf(fmaxf(var, 0.f) + EPS);
      float y = (o[t] - m_) * rstd * g + bb;
      float ya = siluf_(y) * bf2f(inter[(Rs + t) * IW + 384 + c]);
      p.mix[(Rs + t) * DM + c] = f2bf(ya);
      float cv = w0 * zin[t] + w1 * zin[t + 1] + w2 * zin[t + 2];
      float yb = bf2f(inter[(Rs + t) * IW + 1152 + c]) * cv;
      p.mix[(Rs + t) * DM + 384 + c] = f2bf(yb);
    }
    p.out[O_SBS + ((size_t)(l * 128 + n) * 2 + 0) * 384 + c] = zin[4];
    p.out[O_SBS + ((size_t)(l * 128 + n) * 2 + 1) * 384 + c] = zin[5];
  }
  if (c < 256) {
    const float g = p.c_ln_g[l * 256 + c], bb = p.c_ln_b[l * 256 + c];
    const int h = c >> 6;
    float vn[4];
#pragma unroll
    for (int t = 0; t < 4; t++) {
      float m_ = rv[8 + t] * (1.f / 256.f);
      float var = rv[12 + t] * (1.f / 256.f) - m_ * m_;
      float rstd = rsqrtf(fmaxf(var, 0.f) + EPS);
      vn[t] = (cvv[t] - m_) * rstd * g + bb;
      p.out[O_SCV + ((size_t)(l * 128 + n) * 4 + t) * 256 + c] = vn[t];
    }
#pragma unroll
    for (int t = 0; t < 4; t++) {
      float acc = p.c_bs[(l * 4 + h) * 128 + t];
#pragma unroll
      for (int s = 0; s < 4; s++)
        if (s <= t) acc += p.c_ws[((size_t)(l * 4 + h) * 128 + t) * 128 + s] * vn[s];
      float yc = bf2f(inter[(Rs + t) * IW + 1536 + c]) * acc;
      p.mix[(Rs + t) * DM + 768 + c] = f2bf(yc);
    }
  }
  __syncthreads();
}

__device__ void phase2(const Params& p, int l, char* smem) {
  float* red = (float*)(smem + 90112);
  const int nb = gridDim.x, b = blockIdx.x;
  p2_stage_w(p, l, smem);
  {
    ATileRegs A;
    if (b < 512) p2_ab_load(p, b, A);
#pragma unroll 1
    for (int it = b; it < 512; it += nb) {
      p2_ab_store(A, smem);
      __syncthreads();
      const int nx = (it + nb < 512) ? it + nb : it;
      p2_ab_load(p, nx, A);
      p2_ab(p, l, it, smem);
    }
  }
  for (int it = b; it < 128; it += nb) {
    asm volatile("" ::: "memory");
    p2_c(p, l, it, smem);
  }
  for (int it = (b + nb - (128 % nb)) % nb; it < 128; it += nb) {
    asm volatile("" ::: "memory");
    p2_s(p, l, it, red, (float*)smem);
  }
}

__device__ void phase4(const Params& p) {
  const int tid = otid();
  const float* ssq = p.sumsq + (size_t)2 * NTOK;
  for (int idx = blockIdx.x * NT + tid; idx < NTOK * 128; idx += gridDim.x * NT) {
    const int row = idx >> 7, c8 = idx & 127;
    uint4 v = *(const uint4*)(p.xb + (size_t)row * DM + c8 * 8);
    const float rs = rsqrtf(ssq[row] * (1.f / 1024.f) + EPS);
    float4 g0 = *(const float4*)(p.final_g + c8 * 8), g1 = *(const float4*)(p.final_g + c8 * 8 + 4);
    float f[8];
    unpack8(v, f);
    float* o = p.out + (size_t)row * DM + c8 * 8;
    *(float4*)o = make_float4(f[0] * rs * g0.x, f[1] * rs * g0.y, f[2] * rs * g0.z, f[3] * rs * g0.w);
    *(float4*)(o + 4) = make_float4(f[4] * rs * g1.x, f[5] * rs * g1.y, f[6] * rs * g1.z, f[7] * rs * g1.w);
  }
}

#define CEN_WORD(j) (XCD_BAR_WORDS + 64 * (j))
#define BAR_TOTAL_WORDS (XCD_BAR_WORDS + 64 * 16)
__global__ void __launch_bounds__(NT) fwd_megakernel(Params p) {
  extern __shared__ __attribute__((aligned(16))) char smem[];
  __shared__ uint4 xb_words;
  __shared__ uint4 sched_words;
  if (threadIdx.x == 0) {
    xb_words = make_uint4(0u, 0u, 0u, 0u);
    const unsigned x = xb_xcc_id();
    const unsigned slot = xb_add(&p.bar[CEN_WORD(x)], 1u);
    sched_words = make_uint4(slot, 1u, 0u, gridDim.x);
  }
  __syncthreads();
  XcdBarrier gb = xcd_barrier_post(p.bar, (volatile LAS unsigned*)&xb_words);
  const volatile LAS unsigned* sched = (const volatile LAS unsigned*)&sched_words;
  phase0(p, smem);
  xcd_barrier(gb);
  if (threadIdx.x == 0) {
    const unsigned x = xb_xcc_id();
    unsigned prefix = 0u, mine = 1u;
#pragma unroll
    for (unsigned j = 0; j < 16; ++j) {
      const unsigned c = xb_ld(&p.bar[CEN_WORD(j)]);
      prefix += (j < x) ? c : 0u;
      mine = (j == x) ? c : mine;
    }
    volatile LAS unsigned* sw = (volatile LAS unsigned*)&sched_words;
    sw[1] = mine;
    sw[2] = prefix;
  }
  __syncthreads();
#pragma unroll 1
  for (int l = 0; l < 2; l++) {
    phase1(p, l, smem);
    xcd_barrier(gb);
    phase2(p, l, smem);
    xcd_barrier(gb);
    phase3(p, l, smem);
    xcd_barrier(gb);
  }
  phase4(p);
}

extern "C" void kernel_launch(void* const* d_in, const int* in_sizes, int n_in, void* d_out, int out_size, void* d_ws,
                              size_t ws_size, hipStream_t stream) {
  static int grid_blocks = 0;
  if (!grid_blocks) {
    int dev = 0, cus = 0, per_cu = 0;
    hipGetDevice(&dev);
    hipDeviceGetAttribute(&cus, hipDeviceAttributeMultiprocessorCount, dev);
    hipFuncSetAttribute((const void*)fwd_megakernel, hipFuncAttributeMaxDynamicSharedMemorySize, LDS_BYTES);
    hipOccupancyMaxActiveBlocksPerMultiprocessor(&per_cu, (const void*)fwd_megakernel, NT, LDS_BYTES);
    if (per_cu < 1) { fprintf(stderr, "occupancy query returned %d\n", per_cu); per_cu = 1; }
    if (per_cu > 1) per_cu = 1;
    grid_blocks = cus * per_cu;
  }
  Params p{};
  p.x_prompt = (const float*)d_in[0];
  p.x_sample = (const float*)d_in[1];
  p.state_a = (const float*)d_in[2];
  p.state_b = (const float*)d_in[3];
  p.norm_g = (const float*)d_in[4];
  p.w_in = (const float*)d_in[5];
  p.a_conv_w = (const float*)d_in[6];
  p.a_conv_b = (const float*)d_in[7];
  p.a_ln_g = (const float*)d_in[8];
  p.a_ln_b = (const float*)d_in[9];
  p.b_conv_w = (const float*)d_in[10];
  p.c_ln_g = (const float*)d_in[11];
  p.c_ln_b = (const float*)d_in[12];
  p.c_ws = (const float*)d_in[13];
  p.c_bs = (const float*)d_in[14];
  p.w_out = (const float*)d_in[15];
  p.final_g = (const float*)d_in[16];
  p.out = (float*)d_out;
  char* ws = (char*)d_ws;
  size_t off = 0;
  auto take = [&](size_t bytes) { char* r = ws + off; off += (bytes + 255) & ~(size_t)255; return r; };
  p.win_b = (u16*)take((size_t)2 * 3584 * DM * 2);
  p.wout_b = (u16*)take((size_t)2 * DM * DM * 2);
  p.wc_b = (u16*)take((size_t)2 * 4 * 128 * 128 * 2);
  p.xb = (u16*)take((size_t)NTOK * DM * 2);
  p.inter = (u16*)take((size_t)NTOK * IW * 2);
  p.mix = (u16*)take((size_t)NTOK * DM * 2);
  p.sumsq = (float*)take((size_t)3 * NTOK * 4);
  p.rsw = (float*)take((size_t)2 * 4 * 128 * 4);
  p.bar = (unsigned*)take((size_t)BAR_TOTAL_WORDS * 4);
  hipMemsetAsync(p.bar, 0, (size_t)BAR_TOTAL_WORDS * 4, stream);
  void* args[] = {&p};
  hipError_t e = hipLaunchCooperativeKernel((const void*)fwd_megakernel, dim3(grid_blocks), dim3(NT), args, LDS_BYTES, stream);
  if (e != hipSuccess) fprintf(stderr, "cooperative launch failed: %s (grid %d)\n", hipGetErrorString(e), grid_blocks);
}
```

```cpp
#include <hip/hip_runtime.h>
#include <cstdio>
#include <cstdint>
#include <type_traits>

typedef unsigned short u16;
typedef short bf16x8 __attribute__((ext_vector_type(8)));
typedef float f32x16 __attribute__((ext_vector_type(16)));
typedef unsigned int u32x4 __attribute__((ext_vector_type(4)));

constexpr int NTOK = 16896, NPR = 16384, DM = 1024, INW = 3456, IW = 2048;
constexpr int NT = 512;
constexpr int INWP = 3584;
constexpr int LDS_BYTES = 131072;
constexpr float EPS = 1e-6f;

constexpr size_t O_SAP = 17301504, O_SBP = 17485824, O_SAS = 17498112, O_SBS = 20447232, O_SCV = 20643840;

struct Params {
  const float *x_prompt, *x_sample, *state_a, *state_b, *norm_g, *w_in, *a_conv_w, *a_conv_b, *a_ln_g, *a_ln_b,
      *b_conv_w, *c_ln_g, *c_ln_b, *c_ws, *c_bs, *w_out, *final_g;
  float* out;
  u16 *win_b, *wout_b, *wc_b, *xb, *inter, *mix;
  float *sumsq, *rsw;
  unsigned* bar;
};

__device__ __forceinline__ u16 f2bf(float f) {
  unsigned u = __float_as_uint(f);
  u += 0x7fffu + ((u >> 16) & 1u);
  return (u16)(u >> 16);
}
__device__ __forceinline__ float bf2f(u16 h) { return __uint_as_float(((unsigned)h) << 16); }
__device__ __forceinline__ unsigned pack2(float a, float b) {
  unsigned r;
  asm volatile("v_cvt_pk_bf16_f32 %0, %1, %2" : "=v"(r) : "v"(a), "v"(b));
  return r;
}
__device__ __forceinline__ float sigmoidf_(float x) { return __builtin_amdgcn_rcpf(1.f + __builtin_amdgcn_exp2f(-1.44269504f * x)); }
__device__ __forceinline__ float siluf_(float x) { return x * __builtin_amdgcn_rcpf(1.f + __builtin_amdgcn_exp2f(-1.44269504f * x)); }

__device__ __forceinline__ void unpack8(const uint4& v, float (&f)[8]) {
  f[0] = __uint_as_float(v.x << 16); f[1] = __uint_as_float(v.x & 0xffff0000u);
  f[2] = __uint_as_float(v.y << 16); f[3] = __uint_as_float(v.y & 0xffff0000u);
  f[4] = __uint_as_float(v.z << 16); f[5] = __uint_as_float(v.z & 0xffff0000u);
  f[6] = __uint_as_float(v.w << 16); f[7] = __uint_as_float(v.w & 0xffff0000u);
}
__device__ __forceinline__ uint4 pack8(const float (&f)[8]) {
  uint4 o;
  o.x = pack2(f[0], f[1]); o.y = pack2(f[2], f[3]); o.z = pack2(f[4], f[5]); o.w = pack2(f[6], f[7]);
  return o;
}

__device__ __forceinline__ __amdgpu_buffer_rsrc_t mk_rsrc(void* base, unsigned bytes) {
  return __builtin_amdgcn_make_buffer_rsrc(base, 0, bytes, 0x00020000);
}
__device__ __forceinline__ void st16_wt(__amdgpu_buffer_rsrc_t r, unsigned byte_off, const uint4& v) {
  u32x4 d = {v.x, v.y, v.z, v.w};
  __builtin_amdgcn_raw_buffer_store_b128(d, r, byte_off, 0, 16);
}

__device__ __forceinline__ int otid() {
  int t = threadIdx.x;
  asm volatile("" : "+v"(t));
  return t;
}

__device__ __forceinline__ int vcol_src(int vc);

#define XB_TMO      128
#define XB_XCNT(j)  (256  + 64 * (j))
#define XB_XSUB(j)  (1280 + 64 * (j))
#define XB_XGEN(j)  (2304 + 64 * (j))
#define XB_TOP      3328
#define XB_TOPGEN   3392
#define XCD_BAR_WORDS 3456
#define XB_SPIN_CAP (1u << 18)
#define LAS __attribute__((address_space(3)))

__device__ __forceinline__ unsigned xb_ld(unsigned* p)              { return __hip_atomic_load(p, __ATOMIC_RELAXED, __HIP_MEMORY_SCOPE_AGENT); }
__device__ __forceinline__ unsigned xb_add(unsigned* p, unsigned v) { return __hip_atomic_fetch_add(p, v, __ATOMIC_RELAXED, __HIP_MEMORY_SCOPE_AGENT); }
__device__ __forceinline__ unsigned xb_xcc_id() { return (unsigned)__builtin_amdgcn_s_getreg((3 << 11) | 20) & 0xFu; }
#define XB_SPIN(cond, bar) do { unsigned _sp = 0; while (cond) { __builtin_amdgcn_s_sleep(1); \
    if ((++_sp & 255u) == 0u) { if (xb_ld(&(bar)[XB_TMO])) break; if (_sp > XB_SPIN_CAP) { atomicAdd(&(bar)[XB_TMO], 1u); break; } } } } while (0)

struct XcdBarrier {
  unsigned* bar; unsigned x;
  volatile LAS unsigned* st;
};
__device__ __forceinline__ XcdBarrier xcd_barrier_post(unsigned* bar, volatile LAS unsigned* st) {
  XcdBarrier b; b.bar = bar; b.x = xb_xcc_id(); b.st = st;
  if (threadIdx.x == 0) (void)xb_add(&bar[XB_XCNT(b.x)], 1u);
  return b;
}
__device__ __forceinline__ void xcd_barrier_complete(unsigned* bar, unsigned x, unsigned& nloc, unsigned& nx) {
  const unsigned G = gridDim.x * gridDim.y * gridDim.z;
  unsigned sum, cnt, mine, sp = 0u;
  for (;;) {
    sum = 0u; cnt = 0u; mine = 0u;
#pragma unroll
    for (unsigned j = 0; j < 16; ++j) { const unsigned c = xb_ld(&bar[XB_XCNT(j)]); sum += c; cnt += (c > 0u) ? 1u : 0u; mine = (j == x) ? c : mine; }
    if (sum == G) break;
    __builtin_amdgcn_s_sleep(1);
    if ((++sp & 255u) == 0u) { if (xb_ld(&bar[XB_TMO])) break; if (sp > XB_SPIN_CAP) { atomicAdd(&bar[XB_TMO], 1u); break; } }
  }
  nloc = mine > 0u ? mine : 1u; nx = cnt > 0u ? cnt : 1u;
}
__device__ __forceinline__ void xcd_barrier(const XcdBarrier& b) {
  asm volatile("s_waitcnt vmcnt(0)" ::: "memory");
  __syncthreads();
  if (threadIdx.x == 0) {
    unsigned* bar = b.bar;
    __builtin_amdgcn_s_waitcnt(0);
    unsigned nloc = b.st[0], nx = b.st[1];
    if (nloc == 0u) { xcd_barrier_complete(bar, b.x, nloc, nx); b.st[0] = nloc; b.st[1] = nx; }
    const unsigned old = xb_add(&bar[XB_XSUB(b.x)], 1u);
    const unsigned gen = old / nloc;
    if (old + 1u == (gen + 1u) * nloc) {
      __builtin_amdgcn_fence(__ATOMIC_RELEASE, "agent");
      asm volatile("s_waitcnt vmcnt(0)" ::: "memory");
      const unsigned og = xb_add(&bar[XB_TOP], 1u);
      const unsigned tg = og / nx;
      if (og + 1u == (tg + 1u) * nx) xb_add(&bar[XB_TOPGEN], 1u);
      else XB_SPIN(xb_ld(&bar[XB_TOPGEN]) == tg, bar);
      __builtin_amdgcn_fence(__ATOMIC_ACQUIRE, "agent");
      xb_add(&bar[XB_XGEN(b.x)], 1u);
      asm volatile("s_waitcnt vmcnt(0)" ::: "memory");
    } else {
      XB_SPIN(xb_ld(&bar[XB_XGEN(b.x)]) == gen, bar);
      __builtin_amdgcn_fence(__ATOMIC_ACQUIRE, "agent");
      asm volatile("s_waitcnt vmcnt(0)" ::: "memory");
    }
  }
  __syncthreads();
}

__device__ void p0_transpose(const float* __restrict__ W, int ncols, const float* __restrict__ g, u16* __restrict__ outp,
                             int k0, int v0, bool mapv, float* tile) {
  int tid = otid();
  float vals[16];
#pragma unroll
  for (int i = 0; i < 16; i++) {
    int e = tid + i * NT;
    int kk = e >> 7, v = e & 127;
    int src = mapv ? vcol_src(v0 + v) : (v0 + v);
    float val = 0.f;
    if (src >= 0) val = W[(size_t)(k0 + kk) * ncols + src];
    vals[i] = val;
  }
#pragma unroll
  for (int i = 0; i < 16; i++) {
    int e = tid + i * NT;
    int kk = e >> 7, v = e & 127;
    float val = vals[i];
    if (g) val *= g[k0 + kk];
    tile[kk * 129 + v] = val;
  }
  __syncthreads();
#pragma unroll
  for (int h = 0; h < 2; h++) {
    int v = (tid >> 3) + h * 64, kq = tid & 7;
    const float* tp = tile + (kq * 8) * 129 + v;
    uint4 o;
    o.x = pack2(tp[0], tp[129]);
    o.y = pack2(tp[2 * 129], tp[3 * 129]);
    o.z = pack2(tp[4 * 129], tp[5 * 129]);
    o.w = pack2(tp[6 * 129], tp[7 * 129]);
    *(uint4*)(outp + (size_t)(v0 + v) * 1024 + k0 + kq * 8) = o;
  }
  __syncthreads();
}

__device__ void p0_weights(const Params& p, int l, int rank, int nranks, float* tile) {
  for (int it = rank; it < 16 * 28; it += nranks) {
    int kb = it / 28, vb = it % 28;
    p0_transpose(p.w_in + (size_t)l * DM * INW, INW, p.norm_g + l * DM, p.win_b + (size_t)l * INWP * DM, kb * 64, vb * 128, true, tile);
  }
  for (int it = rank; it < 16 * 8; it += nranks) {
    int kb = it >> 3, vb = it & 7;
    p0_transpose(p.w_out + (size_t)l * DM * DM, DM, nullptr, p.wout_b + (size_t)l * DM * DM, kb * 64, vb * 128, false, tile);
  }
}

__device__ void phase0(const Params& p, char* smem) {
  float* tile = (float*)smem;
  int nb = gridDim.x, b = blockIdx.x, tid = otid();
  const int wave = tid >> 6, lane = tid & 63;
  for (int e = b * NT + tid; e < 2 * NTOK; e += nb * NT) p.sumsq[NTOK + e] = 0.f;
  for (int e = b * NT + tid; e < 2 * 4 * 128 * 128; e += nb * NT) {
    int s = e & 127, t = (e >> 7) & 127;
    p.wc_b[e] = (s <= t) ? f2bf(p.c_ws[e]) : (u16)0;
  }
  for (int r = b * 8 + wave; r < 2 * 4 * 128; r += nb * 8) {
    const int t = r & 127;
    const float* wr = p.c_ws + (size_t)r * 128;
    float s = 0.f;
    if (lane <= t) s += bf2f(f2bf(wr[lane]));
    if (lane + 64 <= t) s += bf2f(f2bf(wr[lane + 64]));
#pragma unroll
    for (int m = 32; m >= 1; m >>= 1) s += __shfl_xor(s, m);
    if (lane == 0) p.rsw[r] = s;
  }
  for (int row = (b * 8 + wave) * 2; row < NTOK; row += nb * 16) {
    const float* xr0 = (row < NPR) ? (p.x_prompt + (size_t)row * DM) : (p.x_sample + (size_t)(row - NPR) * DM);
    const float* xr1 = xr0 + DM;
    float4 v0[4], v1[4];
#pragma unroll
    for (int j = 0; j < 4; j++) { v0[j] = *(const float4*)(xr0 + (j * 64 + lane) * 4); v1[j] = *(const float4*)(xr1 + (j * 64 + lane) * 4); }
    float s0 = 0.f, s1 = 0.f;
#pragma unroll
    for (int j = 0; j < 4; j++) {
      s0 += v0[j].x * v0[j].x + v0[j].y * v0[j].y + v0[j].z * v0[j].z + v0[j].w * v0[j].w;
      s1 += v1[j].x * v1[j].x + v1[j].y * v1[j].y + v1[j].z * v1[j].z + v1[j].w * v1[j].w;
      *(uint2*)(p.xb + (size_t)row * DM + (j * 64 + lane) * 4) = make_uint2(pack2(v0[j].x, v0[j].y), pack2(v0[j].z, v0[j].w));
      *(uint2*)(p.xb + (size_t)(row + 1) * DM + (j * 64 + lane) * 4) = make_uint2(pack2(v1[j].x, v1[j].y), pack2(v1[j].z, v1[j].w));
    }
#pragma unroll
    for (int m = 32; m >= 1; m >>= 1) { s0 += __shfl_xor(s0, m); s1 += __shfl_xor(s1, m); }
    if (lane == 0) { p.sumsq[row] = s0; p.sumsq[row + 1] = s1; }
  }
  p0_weights(p, 0, b, nb, tile);
}

namespace pg8 {
#define PG8_LAS __attribute__((address_space(3)))
typedef unsigned short bf16_t;
typedef short bf16x8 __attribute__((ext_vector_type(8)));
typedef float f32x4 __attribute__((ext_vector_type(4)));
typedef unsigned u32x4 __attribute__((ext_vector_type(4)));
constexpr int BM = 256, BK = 64, HALF = 128, HTB = HALF * BK * 2  , STAGE_BYTES = 8 * HTB, NXCD = 8, WGM = 8;

__host__ __device__ __forceinline__ int lds_byte(int r, int c) { const int st = (r >> 4) * 2 + (c >> 5), rr = r & 15, cc = c & 31, ob = rr * 64 + cc * 2; return st * 1024 + (ob ^ (((ob >> 9) & 1) << 5)); }
__host__ __device__ __forceinline__ void stage_rc(int b, int& R, int& C) { const int st = b / 1024, sb = b % 1024, swz = sb ^ (((sb >> 9) & 1) << 5); R = (st >> 1) * 16 + swz / 64; C = (st & 1) * 32 + (swz % 64) / 2; }
__host__ __device__ __forceinline__ int perm32(int rho) { const int n = rho >> 4, i = rho & 15; return 8 * (i >> 2) + 4 * n + (i & 3); }

struct Unit { int pm, pn; };
struct Gemm { const bf16_t* A; const bf16_t* Bt; int M, N, K; };

struct StaticOrder {
    int nM, nN, nwg, G, c;
    __host__ __device__ void init(int M, int N, int G_, int c_) { nM = M / BM; nN = N / BM; nwg = nM * nN; G = G_; c = c_; }
    __host__ __device__ bool next(int i, Unit& u) const {
        const long L = (long)i * G + c; if (L >= nwg) return false;
        int wgid = (int)L; { const int q = nwg / NXCD, r = nwg % NXCD, xcd = wgid % NXCD, off = wgid / NXCD; wgid = (xcd < r ? xcd * (q + 1) : r * (q + 1) + (xcd - r) * q) + off; }
        const int nig = WGM * nN, gid = wgid / nig, fm = gid * WGM, gsz = (nM - fm) < WGM ? (nM - fm) : WGM;
        u.pm = fm + ((wgid % nig) % gsz); u.pn = (wgid % nig) / gsz; return true;
    }
    __device__ __forceinline__ void a_ready(const Unit&) const {}
    __device__ __forceinline__ void done(const Unit&) const {}
};
__device__ __forceinline__ unsigned cvt_pk_bf16(float lo, float hi) { unsigned r; asm volatile("v_cvt_pk_bf16_f32 %0, %1, %2" : "=v"(r) : "v"(lo), "v"(hi)); return r; }
template <class Epi, class Sched, bool STAMP = false>
__device__ __forceinline__ void gemm_phase(PG8_LAS unsigned char* lds, const Gemm g, const Sched& S, const Epi& E, unsigned long long* stamps) {
    const int tid = otid(), wid = __builtin_amdgcn_readfirstlane(tid >> 6), lane = tid & 63, wr = wid >> 2, wc = wid & 3, fr = lane & 15, fq = lane >> 4;
    const int K = g.K, nt = K / BK;
    int ts_lo = 0, ts_hi = 0, nts = 0; const unsigned long long rt_entry = STAMP ? (unsigned long long)wall_clock64() : 0ull;
#define PG8_STAMP() do { if (STAMP && wid == 0 && nts < 64) { const unsigned long long _c = (unsigned long long)clock64(); \
        ts_lo = (lane == nts) ? (int)(unsigned)_c : ts_lo; ts_hi = (lane == nts) ? (int)(unsigned)(_c >> 32) : ts_hi; ++nts; } } while (0)
    PG8_STAMP();
    unsigned voffA[2], voffB[2];
#pragma unroll
    for (int i = 0; i < 2; ++i) { int R, C; stage_rc(tid * 16 + i * 8192, R, C); const int Rb = Epi::PERM ? ((R & ~31) + perm32(R & 31)) : R;
        voffA[i] = (unsigned)(R * K + C) * 2u; voffB[i] = (unsigned)(Rb * K + C) * 2u; }
    const size_t kstep = (size_t)(BK * 2);
    const size_t hstep = (size_t)HALF * K * 2;
    const size_t tstep = 2 * hstep;
    const unsigned ldsw = (unsigned)wid * 1024u;
    const int aoff = lds_byte(wr * 64 + fr, fq * 8), boff = lds_byte(wc * 32 + fr, fq * 8);
#define PG8_SA(b, h) (((b) * 2 + (h)) * HTB)
#define PG8_SB(b, h) ((4 + (b) * 2 + (h)) * HTB)
#define PG8_STAGE(bufoff, gbase, voff) do { _Pragma("unroll") for (int _i = 0; _i < 2; ++_i) \
        __builtin_amdgcn_global_load_lds((const unsigned*)((const char*)(gbase) + (voff)[_i]), (PG8_LAS unsigned*)(lds + (bufoff) + ldsw + _i * 8192), 16, 0, 0); } while (0)
#define PG8_LDA(dst, b, h) do { _Pragma("unroll") for (int m = 0; m < 4; ++m) _Pragma("unroll") for (int k = 0; k < 2; ++k) dst[m][k] = *(const PG8_LAS bf16x8*)(lds + PG8_SA(b, h) + aoff + m * 2048 + k * 1024); } while (0)
#define PG8_LDB(dst, b, h) do { _Pragma("unroll") for (int n = 0; n < 2; ++n) _Pragma("unroll") for (int k = 0; k < 2; ++k) dst[n][k] = *(const PG8_LAS bf16x8*)(lds + PG8_SB(b, h) + boff + n * 2048 + k * 1024); } while (0)
#define PG8_MMA(ai, bj, At, Bt) do { __builtin_amdgcn_s_setprio(1); _Pragma("unroll") for (int m = 0; m < 4; ++m) _Pragma("unroll") for (int n = 0; n < 2; ++n) _Pragma("unroll") for (int k = 0; k < 2; ++k) \
        acc[ai][bj][m][n] = __builtin_amdgcn_mfma_f32_16x16x32_bf16(Bt[n][k], At[m][k], acc[ai][bj][m][n], 0, 0, 0); __builtin_amdgcn_s_setprio(0); } while (0)
#define PG8_WAIT_V(n) asm volatile("s_waitcnt vmcnt(" #n ")" ::: "memory")
#define PG8_WAIT_L(n) asm volatile("s_waitcnt lgkmcnt(" #n ")" ::: "memory")
#define PG8_BAR __builtin_amdgcn_s_barrier()
#define PG8_SCHED __builtin_amdgcn_sched_barrier(0)
    Unit cur, nxt; int ui = 0;
    if (!S.next(0, cur)) return;
    f32x4 acc[2][2][4][2];
#pragma unroll
    for (int a = 0; a < 2; ++a)
#pragma unroll
        for (int b = 0; b < 2; ++b)
#pragma unroll
            for (int m = 0; m < 4; ++m)
#pragma unroll
                for (int n = 0; n < 2; ++n) acc[a][b][m][n] = (f32x4){0.f, 0.f, 0.f, 0.f};
    bf16x8 At[4][2], B0[2][2], B1[2][2];
    const char* cA = (const char*)g.A + (size_t)cur.pm * tstep; const char* cB = (const char*)g.Bt + (size_t)cur.pn * tstep;
    typename Epi::Pre pre;
    E.preload(cur, wr, fr, pre);
    S.a_ready(cur);
    PG8_STAGE(PG8_SB(0, 0), cB, voffB); PG8_STAGE(PG8_SA(0, 0), cA, voffA); PG8_STAGE(PG8_SB(0, 1), cB + hstep, voffB); PG8_STAGE(PG8_SA(0, 1), cA + hstep, voffA);
    if (wr == 1) PG8_BAR;
    PG8_WAIT_V(4); PG8_BAR;
    PG8_STAGE(PG8_SB(1, 0), cB + kstep, voffB); PG8_STAGE(PG8_SA(1, 0), cA + kstep, voffA); PG8_STAGE(PG8_SB(1, 1), cB + hstep + kstep, voffB);
    PG8_WAIT_V(6); PG8_BAR;
    PG8_STAMP();
    for (;;) {
        const bool has_next = S.next(ui + 1, nxt);
        const char* nA = has_next ? (const char*)g.A + (size_t)nxt.pm * tstep : cA; const char* nB = has_next ? (const char*)g.Bt + (size_t)nxt.pn * tstep : cB;
        for (int t = 0; t < nt; t += 2) {
            const bool last = (t == nt - 2);
            const char* a1 = cA + (size_t)(t + 1) * kstep;
            const char* a2 = last ? nA : cA + (size_t)(t + 2) * kstep; const char* b2 = last ? nB : cB + (size_t)(t + 2) * kstep;
            const char* a3 = a2 + kstep; const char* b3 = b2 + kstep;
            if (last && has_next) S.a_ready(nxt);
            PG8_LDB(B0, 0, 0); PG8_SCHED; PG8_LDA(At, 0, 0); PG8_STAGE(PG8_SA(1, 1), a1 + hstep, voffA);
            PG8_WAIT_L(8); PG8_BAR; PG8_WAIT_L(0); PG8_MMA(0, 0, At, B0); PG8_BAR; PG8_SCHED;
            PG8_LDB(B1, 0, 1); PG8_STAGE(PG8_SB(0, 0), b2, voffB);
            PG8_BAR; PG8_WAIT_L(0); PG8_MMA(0, 1, At, B1); PG8_BAR;
            PG8_LDA(At, 0, 1); PG8_STAGE(PG8_SA(0, 0), a2, voffA);
            PG8_BAR; PG8_WAIT_L(0); PG8_MMA(1, 0, At, B0); PG8_BAR; PG8_SCHED;
            PG8_STAGE(PG8_SB(0, 1), b2 + hstep, voffB);
            PG8_WAIT_V(6); PG8_BAR; PG8_MMA(1, 1, At, B1); PG8_BAR;
            PG8_LDB(B0, 1, 0); PG8_SCHED; PG8_LDA(At, 1, 0); PG8_STAGE(PG8_SA(0, 1), a2 + hstep, voffA);
            PG8_WAIT_L(8); PG8_BAR; PG8_WAIT_L(0); PG8_MMA(0, 0, At, B0); PG8_BAR; PG8_SCHED;
            PG8_LDB(B1, 1, 1); PG8_STAGE(PG8_SB(1, 0), b3, voffB);
            PG8_BAR; PG8_WAIT_L(0); PG8_MMA(0, 1, At, B1); PG8_BAR;
            PG8_LDA(At, 1, 1); PG8_STAGE(PG8_SA(1, 0), a3, voffA);
            PG8_BAR; PG8_WAIT_L(0); PG8_MMA(1, 0, At, B0); PG8_BAR; PG8_SCHED;
            PG8_STAGE(PG8_SB(1, 1), b3 + hstep, voffB);
            PG8_WAIT_V(6); PG8_BAR; PG8_MMA(1, 1, At, B1); PG8_BAR;
        }
        PG8_STAMP();
        if constexpr (!Epi::AFTER_DRAIN) { E(acc, cur, wr, wc, fr, fq, pre); S.done(cur); }
        PG8_STAMP();
        if (!has_next) break;
#pragma unroll
        for (int a = 0; a < 2; ++a)
#pragma unroll
            for (int b = 0; b < 2; ++b)
#pragma unroll
                for (int m = 0; m < 4; ++m)
#pragma unroll
                    for (int n = 0; n < 2; ++n) acc[a][b][m][n] = (f32x4){0.f, 0.f, 0.f, 0.f};
        cur = nxt; cA = nA; cB = nB; ++ui;
        E.preload(cur, wr, fr, pre);
    }
    PG8_WAIT_V(0);
    if (wr == 0) PG8_BAR;
    PG8_BAR;
    if constexpr (Epi::AFTER_DRAIN) { E.fused(acc, cur, wr, wc, fr, fq, lds, wid, lane); S.done(cur); }
    PG8_STAMP();
    if (STAMP && wid == 0) { stamps[lane] = lane < nts ? (((unsigned long long)(unsigned)ts_hi << 32) | (unsigned)ts_lo) : 0ull;
        if (lane == 62) stamps[62] = rt_entry; if (lane == 63) stamps[63] = (unsigned long long)wall_clock64(); }
#undef PG8_STAMP
#undef PG8_SA
#undef PG8_SB
#undef PG8_STAGE
#undef PG8_LDA
#undef PG8_LDB
#undef PG8_MMA
#undef PG8_WAIT_V
#undef PG8_WAIT_L
#undef PG8_BAR
#undef PG8_SCHED
}
}


__device__ __forceinline__ int vcol_src(int vc) {
  const int un = vc >> 8, h = (vc >> 7) & 1, i = vc & 127;
  if (un < 3) return (h ? 384 : 0) + 128 * un + i;
  if (un < 6) return (h ? 1920 : 1152) + 128 * (un - 3) + i;
  if (un < 9) return (h ? 2304 : 1536) + 128 * (un - 6) + i;
  if (un < 11) return (h ? 3200 : 2688) + 128 * (un - 9) + i;
  if (un == 11) return 768 + 128 * h + i;
  if (un == 12) return h ? (2944 + i) : (768 + 256 + i);
  return h ? -1 : (2944 + 128 + i);
}

typedef float f32x4_ __attribute__((ext_vector_type(4)));
struct Epi1 {
  static constexpr bool PERM = true, AFTER_DRAIN = false;
  u16* inter; const float* ssq;
  struct Pre { float s[8]; };
  __device__ __forceinline__ void preload(const pg8::Unit& u, int wr, int fr, Pre& P) const {
#pragma unroll
    for (int ai = 0; ai < 2; ++ai)
#pragma unroll
      for (int m = 0; m < 4; ++m) P.s[ai * 4 + m] = ssq[u.pm * 256 + 64 * wr + fr + 128 * ai + 16 * m];
  }
  __device__ __forceinline__ void operator()(const pg8::f32x4 (&acc)[2][2][4][2], const pg8::Unit& u, int wr, int wc, int fr, int fq, const Pre& P) const {
    const int un = u.pn;
    int k0, ob0, k1 = -1, ob1 = 0;
    if (un < 3) { k0 = 0; ob0 = 128 * un; }
    else if (un < 6) { k0 = 2; ob0 = 768 + 128 * (un - 3); }
    else if (un < 9) { k0 = 3; ob0 = 1152 + 128 * (un - 6); }
    else if (un < 11) { k0 = 3; ob0 = 1536 + 128 * (un - 9); }
    else if (un == 11) { k0 = 1; ob0 = 384; k1 = 1; ob1 = 384 + 128; }
    else if (un == 12) { k0 = 1; ob0 = 384 + 256; k1 = 4; ob1 = 1792; }
    else { k0 = 4; ob0 = 1792 + 128; k1 = -2; }
    const int cl = 32 * wc + 8 * fq;
    const int rbase = u.pm * 256 + 64 * wr + fr;
    const __amdgpu_buffer_rsrc_t irs = mk_rsrc(inter, (unsigned)NTOK * IW * 2u);
    auto body = [&](auto K0c, auto K1c) {
      constexpr int K0 = decltype(K0c)::value, K1 = decltype(K1c)::value;
#pragma unroll
      for (int ai = 0; ai < 2; ++ai)
#pragma unroll
        for (int m = 0; m < 4; ++m) {
          const int row = rbase + 128 * ai + 16 * m;
          const float rs = rsqrtf(P.s[ai * 4 + m] * (1.f / 1024.f) + EPS);
          float a[8], b[8], o[8];
#pragma unroll
          for (int i = 0; i < 4; i++) {
            a[i] = acc[ai][0][m][0][i] * rs; a[4 + i] = acc[ai][0][m][1][i] * rs;
            b[i] = acc[ai][1][m][0][i] * rs; b[4 + i] = acc[ai][1][m][1][i] * rs;
          }
          const unsigned rpo = ((unsigned)row * IW + cl) * 2u;
          if (K1 == -1) {
#pragma unroll
            for (int i = 0; i < 8; i++) o[i] = (K0 == 0) ? a[i] * sigmoidf_(b[i]) : (K0 == 2) ? a[i] * b[i] : a[i] * siluf_(b[i]);
            st16_wt(irs, rpo + ob0 * 2u, pack8(o));
          } else {
#pragma unroll
            for (int i = 0; i < 8; i++) o[i] = (K0 == 1) ? siluf_(a[i]) : a[i];
            st16_wt(irs, rpo + ob0 * 2u, pack8(o));
            if (K1 != -2) {
#pragma unroll
              for (int i = 0; i < 8; i++) o[i] = (K1 == 1) ? siluf_(b[i]) : b[i];
              st16_wt(irs, rpo + ob1 * 2u, pack8(o));
            }
          }
        }
    };
    using std::integral_constant;
    if (k1 == -1) {
      if (k0 == 0) body(integral_constant<int, 0>{}, integral_constant<int, -1>{});
      else if (k0 == 2) body(integral_constant<int, 2>{}, integral_constant<int, -1>{});
      else body(integral_constant<int, 3>{}, integral_constant<int, -1>{});
    } else if (k1 == 1) body(integral_constant<int, 1>{}, integral_constant<int, 1>{});
    else if (k1 == 4) body(integral_constant<int, 1>{}, integral_constant<int, 4>{});
    else body(integral_constant<int, 4>{}, integral_constant<int, -2>{});
  }
};
struct Epi2 {
  static constexpr bool PERM = true, AFTER_DRAIN = false;
  u16* xb; float* ssq;
  struct Pre {};
  __device__ __forceinline__ void preload(const pg8::Unit&, int, int, Pre&) const {}
  __device__ __forceinline__ void operator()(const pg8::f32x4 (&acc)[2][2][4][2], const pg8::Unit& u, int wr, int wc, int fr, int fq, const Pre&) const {
    const int cl = u.pn * 256 + 32 * wc + 8 * fq;
#pragma unroll
    for (int ai = 0; ai < 2; ++ai)
#pragma unroll
      for (int m = 0; m < 4; ++m) {
        const int row = u.pm * 256 + 128 * ai + 64 * wr + 16 * m + fr;
        u16* rp = xb + (size_t)row * DM + cl;
        uint4 o0 = *(const uint4*)(rp), o1 = *(const uint4*)(rp + 128);
        float x0[8], x1[8];
        unpack8(o0, x0);
        unpack8(o1, x1);
        float ss = 0.f;
#pragma unroll
        for (int i = 0; i < 4; i++) {
          x0[i] += acc[ai][0][m][0][i]; x0[4 + i] += acc[ai][0][m][1][i];
          x1[i] += acc[ai][1][m][0][i]; x1[4 + i] += acc[ai][1][m][1][i];
        }
#pragma unroll
        for (int i = 0; i < 8; i++) ss += x0[i] * x0[i] + x1[i] * x1[i];
        *(uint4*)(rp) = pack8(x0);
        *(uint4*)(rp + 128) = pack8(x1);
        ss += __shfl_xor(ss, 16);
        ss += __shfl_xor(ss, 32);
        if (fq == 0) atomicAdd(ssq + row, ss);
      }
  }
};

__device__ void phase1(const Params& p, int l, char* smem) {
  pg8::Gemm g{p.xb, p.win_b + (size_t)l * INWP * DM, NTOK, INWP, DM};
  pg8::StaticOrder S;
  S.init(NTOK, INWP, (int)gridDim.x, (int)blockIdx.x);
  Epi1 E{p.inter, p.sumsq + (size_t)l * NTOK};
  pg8::gemm_phase<Epi1, pg8::StaticOrder, false>((PG8_LAS unsigned char*)smem, g, S, E, nullptr);
  if (l == 0) {
    const int G = (int)gridDim.x, c = (int)blockIdx.x;
    const int rem = ((NTOK / 256) * (INWP / 256)) % G;
    const int nidle = (rem == 0) ? G : G - rem;
    const int rank = (rem == 0) ? c : c - rem;
    if (rank >= 0) p0_weights(p, 1, rank, nidle, (float*)smem);
  }
}
__device__ void phase3_sample(const Params& p, int l, char* smem) {
  const int tid = otid();
  const int lane = tid & 63, w = tid >> 6;
  const int l32 = lane & 31, lh = lane >> 5;
  float* part = (float*)smem;
  float* ssq = p.sumsq + (size_t)(l + 1) * NTOK;
  for (int T = blockIdx.x; T < 256; T += gridDim.x) {
    const int row0 = NPR + (T >> 4) * 32, col0 = (T & 15) * 64;
    const u16* ap = p.mix + (size_t)(row0 + l32) * DM + w * 128 + lh * 8;
    const u16* bp = p.wout_b + ((size_t)l * DM + col0 + l32) * DM + w * 128 + lh * 8;
    bf16x8 af[8], b0[8], b1[8];
#pragma unroll
    for (int s = 0; s < 8; s++) {
      af[s] = *(const bf16x8*)(ap + s * 16);
      b0[s] = *(const bf16x8*)(bp + s * 16);
      b1[s] = *(const bf16x8*)(bp + (size_t)32 * DM + s * 16);
    }
    f32x16 acc0, acc1;
#pragma unroll
    for (int r = 0; r < 16; r++) { acc0[r] = 0.f; acc1[r] = 0.f; }
#pragma unroll
    for (int s = 0; s < 8; s++) {
      acc0 = __builtin_amdgcn_mfma_f32_32x32x16_bf16(b0[s], af[s], acc0, 0, 0, 0);
      acc1 = __builtin_amdgcn_mfma_f32_32x32x16_bf16(b1[s], af[s], acc1, 0, 0, 0);
    }
#pragma unroll
    for (int r = 0; r < 16; r++) {
      part[((w * 2 + 0) * 16 + r) * 64 + lane] = acc0[r];
      part[((w * 2 + 1) * 16 + r) * 64 + lane] = acc1[r];
    }
    __syncthreads();
    float ss = 0.f;
    const int row = row0 + l32;
#pragma unroll
    for (int ni = 0; ni < 2; ni++) {
#pragma unroll
      for (int rr = 0; rr < 2; rr++) {
        const int r = 2 * w + rr;
        float v = 0.f;
#pragma unroll
        for (int pw = 0; pw < 8; pw++) v += part[((pw * 2 + ni) * 16 + r) * 64 + lane];
        const int col = col0 + ni * 32 + (r & 3) + 8 * (r >> 2) + 4 * lh;
        u16* xp = p.xb + (size_t)row * DM + col;
        v += bf2f(*xp);
        ss += v * v;
        *xp = f2bf(v);
      }
    }
    ss += __shfl_xor(ss, 32);
    if (lh == 0) atomicAdd(ssq + row, ss);
    __syncthreads();
  }
}

__device__ void phase3(const Params& p, int l, char* smem) {
  phase3_sample(p, l, smem);
  pg8::Gemm g{p.mix, p.wout_b + (size_t)l * DM * DM, NPR, DM, DM};
  pg8::StaticOrder S;
  S.init(NPR, DM, (int)gridDim.x, (int)blockIdx.x);
  Epi2 E{p.xb, p.sumsq + (size_t)(l + 1) * NTOK};
  pg8::gemm_phase<Epi2, pg8::StaticOrder, false>((PG8_LAS unsigned char*)smem, g, S, E, nullptr);
}

__device__ void p2_stage_w(const Params& p, int l, char* smem) {
  const int tid = otid();
  const float4* src = (const float4*)(p.a_conv_w + (size_t)l * 31 * 384);
  for (int f = tid; f < 36 * 96; f += NT) {
    int j = f / 96, q = f - j * 96;
    float4 v = make_float4(0.f, 0.f, 0.f, 0.f);
    if (j < 31) v = src[f];
    ((float4*)smem)[(j * 2 + (q & 1)) * 48 + (q >> 1)] = v;
  }
}

struct ATileRegs { u32x4 r0, r1, r2, r3, r4, r5; };
__device__ __forceinline__ void p2_ab_load(const Params& p, int it, ATileRegs& A) {
  const int tid = otid();
  const int R0 = it * 32;
  const int spos = R0 & 2047;
  const u16* __restrict__ inter = p.inter;
  auto ld = [&](int i) -> u32x4 {
    const int e = tid + i * NT;
    const int r = e / 48, ch = e - r * 48;
    u32x4 v = {0u, 0u, 0u, 0u};
    if (r < 62 && spos - 30 + r >= 0) v = *(const u32x4*)(inter + (size_t)(R0 - 30 + r) * IW + ch * 8);
    return v;
  };
  A.r0 = ld(0); A.r1 = ld(1); A.r2 = ld(2); A.r3 = ld(3); A.r4 = ld(4); A.r5 = ld(5);
}
__device__ __forceinline__ void p2_ab_store(const ATileRegs& A, char* smem) {
  const int tid = otid();
  char* atile = smem + 55296 + tid * 16;
  *(u32x4*)(atile) = A.r0;
  *(u32x4*)(atile + 1 * NT * 16) = A.r1;
  *(u32x4*)(atile + 2 * NT * 16) = A.r2;
  *(u32x4*)(atile + 3 * NT * 16) = A.r3;
  *(u32x4*)(atile + 4 * NT * 16) = A.r4;
  *(u32x4*)(atile + 5 * NT * 16) = A.r5;
}

typedef float f32x2 __attribute__((ext_vector_type(2)));
__device__ void p2_ab(const Params& p, int l, int it, char* smem) {
  const int tid = otid();
  const int lane = tid & 63, w = tid >> 6;
  const bool active = lane < 48;
  const int o = active ? lane : 47;
  const int R0 = it * 32;
  const int spos = R0 & 2047;
  const int bseq = R0 >> 11;
  const bool last = (spos == 2016);
  const u16* __restrict__ inter = p.inter;
  char* atile = smem + 55296;
  const float4* wts = (const float4*)smem;
  const size_t rowq = (size_t)R0 + 4 * w;
  const __amdgpu_buffer_rsrc_t mrs = mk_rsrc(p.mix, (unsigned)NTOK * DM * 2u);
  uint4 szv[4], gbv[4], zv[6];
#pragma unroll
  for (int t = 0; t < 4; t++) {
    szv[t] = *(const uint4*)(inter + (rowq + t) * IW + 384 + 8 * o);
    gbv[t] = *(const uint4*)(inter + (rowq + t) * IW + 1152 + 8 * o);
  }
#pragma unroll
  for (int s2 = 0; s2 < 6; s2++) {
    zv[s2] = make_uint4(0, 0, 0, 0);
    if (spos + 4 * w - 2 + s2 >= 0) zv[s2] = *(const uint4*)(inter + (rowq - 2 + s2) * IW + 768 + 8 * o);
  }
  f32x2 acc2[4][4];
  {
    float4 b0 = *(const float4*)(p.a_conv_b + l * 384 + 8 * o), b1 = *(const float4*)(p.a_conv_b + l * 384 + 8 * o + 4);
#pragma unroll
    for (int t = 0; t < 4; t++) {
      acc2[t][0] = (f32x2){b0.x, b0.y}; acc2[t][1] = (f32x2){b0.z, b0.w};
      acc2[t][2] = (f32x2){b1.x, b1.y}; acc2[t][3] = (f32x2){b1.z, b1.w};
    }
  }
  f32x2 wwin[4][4];
#pragma unroll
  for (int u = 0; u < 4; u++)
#pragma unroll
    for (int c = 0; c < 4; c++) wwin[u][c] = (f32x2){0.f, 0.f};
  const char* arow = atile + (4 * w) * 768 + o * 16;
#pragma unroll 1
  for (int s4 = 0; s4 < 36; s4 += 4) {
    const char* ar = arow + s4 * 768;
    const float4* wr = wts + (s4 * 2) * 48 + o;
#pragma unroll
    for (int u = 0; u < 4; u++) {
      uint4 av = *(const uint4*)(ar + u * 768);
      float4 wa = wr[(u * 2) * 48], wb = wr[(u * 2 + 1) * 48];
      f32x2 v[4];
      v[0] = (f32x2){__uint_as_float(av.x << 16), __uint_as_float(av.x & 0xffff0000u)};
      v[1] = (f32x2){__uint_as_float(av.y << 16), __uint_as_float(av.y & 0xffff0000u)};
      v[2] = (f32x2){__uint_as_float(av.z << 16), __uint_as_float(av.z & 0xffff0000u)};
      v[3] = (f32x2){__uint_as_float(av.w << 16), __uint_as_float(av.w & 0xffff0000u)};
      wwin[u][0] = (f32x2){wa.x, wa.y}; wwin[u][1] = (f32x2){wa.z, wa.w};
      wwin[u][2] = (f32x2){wb.x, wb.y}; wwin[u][3] = (f32x2){wb.z, wb.w};
#pragma unroll
      for (int t = 0; t < 4; t++) {
#pragma unroll
        for (int c = 0; c < 4; c++) acc2[t][c] = __builtin_elementwise_fma(wwin[(u - t) & 3][c], v[c], acc2[t][c]);
      }
    }
  }
  if (last && active) {
#pragma unroll
    for (int t = 0; t < 4; t++) {
      int pp = spos + 4 * w + t;
      if (pp >= 2018) {
        float v[8];
        unpack8(*(const uint4*)(arow + (30 + t) * 768), v);
        float* so = p.out + O_SAP + ((size_t)(l * 8 + bseq) * 30 + (pp - 2018)) * 384 + 8 * o;
        *(float4*)so = make_float4(v[0], v[1], v[2], v[3]);
        *(float4*)(so + 4) = make_float4(v[4], v[5], v[6], v[7]);
      }
    }
  }
  float acc[4][8];
#pragma unroll
  for (int t = 0; t < 4; t++)
#pragma unroll
    for (int c = 0; c < 4; c++) { acc[t][2 * c] = acc2[t][c].x; acc[t][2 * c + 1] = acc2[t][c].y; }
  float s1[4], s2[4];
#pragma unroll
  for (int t = 0; t < 4; t++) {
    float a = 0.f, b = 0.f;
#pragma unroll
    for (int c = 0; c < 8; c++) { a += acc[t][c]; b += acc[t][c] * acc[t][c]; }
    s1[t] = active ? a : 0.f;
    s2[t] = active ? b : 0.f;
  }
#pragma unroll
  for (int t = 0; t < 4; t++) {
#pragma unroll
    for (int m = 32; m >= 1; m >>= 1) { s1[t] += __shfl_xor(s1[t], m); s2[t] += __shfl_xor(s2[t], m); }
  }
  {
    float g8[8], b8[8];
    {
      float4 a0 = *(const float4*)(p.a_ln_g + l * 384 + 8 * o), a1 = *(const float4*)(p.a_ln_g + l * 384 + 8 * o + 4);
      float4 c0 = *(const float4*)(p.a_ln_b + l * 384 + 8 * o), c1 = *(const float4*)(p.a_ln_b + l * 384 + 8 * o + 4);
      g8[0] = a0.x; g8[1] = a0.y; g8[2] = a0.z; g8[3] = a0.w; g8[4] = a1.x; g8[5] = a1.y; g8[6] = a1.z; g8[7] = a1.w;
      b8[0] = c0.x; b8[1] = c0.y; b8[2] = c0.z; b8[3] = c0.w; b8[4] = c1.x; b8[5] = c1.y; b8[6] = c1.z; b8[7] = c1.w;
    }
#pragma unroll
    for (int t = 0; t < 4; t++) {
      float mu = s1[t] * (1.f / 384.f);
      float var = s2[t] * (1.f / 384.f) - mu * mu;
      float rstd = rsqrtf(fmaxf(var, 0.f) + EPS);
      float sz[8], y[8];
      unpack8(szv[t], sz);
#pragma unroll
      for (int c = 0; c < 8; c++) y[c] = siluf_((acc[t][c] - mu) * rstd * g8[c] + b8[c]) * sz[c];
      if (active) st16_wt(mrs, ((unsigned)(rowq + t) * DM + 8 * o) * 2u, pack8(y));
    }
  }
  {
    float w0[8], w1[8], w2[8];
    {
      const float* bw = p.b_conv_w + (size_t)l * 3 * 384 + 8 * o;
      float4 a0 = *(const float4*)(bw), a1 = *(const float4*)(bw + 4);
      float4 c0 = *(const float4*)(bw + 384), c1 = *(const float4*)(bw + 384 + 4);
      float4 d0 = *(const float4*)(bw + 768), d1 = *(const float4*)(bw + 768 + 4);
      w0[0] = a0.x; w0[1] = a0.y; w0[2] = a0.z; w0[3] = a0.w; w0[4] = a1.x; w0[5] = a1.y; w0[6] = a1.z; w0[7] = a1.w;
      w1[0] = c0.x; w1[1] = c0.y; w1[2] = c0.z; w1[3] = c0.w; w1[4] = c1.x; w1[5] = c1.y; w1[6] = c1.z; w1[7] = c1.w;
      w2[0] = d0.x; w2[1] = d0.y; w2[2] = d0.z; w2[3] = d0.w; w2[4] = d1.x; w2[5] = d1.y; w2[6] = d1.z; w2[7] = d1.w;
    }
    float z[6][8];
#pragma unroll
    for (int s2i = 0; s2i < 6; s2i++) unpack8(zv[s2i], z[s2i]);
#pragma unroll
    for (int t = 0; t < 4; t++) {
      float gb[8], y[8];
      unpack8(gbv[t], gb);
#pragma unroll
      for (int c = 0; c < 8; c++) y[c] = gb[c] * (w0[c] * z[t][c] + w1[c] * z[t + 1][c] + w2[c] * z[t + 2][c]);
      if (active) st16_wt(mrs, ((unsigned)(rowq + t) * DM + 384 + 8 * o) * 2u, pack8(y));
    }
    if (last && w == 7 && active) {
#pragma unroll
      for (int i = 0; i < 2; i++) {
        float* so = p.out + O_SBP + ((size_t)(l * 8 + bseq) * 2 + i) * 384 + 8 * o;
        *(float4*)so = make_float4(z[4 + i][0], z[4 + i][1], z[4 + i][2], z[4 + i][3]);
        *(float4*)(so + 4) = make_float4(z[4 + i][4], z[4 + i][5], z[4 + i][6], z[4 + i][7]);
      }
    }
  }
  __syncthreads();
}

__device__ void p2_c(const Params& p, int l, int ci, char* smem) {
  const int tid = otid();
  const int lane = tid & 63, w = tid >> 6;
  const int l32 = lane & 31, lh = lane >> 5;
  const int R0 = ci * 128;
  const u16* __restrict__ inter = p.inter;
  bf16x8 wf[4][8];
  {
    const u16* wb = p.wc_b + ((size_t)(l * 4 + (w >> 1)) * 128 + l32) * 128 + lh * 8;
#pragma unroll
    for (int ks = 0; ks < 8; ks++)
#pragma unroll
      for (int ti = 0; ti < 4; ti++)
        if (ti >= (ks >> 1)) wf[ti][ks] = *(const bf16x8*)(wb + (size_t)ti * 32 * 128 + ks * 16);
  }
  {
    const int tok = tid >> 2, qd = tid & 3;
    const u16* src = inter + (size_t)(R0 + tok) * IW + 1792 + qd * 64;
    uint4 xv[8];
#pragma unroll
    for (int i = 0; i < 8; i++) xv[i] = *(const uint4*)(src + i * 8);
    float s1 = 0.f, s2 = 0.f;
#pragma unroll
    for (int i = 0; i < 8; i++) {
      float f[8];
      unpack8(xv[i], f);
#pragma unroll
      for (int k = 0; k < 8; k++) { s1 += f[k]; s2 += f[k] * f[k]; }
    }
    s1 += __shfl_xor(s1, 1); s2 += __shfl_xor(s2, 1);
    s1 += __shfl_xor(s1, 2); s2 += __shfl_xor(s2, 2);
    const float mu = s1 * (1.f / 256.f);
    const float rstd = rsqrtf(fmaxf(s2 * (1.f / 256.f) - mu * mu, 0.f) + EPS);
    const int tch = tok >> 3, tlo = (tok & 7) * 2;
#pragma unroll
    for (int i = 0; i < 8; i++) {
      float f[8];
      unpack8(xv[i], f);
#pragma unroll
      for (int k = 0; k < 8; k++) {
        const int c = qd * 64 + i * 8 + k;
        *(u16*)(smem + c * 256 + ((tch ^ (c & 15)) << 4) + tlo) = f2bf((f[k] - mu) * rstd);
      }
    }
  }
  __syncthreads();
  {
    const int h = w >> 1;
    const int cbase = h * 64 + (w & 1) * 32;
    const int c = cbase + l32;
    f32x16 acc[4];
#pragma unroll
    for (int ti = 0; ti < 4; ti++)
#pragma unroll
      for (int r = 0; r < 16; r++) acc[ti][r] = 0.f;
#pragma unroll
    for (int ks = 0; ks < 8; ks++) {
      bf16x8 vfrag = *(const bf16x8*)(smem + c * 256 + (((ks * 2 + lh) ^ (c & 15)) << 4));
#pragma unroll
      for (int ti = 0; ti < 4; ti++) {
        if (ti >= (ks >> 1)) acc[ti] = __builtin_amdgcn_mfma_f32_32x32x16_bf16(vfrag, wf[ti][ks], acc[ti], 0, 0, 0);
      }
    }
    float4 gl[4], bl[4];
#pragma unroll
    for (int g = 0; g < 4; g++) {
      gl[g] = *(const float4*)(p.c_ln_g + l * 256 + cbase + 8 * g + 4 * lh);
      bl[g] = *(const float4*)(p.c_ln_b + l * 256 + cbase + 8 * g + 4 * lh);
    }
#pragma unroll
    for (int ti = 0; ti < 4; ti++) {
      const int t = ti * 32 + l32;
      const size_t row = (size_t)R0 + t;
      const float rsw = p.rsw[(l * 4 + h) * 128 + t];
      const float bs = p.c_bs[(l * 4 + h) * 128 + t];
#pragma unroll
      for (int g = 0; g < 4; g++) {
        const int d0 = cbase + 8 * g + 4 * lh;
        uint2 gc = *(const uint2*)(inter + row * IW + 1536 + d0);
        float y0 = __uint_as_float(gc.x << 16) * (gl[g].x * acc[ti][4 * g + 0] + bl[g].x * rsw + bs);
        float y1 = __uint_as_float(gc.x & 0xffff0000u) * (gl[g].y * acc[ti][4 * g + 1] + bl[g].y * rsw + bs);
        float y2 = __uint_as_float(gc.y << 16) * (gl[g].z * acc[ti][4 * g + 2] + bl[g].z * rsw + bs);
        float y3 = __uint_as_float(gc.y & 0xffff0000u) * (gl[g].w * acc[ti][4 * g + 3] + bl[g].w * rsw + bs);
        *(uint2*)(p.mix + row * DM + 768 + d0) = make_uint2(pack2(y0, y1), pack2(y2, y3));
      }
    }
  }
  __syncthreads();
}

__device__ void p2_s(const Params& p, int l, int n, float* red, float* smem_f) {
  const int tid = otid();
  const int lane = tid & 63, w = tid >> 6;
  const int c = tid;
  const size_t Rs = NPR + (size_t)n * 4;
  const u16* __restrict__ inter = p.inter;
  float rv[16];
#pragma unroll
  for (int i = 0; i < 16; i++) rv[i] = 0.f;
  float o[4] = {0.f, 0.f, 0.f, 0.f};
  float zin[6] = {0.f, 0.f, 0.f, 0.f, 0.f, 0.f};
  float cvv[4] = {0.f, 0.f, 0.f, 0.f};
  if (c < 384) {
    float in[34], wv[31];
    const float* sa = p.state_a + ((size_t)(l * 128 + n) * 30) * 384 + c;
    float* so = p.out + O_SAS + ((size_t)(l * 128 + n) * 30) * 384 + c;
#pragma unroll
    for (int i = 0; i < 30; i++) in[i] = sa[i * 384];
#pragma unroll
    for (int t = 0; t < 4; t++) in[30 + t] = bf2f(inter[(Rs + t) * IW + c]);
#pragma unroll
    for (int j = 0; j < 31; j++) wv[j] = p.a_conv_w[(l * 31 + j) * 384 + c];
    const float bias = p.a_conv_b[l * 384 + c];
#pragma unroll
    for (int i = 0; i < 30; i++) so[i * 384] = in[4 + i];
#pragma unroll
    for (int t = 0; t < 4; t++) o[t] = bias;
#pragma unroll
    for (int j = 0; j < 31; j++) {
#pragma unroll
      for (int t = 0; t < 4; t++) o[t] += wv[j] * in[t + j];
    }
#pragma unroll
    for (int t = 0; t < 4; t++) { rv[t] = o[t]; rv[4 + t] = o[t] * o[t]; }
    const float* sb = p.state_b + ((size_t)(l * 128 + n) * 2) * 384 + c;
    zin[0] = sb[0]; zin[1] = sb[384];
#pragma unroll
    for (int t = 0; t < 4; t++) zin[2 + t] = bf2f(inter[(Rs + t) * IW + 768 + c]);
  }
  if (c < 256) {
#pragma unroll
    for (int t = 0; t < 4; t++) {
      cvv[t] = bf2f(inter[(Rs + t) * IW + 1792 + c]);
      rv[8 + t] = cvv[t];
      rv[12 + t] = cvv[t] * cvv[t];
    }
  }
#pragma unroll
  for (int i = 0; i < 16; i++) {
#pragma unroll
    for (int m = 32; m >= 1; m >>= 1) rv[i] += __shfl_xor(rv[i], m);
  }
  if (lane == 0) {
#pragma unroll
    for (int i = 0; i < 16; i++) red[w * 16 + i] = rv[i];
  }
  __syncthreads();
#pragma unroll
  for (int i = 0; i < 16; i++) {
    float s = 0.f;
#pragma unroll
    for (int ww = 0; ww < 8; ww++) s += red[ww * 16 + i];
    rv[i] = s;
  }
  if (c < 384) {
    const float g = p.a_ln_g[l * 384 + c], bb = p.a_ln_b[l * 384 + c];
    const float w0 = p.b_conv_w[(l * 3 + 0) * 384 + c], w1 = p.b_conv_w[(l * 3 + 1) * 384 + c], w2 = p.b_conv_w[(l * 3 + 2) * 384 + c];
#pragma unroll
    for (int t = 0; t < 4; t++) {
      float m_ = rv[t] * (1.f / 384.f);
      float var = rv[4 + t] * (1.f / 384.f) - m_ * m_;
      float rstd = rsqrtf(fmaxf(var, 0.f) + EPS);
      float y = (o[t] - m_) * rstd * g + bb;
      float ya = siluf_(y) * bf2f(inter[(Rs + t) * IW + 384 + c]);
      p.mix[(Rs + t) * DM + c] = f2bf(ya);
      float cv = w0 * zin[t] + w1 * zin[t + 1] + w2 * zin[t + 2];
      float yb = bf2f(inter[(Rs + t) * IW + 1152 + c]) * cv;
      p.mix[(Rs + t) * DM + 384 + c] = f2bf(yb);
    }
    p.out[O_SBS + ((size_t)(l * 128 + n) * 2 + 0) * 384 + c] = zin[4];
    p.out[O_SBS + ((size_t)(l * 128 + n) * 2 + 1) * 384 + c] = zin[5];
  }
  if (c < 256) {
    const float g = p.c_ln_g[l * 256 + c], bb = p.c_ln_b[l * 256 + c];
    const int h = c >> 6;
    float vn[4];
#pragma unroll
    for (int t = 0; t < 4; t++) {
      float m_ = rv[8 + t] * (1.f / 256.f);
      float var = rv[12 + t] * (1.f / 256.f) - m_ * m_;
      float rstd = rsqrtf(fmaxf(var, 0.f) + EPS);
      vn[t] = (cvv[t] - m_) * rstd * g + bb;
      p.out[O_SCV + ((size_t)(l * 128 + n) * 4 + t) * 256 + c] = vn[t];
    }
#pragma unroll
    for (int t = 0; t < 4; t++) {
      float acc = p.c_bs[(l * 4 + h) * 128 + t];
#pragma unroll
      for (int s = 0; s < 4; s++)
        if (s <= t) acc += p.c_ws[((size_t)(l * 4 + h) * 128 + t) * 128 + s] * vn[s];
      float yc = bf2f(inter[(Rs + t) * IW + 1536 + c]) * acc;
      p.mix[(Rs + t) * DM + 768 + c] = f2bf(yc);
    }
  }
  __syncthreads();
}

__device__ void phase2(const Params& p, int l, char* smem) {
  float* red = (float*)(smem + 90112);
  const int nb = gridDim.x, b = blockIdx.x;
  p2_stage_w(p, l, smem);
  {
    ATileRegs A;
    if (b < 512) p2_ab_load(p, b, A);
#pragma unroll 1
    for (int it = b; it < 512; it += nb) {
      p2_ab_store(A, smem);
      __syncthreads();
      const int nx = (it + nb < 512) ? it + nb : it;
      p2_ab_load(p, nx, A);
      p2_ab(p, l, it, smem);
    }
  }
  for (int it = b; it < 128; it += nb) {
    asm volatile("" ::: "memory");
    p2_c(p, l, it, smem);
  }
  for (int it = (b + nb - (128 % nb)) % nb; it < 128; it += nb) {
    asm volatile("" ::: "memory");
    p2_s(p, l, it, red, (float*)smem);
  }
}

__device__ void phase4(const Params& p) {
  const int tid = otid();
  const float* ssq = p.sumsq + (size_t)2 * NTOK;
  for (int idx = blockIdx.x * NT + tid; idx < NTOK * 128; idx += gridDim.x * NT) {
    const int row = idx >> 7, c8 = idx & 127;
    uint4 v = *(const uint4*)(p.xb + (size_t)row * DM + c8 * 8);
    const float rs = rsqrtf(ssq[row] * (1.f / 1024.f) + EPS);
    float4 g0 = *(const float4*)(p.final_g + c8 * 8), g1 = *(const float4*)(p.final_g + c8 * 8 + 4);
    float f[8];
    unpack8(v, f);
    float* o = p.out + (size_t)row * DM + c8 * 8;
    *(float4*)o = make_float4(f[0] * rs * g0.x, f[1] * rs * g0.y, f[2] * rs * g0.z, f[3] * rs * g0.w);
    *(float4*)(o + 4) = make_float4(f[4] * rs * g1.x, f[5] * rs * g1.y, f[6] * rs * g1.z, f[7] * rs * g1.w);
  }
}

#define CEN_WORD(j) (XCD_BAR_WORDS + 64 * (j))
#define BAR_TOTAL_WORDS (XCD_BAR_WORDS + 64 * 16)
__global__ void __launch_bounds__(NT) fwd_megakernel(Params p) {
  extern __shared__ __attribute__((aligned(16))) char smem[];
  __shared__ uint4 xb_words;
  __shared__ uint4 sched_words;
  if (threadIdx.x == 0) {
    xb_words = make_uint4(0u, 0u, 0u, 0u);
    const unsigned x = xb_xcc_id();
    const unsigned slot = xb_add(&p.bar[CEN_WORD(x)], 1u);
    sched_words = make_uint4(slot, 1u, 0u, gridDim.x);
  }
  __syncthreads();
  XcdBarrier gb = xcd_barrier_post(p.bar, (volatile LAS unsigned*)&xb_words);
  const volatile LAS unsigned* sched = (const volatile LAS unsigned*)&sched_words;
  phase0(p, smem);
  xcd_barrier(gb);
  if (threadIdx.x == 0) {
    const unsigned x = xb_xcc_id();
    unsigned prefix = 0u, mine = 1u;
#pragma unroll
    for (unsigned j = 0; j < 16; ++j) {
      const unsigned c = xb_ld(&p.bar[CEN_WORD(j)]);
      prefix += (j < x) ? c : 0u;
      mine = (j == x) ? c : mine;
    }
    volatile LAS unsigned* sw = (volatile LAS unsigned*)&sched_words;
    sw[1] = mine;
    sw[2] = prefix;
  }
  __syncthreads();
#pragma unroll 1
  for (int l = 0; l < 2; l++) {
    phase1(p, l, smem);
    xcd_barrier(gb);
    phase2(p, l, smem);
    xcd_barrier(gb);
    phase3(p, l, smem);
    xcd_barrier(gb);
  }
  phase4(p);
}

extern "C" void kernel_launch(void* const* d_in, const int* in_sizes, int n_in, void* d_out, int out_size, void* d_ws,
                              size_t ws_size, hipStream_t stream) {
  static int grid_blocks = 0;
  if (!grid_blocks) {
    int dev = 0, cus = 0, per_cu = 0;
    hipGetDevice(&dev);
    hipDeviceGetAttribute(&cus, hipDeviceAttributeMultiprocessorCount, dev);
    hipFuncSetAttribute((const void*)fwd_megakernel, hipFuncAttributeMaxDynamicSharedMemorySize, LDS_BYTES);
    hipOccupancyMaxActiveBlocksPerMultiprocessor(&per_cu, (const void*)fwd_megakernel, NT, LDS_BYTES);
    if (per_cu < 1) { fprintf(stderr, "occupancy query returned %d\n", per_cu); per_cu = 1; }
    if (per_cu > 1) per_cu = 1;
    grid_blocks = cus * per_cu;
  }
  Params p{};
  p.x_prompt = (const float*)d_in[0];
  p.x_sample = (const float*)d_in[1];
  p.state_a = (const float*)d_in[2];
  p.state_b = (const float*)d_in[3];
  p.norm_g = (const float*)d_in[4];
  p.w_in = (const float*)d_in[5];
  p.a_conv_w = (const float*)d_in[6];
  p.a_conv_b = (const float*)d_in[7];
  p.a_ln_g = (const float*)d_in[8];
  p.a_ln_b = (const float*)d_in[9];
  p.b_conv_w = (const float*)d_in[10];
  p.c_ln_g = (const float*)d_in[11];
  p.c_ln_b = (const float*)d_in[12];
  p.c_ws = (const float*)d_in[13];
  p.c_bs = (const float*)d_in[14];
  p.w_out = (const float*)d_in[15];
  p.final_g = (const float*)d_in[16];
  p.out = (float*)d_out;
  char* ws = (char*)d_ws;
  size_t off = 0;
  auto take = [&](size_t bytes) { char* r = ws + off; off += (bytes + 255) & ~(size_t)255; return r; };
  p.win_b = (u16*)take((size_t)2 * 3584 * DM * 2);
  p.wout_b = (u16*)take((size_t)2 * DM * DM * 2);
  p.wc_b = (u16*)take((size_t)2 * 4 * 128 * 128 * 2);
  p.xb = (u16*)take((size_t)NTOK * DM * 2);
  p.inter = (u16*)take((size_t)NTOK * IW * 2);
  p.mix = (u16*)take((size_t)NTOK * DM * 2);
  p.sumsq = (float*)take((size_t)3 * NTOK * 4);
  p.rsw = (float*)take((size_t)2 * 4 * 128 * 4);
  p.bar = (unsigned*)take((size_t)BAR_TOTAL_WORDS * 4);
  hipMemsetAsync(p.bar, 0, (size_t)BAR_TOTAL_WORDS * 4, stream);
  void* args[] = {&p};
  hipError_t e = hipLaunchCooperativeKernel((const void*)fwd_megakernel, dim3(grid_blocks), dim3(NT), args, LDS_BYTES, stream);
  if (e != hipSuccess) fprintf(stderr, "cooperative launch failed: %s (grid %d)\n", hipGetErrorString(e), grid_blocks);
}
```

```cpp
#include <hip/hip_runtime.h>
#include <cstdio>
#include <cstdint>
#include <type_traits>

typedef unsigned short u16;
typedef short bf16x8 __attribute__((ext_vector_type(8)));
typedef float f32x16 __attribute__((ext_vector_type(16)));
typedef unsigned int u32x4 __attribute__((ext_vector_type(4)));

constexpr int NTOK = 16896, NPR = 16384, DM = 1024, INW = 3456, IW = 2048;
constexpr int NT = 512;
constexpr int INWP = 3584;
constexpr int LDS_BYTES = 131072;
constexpr float EPS = 1e-6f;

constexpr size_t O_SAP = 17301504, O_SBP = 17485824, O_SAS = 17498112, O_SBS = 20447232, O_SCV = 20643840;

struct Params {
  const float *x_prompt, *x_sample, *state_a, *state_b, *norm_g, *w_in, *a_conv_w, *a_conv_b, *a_ln_g, *a_ln_b,
      *b_conv_w, *c_ln_g, *c_ln_b, *c_ws, *c_bs, *w_out, *final_g;
  float* out;
  u16 *win_b, *wout_b, *wc_b, *xb, *inter, *mix;
  float *sumsq, *rsw;
  unsigned* bar;
};

__device__ __forceinline__ u16 f2bf(float f) {
  unsigned u = __float_as_uint(f);
  u += 0x7fffu + ((u >> 16) & 1u);
  return (u16)(u >> 16);
}
__device__ __forceinline__ float bf2f(u16 h) { return __uint_as_float(((unsigned)h) << 16); }
__device__ __forceinline__ unsigned pack2(float a, float b) {
  unsigned r;
  asm volatile("v_cvt_pk_bf16_f32 %0, %1, %2" : "=v"(r) : "v"(a), "v"(b));
  return r;
}
__device__ __forceinline__ float sigmoidf_(float x) { return __builtin_amdgcn_rcpf(1.f + __builtin_amdgcn_exp2f(-1.44269504f * x)); }
__device__ __forceinline__ float siluf_(float x) { return x * __builtin_amdgcn_rcpf(1.f + __builtin_amdgcn_exp2f(-1.44269504f * x)); }

__device__ __forceinline__ void unpack8(const uint4& v, float (&f)[8]) {
  f[0] = __uint_as_float(v.x << 16); f[1] = __uint_as_float(v.x & 0xffff0000u);
  f[2] = __uint_as_float(v.y << 16); f[3] = __uint_as_float(v.y & 0xffff0000u);
  f[4] = __uint_as_float(v.z << 16); f[5] = __uint_as_float(v.z & 0xffff0000u);
  f[6] = __uint_as_float(v.w << 16); f[7] = __uint_as_float(v.w & 0xffff0000u);
}
__device__ __forceinline__ uint4 pack8(const float (&f)[8]) {
  uint4 o;
  o.x = pack2(f[0], f[1]); o.y = pack2(f[2], f[3]); o.z = pack2(f[4], f[5]); o.w = pack2(f[6], f[7]);
  return o;
}

__device__ __forceinline__ __amdgpu_buffer_rsrc_t mk_rsrc(void* base, unsigned bytes) {
  return __builtin_amdgcn_make_buffer_rsrc(base, 0, bytes, 0x00020000);
}
__device__ __forceinline__ void st16_wt(__amdgpu_buffer_rsrc_t r, unsigned byte_off, const uint4& v) {
  u32x4 d = {v.x, v.y, v.z, v.w};
  __builtin_amdgcn_raw_buffer_store_b128(d, r, byte_off, 0, 16);
}

__device__ __forceinline__ int otid() {
  int t = threadIdx.x;
  asm volatile("" : "+v"(t));
  return t;
}

__device__ __forceinline__ int vcol_src(int vc);

#define XB_TMO      128
#define XB_XCNT(j)  (256  + 64 * (j))
#define XB_XSUB(j)  (1280 + 64 * (j))
#define XB_XGEN(j)  (2304 + 64 * (j))
#define XB_TOP      3328
#define XB_TOPGEN   3392
#define XCD_BAR_WORDS 3456
#define XB_SPIN_CAP (1u << 18)
#define LAS __attribute__((address_space(3)))

__device__ __forceinline__ unsigned xb_ld(unsigned* p)              { return __hip_atomic_load(p, __ATOMIC_RELAXED, __HIP_MEMORY_SCOPE_AGENT); }
__device__ __forceinline__ unsigned xb_add(unsigned* p, unsigned v) { return __hip_atomic_fetch_add(p, v, __ATOMIC_RELAXED, __HIP_MEMORY_SCOPE_AGENT); }
__device__ __forceinline__ unsigned xb_xcc_id() { return (unsigned)__builtin_amdgcn_s_getreg((3 << 11) | 20) & 0xFu; }
#define XB_SPIN(cond, bar) do { unsigned _sp = 0; while (cond) { __builtin_amdgcn_s_sleep(1); \
    if ((++_sp & 255u) == 0u) { if (xb_ld(&(bar)[XB_TMO])) break; if (_sp > XB_SPIN_CAP) { atomicAdd(&(bar)[XB_TMO], 1u); break; } } } } while (0)

struct XcdBarrier {
  unsigned* bar; unsigned x;
  volatile LAS unsigned* st;
};
__device__ __forceinline__ XcdBarrier xcd_barrier_post(unsigned* bar, volatile LAS unsigned* st) {
  XcdBarrier b; b.bar = bar; b.x = xb_xcc_id(); b.st = st;
  if (threadIdx.x == 0) (void)xb_add(&bar[XB_XCNT(b.x)], 1u);
  return b;
}
__device__ __forceinline__ void xcd_barrier_complete(unsigned* bar, unsigned x, unsigned& nloc, unsigned& nx) {
  const unsigned G = gridDim.x * gridDim.y * gridDim.z;
  unsigned sum, cnt, mine, sp = 0u;
  for (;;) {
    sum = 0u; cnt = 0u; mine = 0u;
#pragma unroll
    for (unsigned j = 0; j < 16; ++j) { const unsigned c = xb_ld(&bar[XB_XCNT(j)]); sum += c; cnt += (c > 0u) ? 1u : 0u; mine = (j == x) ? c : mine; }
    if (sum == G) break;
    __builtin_amdgcn_s_sleep(1);
    if ((++sp & 255u) == 0u) { if (xb_ld(&bar[XB_TMO])) break; if (sp > XB_SPIN_CAP) { atomicAdd(&bar[XB_TMO], 1u); break; } }
  }
  nloc = mine > 0u ? mine : 1u; nx = cnt > 0u ? cnt : 1u;
}
__device__ __forceinline__ void xcd_barrier(const XcdBarrier& b) {
  asm volatile("s_waitcnt vmcnt(0)" ::: "memory");
  __syncthreads();
  if (threadIdx.x == 0) {
    unsigned* bar = b.bar;
    __builtin_amdgcn_s_waitcnt(0);
    unsigned nloc = b.st[0], nx = b.st[1];
    if (nloc == 0u) { xcd_barrier_complete(bar, b.x, nloc, nx); b.st[0] = nloc; b.st[1] = nx; }
    const unsigned old = xb_add(&bar[XB_XSUB(b.x)], 1u);
    const unsigned gen = old / nloc;
    if (old + 1u == (gen + 1u) * nloc) {
      __builtin_amdgcn_fence(__ATOMIC_RELEASE, "agent");
      asm volatile("s_waitcnt vmcnt(0)" ::: "memory");
      const unsigned og = xb_add(&bar[XB_TOP], 1u);
      const unsigned tg = og / nx;
      if (og + 1u == (tg + 1u) * nx) xb_add(&bar[XB_TOPGEN], 1u);
      else XB_SPIN(xb_ld(&bar[XB_TOPGEN]) == tg, bar);
      __builtin_amdgcn_fence(__ATOMIC_ACQUIRE, "agent");
      xb_add(&bar[XB_XGEN(b.x)], 1u);
      asm volatile("s_waitcnt vmcnt(0)" ::: "memory");
    } else {
      XB_SPIN(xb_ld(&bar[XB_XGEN(b.x)]) == gen, bar);
      __builtin_amdgcn_fence(__ATOMIC_ACQUIRE, "agent");
      asm volatile("s_waitcnt vmcnt(0)" ::: "memory");
    }
  }
  __syncthreads();
}

__device__ void p0_transpose(const float* __restrict__ W, int ncols, const float* __restrict__ g, u16* __restrict__ outp,
                             int k0, int v0, bool mapv, float* tile) {
  int tid = otid();
  float vals[16];
#pragma unroll
  for (int i = 0; i < 16; i++) {
    int e = tid + i * NT;
    int kk = e >> 7, v = e & 127;
    int src = mapv ? vcol_src(v0 + v) : (v0 + v);
    float val = 0.f;
    if (src >= 0) val = W[(size_t)(k0 + kk) * ncols + src];
    vals[i] = val;
  }
#pragma unroll
  for (int i = 0; i < 16; i++) {
    int e = tid + i * NT;
    int kk = e >> 7, v = e & 127;
    float val = vals[i];
    if (g) val *= g[k0 + kk];
    tile[kk * 129 + v] = val;
  }
  __syncthreads();
#pragma unroll
  for (int h = 0; h < 2; h++) {
    int v = (tid >> 3) + h * 64, kq = tid & 7;
    const float* tp = tile + (kq * 8) * 129 + v;
    uint4 o;
    o.x = pack2(tp[0], tp[129]);
    o.y = pack2(tp[2 * 129], tp[3 * 129]);
    o.z = pack2(tp[4 * 129], tp[5 * 129]);
    o.w = pack2(tp[6 * 129], tp[7 * 129]);
    *(uint4*)(outp + (size_t)(v0 + v) * 1024 + k0 + kq * 8) = o;
  }
  __syncthreads();
}

__device__ void p0_weights(const Params& p, int l, int rank, int nranks, float* tile) {
  for (int it = rank; it < 16 * 28; it += nranks) {
    int kb = it / 28, vb = it % 28;
    p0_transpose(p.w_in + (size_t)l * DM * INW, INW, p.norm_g + l * DM, p.win_b + (size_t)l * INWP * DM, kb * 64, vb * 128, true, tile);
  }
  for (int it = rank; it < 16 * 8; it += nranks) {
    int kb = it >> 3, vb = it & 7;
    p0_transpose(p.w_out + (size_t)l * DM * DM, DM, nullptr, p.wout_b + (size_t)l * DM * DM, kb * 64, vb * 128, false, tile);
  }
}

__device__ void phase0(const Params& p, char* smem) {
  float* tile = (float*)smem;
  int nb = gridDim.x, b = blockIdx.x, tid = otid();
  const int wave = tid >> 6, lane = tid & 63;
  for (int e = b * NT + tid; e < 2 * NTOK; e += nb * NT) p.sumsq[NTOK + e] = 0.f;
  for (int e = b * NT + tid; e < 2 * 4 * 128 * 128; e += nb * NT) {
    int s = e & 127, t = (e >> 7) & 127;
    p.wc_b[e] = (s <= t) ? f2bf(p.c_ws[e]) : (u16)0;
  }
  for (int r = b * 8 + wave; r < 2 * 4 * 128; r += nb * 8) {
    const int t = r & 127;
    const float* wr = p.c_ws + (size_t)r * 128;
    float s = 0.f;
    if (lane <= t) s += bf2f(f2bf(wr[lane]));
    if (lane + 64 <= t) s += bf2f(f2bf(wr[lane + 64]));
#pragma unroll
    for (int m = 32; m >= 1; m >>= 1) s += __shfl_xor(s, m);
    if (lane == 0) p.rsw[r] = s;
  }
  for (int row = (b * 8 + wave) * 2; row < NTOK; row += nb * 16) {
    const float* xr0 = (row < NPR) ? (p.x_prompt + (size_t)row * DM) : (p.x_sample + (size_t)(row - NPR) * DM);
    const float* xr1 = xr0 + DM;
    float4 v0[4], v1[4];
#pragma unroll
    for (int j = 0; j < 4; j++) { v0[j] = *(const float4*)(xr0 + (j * 64 + lane) * 4); v1[j] = *(const float4*)(xr1 + (j * 64 + lane) * 4); }
    float s0 = 0.f, s1 = 0.f;
#pragma unroll
    for (int j = 0; j < 4; j++) {
      s0 += v0[j].x * v0[j].x + v0[j].y * v0[j].y + v0[j].z * v0[j].z + v0[j].w * v0[j].w;
      s1 += v1[j].x * v1[j].x + v1[j].y * v1[j].y + v1[j].z * v1[j].z + v1[j].w * v1[j].w;
      *(uint2*)(p.xb + (size_t)row * DM + (j * 64 + lane) * 4) = make_uint2(pack2(v0[j].x, v0[j].y), pack2(v0[j].z, v0[j].w));
      *(uint2*)(p.xb + (size_t)(row + 1) * DM + (j * 64 + lane) * 4) = make_uint2(pack2(v1[j].x, v1[j].y), pack2(v1[j].z, v1[j].w));
    }
#pragma unroll
    for (int m = 32; m >= 1; m >>= 1) { s0 += __shfl_xor(s0, m); s1 += __shfl_xor(s1, m); }
    if (lane == 0) { p.sumsq[row] = s0; p.sumsq[row + 1] = s1; }
  }
  p0_weights(p, 0, b, nb, tile);
}

namespace pg8 {
#define PG8_LAS __attribute__((address_space(3)))
typedef unsigned short bf16_t;
typedef short bf16x8 __attribute__((ext_vector_type(8)));
typedef float f32x4 __attribute__((ext_vector_type(4)));
typedef unsigned u32x4 __attribute__((ext_vector_type(4)));
constexpr int BM = 256, BK = 64, HALF = 128, HTB = HALF * BK * 2  , STAGE_BYTES = 8 * HTB, NXCD = 8, WGM = 8;

__host__ __device__ __forceinline__ int lds_byte(int r, int c) { const int st = (r >> 4) * 2 + (c >> 5), rr = r & 15, cc = c & 31, ob = rr * 64 + cc * 2; return st * 1024 + (ob ^ (((ob >> 9) & 1) << 5)); }
__host__ __device__ __forceinline__ void stage_rc(int b, int& R, int& C) { const int st = b / 1024, sb = b % 1024, swz = sb ^ (((sb >> 9) & 1) << 5); R = (st >> 1) * 16 + swz / 64; C = (st & 1) * 32 + (swz % 64) / 2; }
__host__ __device__ __forceinline__ int perm32(int rho) { const int n = rho >> 4, i = rho & 15; return 8 * (i >> 2) + 4 * n + (i & 3); }

struct Unit { int pm, pn; };
struct Gemm { const bf16_t* A; const bf16_t* Bt; int M, N, K; };

struct StaticOrder {
    int nM, nN, nwg, G, c;
    __host__ __device__ void init(int M, int N, int G_, int c_) { nM = M / BM; nN = N / BM; nwg = nM * nN; G = G_; c = c_; }
    __host__ __device__ bool next(int i, Unit& u) const {
        const long L = (long)i * G + c; if (L >= nwg) return false;
        int wgid = (int)L; { const int q = nwg / NXCD, r = nwg % NXCD, xcd = wgid % NXCD, off = wgid / NXCD; wgid = (xcd < r ? xcd * (q + 1) : r * (q + 1) + (xcd - r) * q) + off; }
        const int nig = WGM * nN, gid = wgid / nig, fm = gid * WGM, gsz = (nM - fm) < WGM ? (nM - fm) : WGM;
        u.pm = fm + ((wgid % nig) % gsz); u.pn = (wgid % nig) / gsz; return true;
    }
    __device__ __forceinline__ void a_ready(const Unit&) const {}
    __device__ __forceinline__ void done(const Unit&) const {}
};
__device__ __forceinline__ unsigned cvt_pk_bf16(float lo, float hi) { unsigned r; asm volatile("v_cvt_pk_bf16_f32 %0, %1, %2" : "=v"(r) : "v"(lo), "v"(hi)); return r; }
template <class Epi, class Sched, bool STAMP = false>
__device__ __forceinline__ void gemm_phase(PG8_LAS unsigned char* lds, const Gemm g, const Sched& S, const Epi& E, unsigned long long* stamps) {
    const int tid = otid(), wid = __builtin_amdgcn_readfirstlane(tid >> 6), lane = tid & 63, wr = wid >> 2, wc = wid & 3, fr = lane & 15, fq = lane >> 4;
    const int K = g.K, nt = K / BK;
    int ts_lo = 0, ts_hi = 0, nts = 0; const unsigned long long rt_entry = STAMP ? (unsigned long long)wall_clock64() : 0ull;
#define PG8_STAMP() do { if (STAMP && wid == 0 && nts < 64) { const unsigned long long _c = (unsigned long long)clock64(); \
        ts_lo = (lane == nts) ? (int)(unsigned)_c : ts_lo; ts_hi = (lane == nts) ? (int)(unsigned)(_c >> 32) : ts_hi; ++nts; } } while (0)
    PG8_STAMP();
    unsigned voffA[2], voffB[2];
#pragma unroll
    for (int i = 0; i < 2; ++i) { int R, C; stage_rc(tid * 16 + i * 8192, R, C); const int Rb = Epi::PERM ? ((R & ~31) + perm32(R & 31)) : R;
        voffA[i] = (unsigned)(R * K + C) * 2u; voffB[i] = (unsigned)(Rb * K + C) * 2u; }
    const size_t kstep = (size_t)(BK * 2);
    const size_t hstep = (size_t)HALF * K * 2;
    const size_t tstep = 2 * hstep;
    const unsigned ldsw = (unsigned)wid * 1024u;
    const int aoff = lds_byte(wr * 64 + fr, fq * 8), boff = lds_byte(wc * 32 + fr, fq * 8);
#define PG8_SA(b, h) (((b) * 2 + (h)) * HTB)
#define PG8_SB(b, h) ((4 + (b) * 2 + (h)) * HTB)
#define PG8_STAGE(bufoff, gbase, voff) do { _Pragma("unroll") for (int _i = 0; _i < 2; ++_i) \
        __builtin_amdgcn_global_load_lds((const unsigned*)((const char*)(gbase) + (voff)[_i]), (PG8_LAS unsigned*)(lds + (bufoff) + ldsw + _i * 8192), 16, 0, 0); } while (0)
#define PG8_LDA(dst, b, h) do { _Pragma("unroll") for (int m = 0; m < 4; ++m) _Pragma("unroll") for (int k = 0; k < 2; ++k) dst[m][k] = *(const PG8_LAS bf16x8*)(lds + PG8_SA(b, h) + aoff + m * 2048 + k * 1024); } while (0)
#define PG8_LDB(dst, b, h) do { _Pragma("unroll") for (int n = 0; n < 2; ++n) _Pragma("unroll") for (int k = 0; k < 2; ++k) dst[n][k] = *(const PG8_LAS bf16x8*)(lds + PG8_SB(b, h) + boff + n * 2048 + k * 1024); } while (0)
#define PG8_MMA(ai, bj, At, Bt) do { __builtin_amdgcn_s_setprio(1); _Pragma("unroll") for (int m = 0; m < 4; ++m) _Pragma("unroll") for (int n = 0; n < 2; ++n) _Pragma("unroll") for (int k = 0; k < 2; ++k) \
        acc[ai][bj][m][n] = __builtin_amdgcn_mfma_f32_16x16x32_bf16(Bt[n][k], At[m][k], acc[ai][bj][m][n], 0, 0, 0); __builtin_amdgcn_s_setprio(0); } while (0)
#define PG8_WAIT_V(n) asm volatile("s_waitcnt vmcnt(" #n ")" ::: "memory")
#define PG8_WAIT_L(n) asm volatile("s_waitcnt lgkmcnt(" #n ")" ::: "memory")
#define PG8_BAR __builtin_amdgcn_s_barrier()
#define PG8_SCHED __builtin_amdgcn_sched_barrier(0)
    Unit cur, nxt; int ui = 0;
    if (!S.next(0, cur)) return;
    f32x4 acc[2][2][4][2];
#pragma unroll
    for (int a = 0; a < 2; ++a)
#pragma unroll
        for (int b = 0; b < 2; ++b)
#pragma unroll
            for (int m = 0; m < 4; ++m)
#pragma unroll
                for (int n = 0; n < 2; ++n) acc[a][b][m][n] = (f32x4){0.f, 0.f, 0.f, 0.f};
    bf16x8 At[4][2], B0[2][2], B1[2][2];
    const char* cA = (const char*)g.A + (size_t)cur.pm * tstep; const char* cB = (const char*)g.Bt + (size_t)cur.pn * tstep;
    typename Epi::Pre pre;
    E.preload(cur, wr, fr, pre);
    S.a_ready(cur);
    PG8_STAGE(PG8_SB(0, 0), cB, voffB); PG8_STAGE(PG8_SA(0, 0), cA, voffA); PG8_STAGE(PG8_SB(0, 1), cB + hstep, voffB); PG8_STAGE(PG8_SA(0, 1), cA + hstep, voffA);
    if (wr == 1) PG8_BAR;
    PG8_WAIT_V(4); PG8_BAR;
    PG8_STAGE(PG8_SB(1, 0), cB + kstep, voffB); PG8_STAGE(PG8_SA(1, 0), cA + kstep, voffA); PG8_STAGE(PG8_SB(1, 1), cB + hstep + kstep, voffB);
    PG8_WAIT_V(6); PG8_BAR;
    PG8_STAMP();
    for (;;) {
        const bool has_next = S.next(ui + 1, nxt);
        const char* nA = has_next ? (const char*)g.A + (size_t)nxt.pm * tstep : cA; const char* nB = has_next ? (const char*)g.Bt + (size_t)nxt.pn * tstep : cB;
        for (int t = 0; t < nt; t += 2) {
            const bool last = (t == nt - 2);
            const char* a1 = cA + (size_t)(t + 1) * kstep;
            const char* a2 = last ? nA : cA + (size_t)(t + 2) * kstep; const char* b2 = last ? nB : cB + (size_t)(t + 2) * kstep;
            const char* a3 = a2 + kstep; const char* b3 = b2 + kstep;
            if (last && has_next) S.a_ready(nxt);
            PG8_LDB(B0, 0, 0); PG8_SCHED; PG8_LDA(At, 0, 0); PG8_STAGE(PG8_SA(1, 1), a1 + hstep, voffA);
            PG8_WAIT_L(8); PG8_BAR; PG8_WAIT_L(0); PG8_MMA(0, 0, At, B0); PG8_BAR; PG8_SCHED;
            PG8_LDB(B1, 0, 1); PG8_STAGE(PG8_SB(0, 0), b2, voffB);
            PG8_BAR; PG8_WAIT_L(0); PG8_MMA(0, 1, At, B1); PG8_BAR;
            PG8_LDA(At, 0, 1); PG8_STAGE(PG8_SA(0, 0), a2, voffA);
            PG8_BAR; PG8_WAIT_L(0); PG8_MMA(1, 0, At, B0); PG8_BAR; PG8_SCHED;
            PG8_STAGE(PG8_SB(0, 1), b2 + hstep, voffB);
            PG8_WAIT_V(6); PG8_BAR; PG8_MMA(1, 1, At, B1); PG8_BAR;
            PG8_LDB(B0, 1, 0); PG8_SCHED; PG8_LDA(At, 1, 0); PG8_STAGE(PG8_SA(0, 1), a2 + hstep, voffA);
            PG8_WAIT_L(8); PG8_BAR; PG8_WAIT_L(0); PG8_MMA(0, 0, At, B0); PG8_BAR; PG8_SCHED;
            PG8_LDB(B1, 1, 1); PG8_STAGE(PG8_SB(1, 0), b3, voffB);
            PG8_BAR; PG8_WAIT_L(0); PG8_MMA(0, 1, At, B1); PG8_BAR;
            PG8_LDA(At, 1, 1); PG8_STAGE(PG8_SA(1, 0), a3, voffA);
            PG8_BAR; PG8_WAIT_L(0); PG8_MMA(1, 0, At, B0); PG8_BAR; PG8_SCHED;
            PG8_STAGE(PG8_SB(1, 1), b3 + hstep, voffB);
            PG8_WAIT_V(6); PG8_BAR; PG8_MMA(1, 1, At, B1); PG8_BAR;
        }
        PG8_STAMP();
        if constexpr (!Epi::AFTER_DRAIN) { E(acc, cur, wr, wc, fr, fq, pre); S.done(cur); }
        PG8_STAMP();
        if (!has_next) break;
#pragma unroll
        for (int a = 0; a < 2; ++a)
#pragma unroll
            for (int b = 0; b < 2; ++b)
#pragma unroll
                for (int m = 0; m < 4; ++m)
#pragma unroll
                    for (int n = 0; n < 2; ++n) acc[a][b][m][n] = (f32x4){0.f, 0.f, 0.f, 0.f};
        cur = nxt; cA = nA; cB = nB; ++ui;
        E.preload(cur, wr, fr, pre);
    }
    PG8_WAIT_V(0);
    if (wr == 0) PG8_BAR;
    PG8_BAR;
    if constexpr (Epi::AFTER_DRAIN) { E.fused(acc, cur, wr, wc, fr, fq, lds, wid, lane); S.done(cur); }
    PG8_STAMP();
    if (STAMP && wid == 0) { stamps[lane] = lane < nts ? (((unsigned long long)(unsigned)ts_hi << 32) | (unsigned)ts_lo) : 0ull;
        if (lane == 62) stamps[62] = rt_entry; if (lane == 63) stamps[63] = (unsigned long long)wall_clock64(); }
#undef PG8_STAMP
#undef PG8_SA
#undef PG8_SB
#undef PG8_STAGE
#undef PG8_LDA
#undef PG8_LDB
#undef PG8_MMA
#undef PG8_WAIT_V
#undef PG8_WAIT_L
#undef PG8_BAR
#undef PG8_SCHED
}
}


__device__ __forceinline__ int vcol_src(int vc) {
  const int un = vc >> 8, h = (vc >> 7) & 1, i = vc & 127;
  if (un < 3) return (h ? 384 : 0) + 128 * un + i;
  if (un < 6) return (h ? 1920 : 1152) + 128 * (un - 3) + i;
  if (un < 9) return (h ? 2304 : 1536) + 128 * (un - 6) + i;
  if (un < 11) return (h ? 3200 : 2688) + 128 * (un - 9) + i;
  if (un == 11) return 768 + 128 * h + i;
  if (un == 12) return h ? (2944 + i) : (768 + 256 + i);
  return h ? -1 : (2944 + 128 + i);
}

typedef float f32x4_ __attribute__((ext_vector_type(4)));
struct Epi1 {
  static constexpr bool PERM = true, AFTER_DRAIN = false;
  u16* inter; const float* ssq;
  struct Pre { float s[8]; };
  __device__ __forceinline__ void preload(const pg8::Unit& u, int wr, int fr, Pre& P) const {
#pragma unroll
    for (int ai = 0; ai < 2; ++ai)
#pragma unroll
      for (int m = 0; m < 4; ++m) P.s[ai * 4 + m] = ssq[u.pm * 256 + 64 * wr + fr + 128 * ai + 16 * m];
  }
  __device__ __forceinline__ void operator()(const pg8::f32x4 (&acc)[2][2][4][2], const pg8::Unit& u, int wr, int wc, int fr, int fq, const Pre& P) const {
    const int un = u.pn;
    int k0, ob0, k1 = -1, ob1 = 0;
    if (un < 3) { k0 = 0; ob0 = 128 * un; }
    else if (un < 6) { k0 = 2; ob0 = 768 + 128 * (un - 3); }
    else if (un < 9) { k0 = 3; ob0 = 1152 + 128 * (un - 6); }
    else if (un < 11) { k0 = 3; ob0 = 1536 + 128 * (un - 9); }
    else if (un == 11) { k0 = 1; ob0 = 384; k1 = 1; ob1 = 384 + 128; }
    else if (un == 12) { k0 = 1; ob0 = 384 + 256; k1 = 4; ob1 = 1792; }
    else { k0 = 4; ob0 = 1792 + 128; k1 = -2; }
    const int cl = 32 * wc + 8 * fq;
    const int rbase = u.pm * 256 + 64 * wr + fr;
    const __amdgpu_buffer_rsrc_t irs = mk_rsrc(inter, (unsigned)NTOK * IW * 2u);
    auto body = [&](auto K0c, auto K1c) {
      constexpr int K0 = decltype(K0c)::value, K1 = decltype(K1c)::value;
#pragma unroll
      for (int ai = 0; ai < 2; ++ai)
#pragma unroll
        for (int m = 0; m < 4; ++m) {
          const int row = rbase + 128 * ai + 16 * m;
          const float rs = rsqrtf(P.s[ai * 4 + m] * (1.f / 1024.f) + EPS);
          float a[8], b[8], o[8];
#pragma unroll
          for (int i = 0; i < 4; i++) {
            a[i] = acc[ai][0][m][0][i] * rs; a[4 + i] = acc[ai][0][m][1][i] * rs;
            b[i] = acc[ai][1][m][0][i] * rs; b[4 + i] = acc[ai][1][m][1][i] * rs;
          }
          const unsigned rpo = ((unsigned)row * IW + cl) * 2u;
          if (K1 == -1) {
#pragma unroll
            for (int i = 0; i < 8; i++) o[i] = (K0 == 0) ? a[i] * sigmoidf_(b[i]) : (K0 == 2) ? a[i] * b[i] : a[i] * siluf_(b[i]);
            st16_wt(irs, rpo + ob0 * 2u, pack8(o));
          } else {
#pragma unroll
            for (int i = 0; i < 8; i++) o[i] = (K0 == 1) ? siluf_(a[i]) : a[i];
            st16_wt(irs, rpo + ob0 * 2u, pack8(o));
            if (K1 != -2) {
#pragma unroll
              for (int i = 0; i < 8; i++) o[i] = (K1 == 1) ? siluf_(b[i]) : b[i];
              st16_wt(irs, rpo + ob1 * 2u, pack8(o));
            }
          }
        }
    };
    using std::integral_constant;
    if (k1 == -1) {
      if (k0 == 0) body(integral_constant<int, 0>{}, integral_constant<int, -1>{});
      else if (k0 == 2) body(integral_constant<int, 2>{}, integral_constant<int, -1>{});
      else body(integral_constant<int, 3>{}, integral_constant<int, -1>{});
    } else if (k1 == 1) body(integral_constant<int, 1>{}, integral_constant<int, 1>{});
    else if (k1 == 4) body(integral_constant<int, 1>{}, integral_constant<int, 4>{});
    else body(integral_constant<int, 4>{}, integral_constant<int, -2>{});
  }
};
struct Epi2 {
  static constexpr bool PERM = true, AFTER_DRAIN = false;
  u16* xb; float* ssq;
  struct Pre {};
  __device__ __forceinline__ void preload(const pg8::Unit&, int, int, Pre&) const {}
  __device__ __forceinline__ void operator()(const pg8::f32x4 (&acc)[2][2][4][2], const pg8::Unit& u, int wr, int wc, int fr, int fq, const Pre&) const {
    const int cl = u.pn * 256 + 32 * wc + 8 * fq;
    const __amdgpu_buffer_rsrc_t xrs = mk_rsrc(xb, (unsigned)NTOK * DM * 2u);
#pragma unroll
    for (int ai = 0; ai < 2; ++ai)
#pragma unroll
      for (int m = 0; m < 4; ++m) {
        const int row = u.pm * 256 + 128 * ai + 64 * wr + 16 * m + fr;
        u16* rp = xb + (size_t)row * DM + cl;
        uint4 o0 = *(const uint4*)(rp), o1 = *(const uint4*)(rp + 128);
        float x0[8], x1[8];
        unpack8(o0, x0);
        unpack8(o1, x1);
        float ss = 0.f;
#pragma unroll
        for (int i = 0; i < 4; i++) {
          x0[i] += acc[ai][0][m][0][i]; x0[4 + i] += acc[ai][0][m][1][i];
          x1[i] += acc[ai][1][m][0][i]; x1[4 + i] += acc[ai][1][m][1][i];
        }
#pragma unroll
        for (int i = 0; i < 8; i++) ss += x0[i] * x0[i] + x1[i] * x1[i];
        const unsigned xo = ((unsigned)row * DM + cl) * 2u;
        st16_wt(xrs, xo, pack8(x0));
        st16_wt(xrs, xo + 256u, pack8(x1));
        ss += __shfl_xor(ss, 16);
        ss += __shfl_xor(ss, 32);
        if (fq == 0) atomicAdd(ssq + row, ss);
      }
  }
};

__device__ void phase1(const Params& p, int l, char* smem) {
  pg8::Gemm g{p.xb, p.win_b + (size_t)l * INWP * DM, NTOK, INWP, DM};
  pg8::StaticOrder S;
  S.init(NTOK, INWP, (int)gridDim.x, (int)blockIdx.x);
  Epi1 E{p.inter, p.sumsq + (size_t)l * NTOK};
  pg8::gemm_phase<Epi1, pg8::StaticOrder, false>((PG8_LAS unsigned char*)smem, g, S, E, nullptr);
  if (l == 0) {
    const int G = (int)gridDim.x, c = (int)blockIdx.x;
    const int rem = ((NTOK / 256) * (INWP / 256)) % G;
    const int nidle = (rem == 0) ? G : G - rem;
    const int rank = (rem == 0) ? c : c - rem;
    if (rank >= 0) p0_weights(p, 1, rank, nidle, (float*)smem);
  }
}
__device__ void phase3_sample(const Params& p, int l, char* smem) {
  const int tid = otid();
  const int lane = tid & 63, w = tid >> 6;
  const int l32 = lane & 31, lh = lane >> 5;
  float* part = (float*)smem;
  float* ssq = p.sumsq + (size_t)(l + 1) * NTOK;
  for (int T = blockIdx.x; T < 256; T += gridDim.x) {
    const int row0 = NPR + (T >> 4) * 32, col0 = (T & 15) * 64;
    const u16* ap = p.mix + (size_t)(row0 + l32) * DM + w * 128 + lh * 8;
    const u16* bp = p.wout_b + ((size_t)l * DM + col0 + l32) * DM + w * 128 + lh * 8;
    bf16x8 af[8], b0[8], b1[8];
#pragma unroll
    for (int s = 0; s < 8; s++) {
      af[s] = *(const bf16x8*)(ap + s * 16);
      b0[s] = *(const bf16x8*)(bp + s * 16);
      b1[s] = *(const bf16x8*)(bp + (size_t)32 * DM + s * 16);
    }
    f32x16 acc0, acc1;
#pragma unroll
    for (int r = 0; r < 16; r++) { acc0[r] = 0.f; acc1[r] = 0.f; }
#pragma unroll
    for (int s = 0; s < 8; s++) {
      acc0 = __builtin_amdgcn_mfma_f32_32x32x16_bf16(b0[s], af[s], acc0, 0, 0, 0);
      acc1 = __builtin_amdgcn_mfma_f32_32x32x16_bf16(b1[s], af[s], acc1, 0, 0, 0);
    }
#pragma unroll
    for (int r = 0; r < 16; r++) {
      part[((w * 2 + 0) * 16 + r) * 64 + lane] = acc0[r];
      part[((w * 2 + 1) * 16 + r) * 64 + lane] = acc1[r];
    }
    __syncthreads();
    float ss = 0.f;
    const int row = row0 + l32;
#pragma unroll
    for (int ni = 0; ni < 2; ni++) {
#pragma unroll
      for (int rr = 0; rr < 2; rr++) {
        const int r = 2 * w + rr;
        float v = 0.f;
#pragma unroll
        for (int pw = 0; pw < 8; pw++) v += part[((pw * 2 + ni) * 16 + r) * 64 + lane];
        const int col = col0 + ni * 32 + (r & 3) + 8 * (r >> 2) + 4 * lh;
        u16* xp = p.xb + (size_t)row * DM + col;
        v += bf2f(*xp);
        ss += v * v;
        *xp = f2bf(v);
      }
    }
    ss += __shfl_xor(ss, 32);
    if (lh == 0) atomicAdd(ssq + row, ss);
    __syncthreads();
  }
}

__device__ void phase3(const Params& p, int l, char* smem) {
  phase3_sample(p, l, smem);
  pg8::Gemm g{p.mix, p.wout_b + (size_t)l * DM * DM, NPR, DM, DM};
  pg8::StaticOrder S;
  S.init(NPR, DM, (int)gridDim.x, (int)blockIdx.x);
  Epi2 E{p.xb, p.sumsq + (size_t)(l + 1) * NTOK};
  pg8::gemm_phase<Epi2, pg8::StaticOrder, false>((PG8_LAS unsigned char*)smem, g, S, E, nullptr);
}

__device__ void p2_stage_w(const Params& p, int l, char* smem) {
  const int tid = otid();
  const float4* src = (const float4*)(p.a_conv_w + (size_t)l * 31 * 384);
  for (int f = tid; f < 36 * 96; f += NT) {
    int j = f / 96, q = f - j * 96;
    float4 v = make_float4(0.f, 0.f, 0.f, 0.f);
    if (j < 31) v = src[f];
    ((float4*)smem)[(j * 2 + (q & 1)) * 48 + (q >> 1)] = v;
  }
}

struct ATileRegs { u32x4 r0, r1, r2, r3, r4, r5; };
__device__ __forceinline__ void p2_ab_load(const Params& p, int it, ATileRegs& A) {
  const int tid = otid();
  const int R0 = it * 32;
  const int spos = R0 & 2047;
  const u16* __restrict__ inter = p.inter;
  auto ld = [&](int i) -> u32x4 {
    const int e = tid + i * NT;
    const int r = e / 48, ch = e - r * 48;
    u32x4 v = {0u, 0u, 0u, 0u};
    if (r < 62 && spos - 30 + r >= 0) v = *(const u32x4*)(inter + (size_t)(R0 - 30 + r) * IW + ch * 8);
    return v;
  };
  A.r0 = ld(0); A.r1 = ld(1); A.r2 = ld(2); A.r3 = ld(3); A.r4 = ld(4); A.r5 = ld(5);
}
__device__ __forceinline__ void p2_ab_store(const ATileRegs& A, char* smem) {
  const int tid = otid();
  char* atile = smem + 55296 + tid * 16;
  *(u32x4*)(atile) = A.r0;
  *(u32x4*)(atile + 1 * NT * 16) = A.r1;
  *(u32x4*)(atile + 2 * NT * 16) = A.r2;
  *(u32x4*)(atile + 3 * NT * 16) = A.r3;
  *(u32x4*)(atile + 4 * NT * 16) = A.r4;
  *(u32x4*)(atile + 5 * NT * 16) = A.r5;
}

typedef float f32x2 __attribute__((ext_vector_type(2)));
__device__ void p2_ab(const Params& p, int l, int it, char* smem) {
  const int tid = otid();
  const int lane = tid & 63, w = tid >> 6;
  const bool active = lane < 48;
  const int o = active ? lane : 47;
  const int R0 = it * 32;
  const int spos = R0 & 2047;
  const int bseq = R0 >> 11;
  const bool last = (spos == 2016);
  const u16* __restrict__ inter = p.inter;
  char* atile = smem + 55296;
  const float4* wts = (const float4*)smem;
  const size_t rowq = (size_t)R0 + 4 * w;
  const __amdgpu_buffer_rsrc_t mrs = mk_rsrc(p.mix, (unsigned)NTOK * DM * 2u);
  uint4 szv[4], gbv[4], zv[6];
#pragma unroll
  for (int t = 0; t < 4; t++) {
    szv[t] = *(const uint4*)(inter + (rowq + t) * IW + 384 + 8 * o);
    gbv[t] = *(const uint4*)(inter + (rowq + t) * IW + 1152 + 8 * o);
  }
#pragma unroll
  for (int s2 = 0; s2 < 6; s2++) {
    zv[s2] = make_uint4(0, 0, 0, 0);
    if (spos + 4 * w - 2 + s2 >= 0) zv[s2] = *(const uint4*)(inter + (rowq - 2 + s2) * IW + 768 + 8 * o);
  }
  f32x2 acc2[4][4];
  {
    float4 b0 = *(const float4*)(p.a_conv_b + l * 384 + 8 * o), b1 = *(const float4*)(p.a_conv_b + l * 384 + 8 * o + 4);
#pragma unroll
    for (int t = 0; t < 4; t++) {
      acc2[t][0] = (f32x2){b0.x, b0.y}; acc2[t][1] = (f32x2){b0.z, b0.w};
      acc2[t][2] = (f32x2){b1.x, b1.y}; acc2[t][3] = (f32x2){b1.z, b1.w};
    }
  }
  f32x2 wwin[4][4];
#pragma unroll
  for (int u = 0; u < 4; u++)
#pragma unroll
    for (int c = 0; c < 4; c++) wwin[u][c] = (f32x2){0.f, 0.f};
  const char* arow = atile + (4 * w) * 768 + o * 16;
#pragma unroll 1
  for (int s4 = 0; s4 < 36; s4 += 4) {
    const char* ar = arow + s4 * 768;
    const float4* wr = wts + (s4 * 2) * 48 + o;
#pragma unroll
    for (int u = 0; u < 4; u++) {
      uint4 av = *(const uint4*)(ar + u * 768);
      float4 wa = wr[(u * 2) * 48], wb = wr[(u * 2 + 1) * 48];
      f32x2 v[4];
      v[0] = (f32x2){__uint_as_float(av.x << 16), __uint_as_float(av.x & 0xffff0000u)};
      v[1] = (f32x2){__uint_as_float(av.y << 16), __uint_as_float(av.y & 0xffff0000u)};
      v[2] = (f32x2){__uint_as_float(av.z << 16), __uint_as_float(av.z & 0xffff0000u)};
      v[3] = (f32x2){__uint_as_float(av.w << 16), __uint_as_float(av.w & 0xffff0000u)};
      wwin[u][0] = (f32x2){wa.x, wa.y}; wwin[u][1] = (f32x2){wa.z, wa.w};
      wwin[u][2] = (f32x2){wb.x, wb.y}; wwin[u][3] = (f32x2){wb.z, wb.w};
#pragma unroll
      for (int t = 0; t < 4; t++) {
#pragma unroll
        for (int c = 0; c < 4; c++) acc2[t][c] = __builtin_elementwise_fma(wwin[(u - t) & 3][c], v[c], acc2[t][c]);
      }
    }
  }
  if (last && active) {
#pragma unroll
    for (int t = 0; t < 4; t++) {
      int pp = spos + 4 * w + t;
      if (pp >= 2018) {
        float v[8];
        unpack8(*(const uint4*)(arow + (30 + t) * 768), v);
        float* so = p.out + O_SAP + ((size_t)(l * 8 + bseq) * 30 + (pp - 2018)) * 384 + 8 * o;
        *(float4*)so = make_float4(v[0], v[1], v[2], v[3]);
        *(float4*)(so + 4) = make_float4(v[4], v[5], v[6], v[7]);
      }
    }
  }
  float acc[4][8];
#pragma unroll
  for (int t = 0; t < 4; t++)
#pragma unroll
    for (int c = 0; c < 4; c++) { acc[t][2 * c] = acc2[t][c].x; acc[t][2 * c + 1] = acc2[t][c].y; }
  float s1[4], s2[4];
#pragma unroll
  for (int t = 0; t < 4; t++) {
    float a = 0.f, b = 0.f;
#pragma unroll
    for (int c = 0; c < 8; c++) { a += acc[t][c]; b += acc[t][c] * acc[t][c]; }
    s1[t] = active ? a : 0.f;
    s2[t] = active ? b : 0.f;
  }
#pragma unroll
  for (int t = 0; t < 4; t++) {
#pragma unroll
    for (int m = 32; m >= 1; m >>= 1) { s1[t] += __shfl_xor(s1[t], m); s2[t] += __shfl_xor(s2[t], m); }
  }
  {
    float g8[8], b8[8];
    {
      float4 a0 = *(const float4*)(p.a_ln_g + l * 384 + 8 * o), a1 = *(const float4*)(p.a_ln_g + l * 384 + 8 * o + 4);
      float4 c0 = *(const float4*)(p.a_ln_b + l * 384 + 8 * o), c1 = *(const float4*)(p.a_ln_b + l * 384 + 8 * o + 4);
      g8[0] = a0.x; g8[1] = a0.y; g8[2] = a0.z; g8[3] = a0.w; g8[4] = a1.x; g8[5] = a1.y; g8[6] = a1.z; g8[7] = a1.w;
      b8[0] = c0.x; b8[1] = c0.y; b8[2] = c0.z; b8[3] = c0.w; b8[4] = c1.x; b8[5] = c1.y; b8[6] = c1.z; b8[7] = c1.w;
    }
#pragma unroll
    for (int t = 0; t < 4; t++) {
      float mu = s1[t] * (1.f / 384.f);
      float var = s2[t] * (1.f / 384.f) - mu * mu;
      float rstd = rsqrtf(fmaxf(var, 0.f) + EPS);
      float sz[8], y[8];
      unpack8(szv[t], sz);
#pragma unroll
      for (int c = 0; c < 8; c++) y[c] = siluf_((acc[t][c] - mu) * rstd * g8[c] + b8[c]) * sz[c];
      if (active) st16_wt(mrs, ((unsigned)(rowq + t) * DM + 8 * o) * 2u, pack8(y));
    }
  }
  {
    float w0[8], w1[8], w2[8];
    {
      const float* bw = p.b_conv_w + (size_t)l * 3 * 384 + 8 * o;
      float4 a0 = *(const float4*)(bw), a1 = *(const float4*)(bw + 4);
      float4 c0 = *(const float4*)(bw + 384), c1 = *(const float4*)(bw + 384 + 4);
      float4 d0 = *(const float4*)(bw + 768), d1 = *(const float4*)(bw + 768 + 4);
      w0[0] = a0.x; w0[1] = a0.y; w0[2] = a0.z; w0[3] = a0.w; w0[4] = a1.x; w0[5] = a1.y; w0[6] = a1.z; w0[7] = a1.w;
      w1[0] = c0.x; w1[1] = c0.y; w1[2] = c0.z; w1[3] = c0.w; w1[4] = c1.x; w1[5] = c1.y; w1[6] = c1.z; w1[7] = c1.w;
      w2[0] = d0.x; w2[1] = d0.y; w2[2] = d0.z; w2[3] = d0.w; w2[4] = d1.x; w2[5] = d1.y; w2[6] = d1.z; w2[7] = d1.w;
    }
    float z[6][8];
#pragma unroll
    for (int s2i = 0; s2i < 6; s2i++) unpack8(zv[s2i], z[s2i]);
#pragma unroll
    for (int t = 0; t < 4; t++) {
      float gb[8], y[8];
      unpack8(gbv[t], gb);
#pragma unroll
      for (int c = 0; c < 8; c++) y[c] = gb[c] * (w0[c] * z[t][c] + w1[c] * z[t + 1][c] + w2[c] * z[t + 2][c]);
      if (active) st16_wt(mrs, ((unsigned)(rowq + t) * DM + 384 + 8 * o) * 2u, pack8(y));
    }
    if (last && w == 7 && active) {
#pragma unroll
      for (int i = 0; i < 2; i++) {
        float* so = p.out + O_SBP + ((size_t)(l * 8 + bseq) * 2 + i) * 384 + 8 * o;
        *(float4*)so = make_float4(z[4 + i][0], z[4 + i][1], z[4 + i][2], z[4 + i][3]);
        *(float4*)(so + 4) = make_float4(z[4 + i][4], z[4 + i][5], z[4 + i][6], z[4 + i][7]);
      }
    }
  }
  __syncthreads();
}

__device__ void p2_c(const Params& p, int l, int ci, char* smem) {
  const int tid = otid();
  const int lane = tid & 63, w = tid >> 6;
  const int l32 = lane & 31, lh = lane >> 5;
  const int R0 = ci * 128;
  const u16* __restrict__ inter = p.inter;
  bf16x8 wf[4][8];
  {
    const u16* wb = p.wc_b + ((size_t)(l * 4 + (w >> 1)) * 128 + l32) * 128 + lh * 8;
#pragma unroll
    for (int ks = 0; ks < 8; ks++)
#pragma unroll
      for (int ti = 0; ti < 4; ti++)
        if (ti >= (ks >> 1)) wf[ti][ks] = *(const bf16x8*)(wb + (size_t)ti * 32 * 128 + ks * 16);
  }
  {
    const int tok = tid >> 2, qd = tid & 3;
    const u16* src = inter + (size_t)(R0 + tok) * IW + 1792 + qd * 64;
    uint4 xv[8];
#pragma unroll
    for (int i = 0; i < 8; i++) xv[i] = *(const uint4*)(src + i * 8);
    float s1 = 0.f, s2 = 0.f;
#pragma unroll
    for (int i = 0; i < 8; i++) {
      float f[8];
      unpack8(xv[i], f);
#pragma unroll
      for (int k = 0; k < 8; k++) { s1 += f[k]; s2 += f[k] * f[k]; }
    }
    s1 += __shfl_xor(s1, 1); s2 += __shfl_xor(s2, 1);
    s1 += __shfl_xor(s1, 2); s2 += __shfl_xor(s2, 2);
    const float mu = s1 * (1.f / 256.f);
    const float rstd = rsqrtf(fmaxf(s2 * (1.f / 256.f) - mu * mu, 0.f) + EPS);
    const int tch = tok >> 3, tlo = (tok & 7) * 2;
#pragma unroll
    for (int i = 0; i < 8; i++) {
      float f[8];
      unpack8(xv[i], f);
#pragma unroll
      for (int k = 0; k < 8; k++) {
        const int c = qd * 64 + i * 8 + k;
        *(u16*)(smem + c * 256 + ((tch ^ (c & 15)) << 4) + tlo) = f2bf((f[k] - mu) * rstd);
      }
    }
  }
  __syncthreads();
  {
    const int h = w >> 1;
    const int cbase = h * 64 + (w & 1) * 32;
    const int c = cbase + l32;
    f32x16 acc[4];
#pragma unroll
    for (int ti = 0; ti < 4; ti++)
#pragma unroll
      for (int r = 0; r < 16; r++) acc[ti][r] = 0.f;
#pragma unroll
    for (int ks = 0; ks < 8; ks++) {
      bf16x8 vfrag = *(const bf16x8*)(smem + c * 256 + (((ks * 2 + lh) ^ (c & 15)) << 4));
#pragma unroll
      for (int ti = 0; ti < 4; ti++) {
        if (ti >= (ks >> 1)) acc[ti] = __builtin_amdgcn_mfma_f32_32x32x16_bf16(vfrag, wf[ti][ks], acc[ti], 0, 0, 0);
      }
    }
    float4 gl[4], bl[4];
#pragma unroll
    for (int g = 0; g < 4; g++) {
      gl[g] = *(const float4*)(p.c_ln_g + l * 256 + cbase + 8 * g + 4 * lh);
      bl[g] = *(const float4*)(p.c_ln_b + l * 256 + cbase + 8 * g + 4 * lh);
    }
#pragma unroll
    for (int ti = 0; ti < 4; ti++) {
      const int t = ti * 32 + l32;
      const size_t row = (size_t)R0 + t;
      const float rsw = p.rsw[(l * 4 + h) * 128 + t];
      const float bs = p.c_bs[(l * 4 + h) * 128 + t];
#pragma unroll
      for (int g = 0; g < 4; g++) {
        const int d0 = cbase + 8 * g + 4 * lh;
        uint2 gc = *(const uint2*)(inter + row * IW + 1536 + d0);
        float y0 = __uint_as_float(gc.x << 16) * (gl[g].x * acc[ti][4 * g + 0] + bl[g].x * rsw + bs);
        float y1 = __uint_as_float(gc.x & 0xffff0000u) * (gl[g].y * acc[ti][4 * g + 1] + bl[g].y * rsw + bs);
        float y2 = __uint_as_float(gc.y << 16) * (gl[g].z * acc[ti][4 * g + 2] + bl[g].z * rsw + bs);
        float y3 = __uint_as_float(gc.y & 0xffff0000u) * (gl[g].w * acc[ti][4 * g + 3] + bl[g].w * rsw + bs);
        *(uint2*)(p.mix + row * DM + 768 + d0) = make_uint2(pack2(y0, y1), pack2(y2, y3));
      }
    }
  }
  __syncthreads();
}

__device__ void p2_s(const Params& p, int l, int n, float* red, float* smem_f) {
  const int tid = otid();
  const int lane = tid & 63, w = tid >> 6;
  const int c = tid;
  const size_t Rs = NPR + (size_t)n * 4;
  const u16* __restrict__ inter = p.inter;
  float rv[16];
#pragma unroll
  for (int i = 0; i < 16; i++) rv[i] = 0.f;
  float o[4] = {0.f, 0.f, 0.f, 0.f};
  float zin[6] = {0.f, 0.f, 0.f, 0.f, 0.f, 0.f};
  float cvv[4] = {0.f, 0.f, 0.f, 0.f};
  if (c < 384) {
    float in[34], wv[31];
    const float* sa = p.state_a + ((size_t)(l * 128 + n) * 30) * 384 + c;
    float* so = p.out + O_SAS + ((size_t)(l * 128 + n) * 30) * 384 + c;
#pragma unroll
    for (int i = 0; i < 30; i++) in[i] = sa[i * 384];
#pragma unroll
    for (int t = 0; t < 4; t++) in[30 + t] = bf2f(inter[(Rs + t) * IW + c]);
#pragma unroll
    for (int j = 0; j < 31; j++) wv[j] = p.a_conv_w[(l * 31 + j) * 384 + c];
    const float bias = p.a_conv_b[l * 384 + c];
#pragma unroll
    for (int i = 0; i < 30; i++) so[i * 384] = in[4 + i];
#pragma unroll
    for (int t = 0; t < 4; t++) o[t] = bias;
#pragma unroll
    for (int j = 0; j < 31; j++) {
#pragma unroll
      for (int t = 0; t < 4; t++) o[t] += wv[j] * in[t + j];
    }
#pragma unroll
    for (int t = 0; t < 4; t++) { rv[t] = o[t]; rv[4 + t] = o[t] * o[t]; }
    const float* sb = p.state_b + ((size_t)(l * 128 + n) * 2) * 384 + c;
    zin[0] = sb[0]; zin[1] = sb[384];
#pragma unroll
    for (int t = 0; t < 4; t++) zin[2 + t] = bf2f(inter[(Rs + t) * IW + 768 + c]);
  }
  if (c < 256) {
#pragma unroll
    for (int t = 0; t < 4; t++) {
      cvv[t] = bf2f(inter[(Rs + t) * IW + 1792 + c]);
      rv[8 + t] = cvv[t];
      rv[12 + t] = cvv[t] * cvv[t];
    }
  }
#pragma unroll
  for (int i = 0; i < 16; i++) {
#pragma unroll
    for (int m = 32; m >= 1; m >>= 1) rv[i] += __shfl_xor(rv[i], m);
  }
  if (lane == 0) {
#pragma unroll
    for (int i = 0; i < 16; i++) red[w * 16 + i] = rv[i];
  }
  __syncthreads();
#pragma unroll
  for (int i = 0; i < 16; i++) {
    float s = 0.f;
#pragma unroll
    for (int ww = 0; ww < 8; ww++) s += red[ww * 16 + i];
    rv[i] = s;
  }
  if (c < 384) {
    const float g = p.a_ln_g[l * 384 + c], bb = p.a_ln_b[l * 384 + c];
    const float w0 = p.b_conv_w[(l * 3 + 0) * 384 + c], w1 = p.b_conv_w[(l * 3 + 1) * 384 + c], w2 = p.b_conv_w[(l * 3 + 2) * 384 + c];
#pragma unroll
    for (int t = 0; t < 4; t++) {
      float m_ = rv[t] * (1.f / 384.f);
      float var = rv[4 + t] * (1.f / 384.f) - m_ * m_;
      float rstd = rsqrtf(fmaxf(var, 0.f) + EPS);
      float y = (o[t] - m_) * rstd * g + bb;
      float ya = siluf_(y) * bf2f(inter[(Rs + t) * IW + 384 + c]);
      p.mix[(Rs + t) * DM + c] = f2bf(ya);
      float cv = w0 * zin[t] + w1 * zin[t + 1] + w2 * zin[t + 2];
      float yb = bf2f(inter[(Rs + t) * IW + 1152 + c]) * cv;
      p.mix[(Rs + t) * DM + 384 + c] = f2bf(yb);
    }
    p.out[O_SBS + ((size_t)(l * 128 + n) * 2 + 0) * 384 + c] = zin[4];
    p.out[O_SBS + ((size_t)(l * 128 + n) * 2 + 1) * 384 + c] = zin[5];
  }
  if (c < 256) {
    const float g = p.c_ln_g[l * 256 + c], bb = p.c_ln_b[l * 256 + c];
    const int h = c >> 6;
    float vn[4];
#pragma unroll
    for (int t = 0; t < 4; t++) {
      float m_ = rv[8 + t] * (1.f / 256.f);
      float var = rv[12 + t] * (1.f / 256.f) - m_ * m_;
      float rstd = rsqrtf(fmaxf(var, 0.f) + EPS);
      vn[t] = (cvv[t] - m_) * rstd * g + bb;
      p.out[O_SCV + ((size_t)(l * 128 + n) * 4 + t) * 256 + c] = vn[t];
    }
#pragma unroll
    for (int t = 0; t < 4; t++) {
      float acc = p.c_bs[(l * 4 + h) * 128 + t];
#pragma unroll
      for (int s = 0; s < 4; s++)
        if (s <= t) acc += p.c_ws[((size_t)(l * 4 + h) * 128 + t) * 128 + s] * vn[s];
      float yc = bf2f(inter[(Rs + t) * IW + 1536 + c]) * acc;
      p.mix[(Rs + t) * DM + 768 + c] = f2bf(yc);
    }
  }
  __syncthreads();
}

__device__ void phase2(const Params& p, int l, char* smem) {
  float* red = (float*)(smem + 90112);
  const int nb = gridDim.x, b = blockIdx.x;
  p2_stage_w(p, l, smem);
  {
    ATileRegs A;
    if (b < 512) p2_ab_load(p, b, A);
#pragma unroll 1
    for (int it = b; it < 512; it += nb) {
      p2_ab_store(A, smem);
      __syncthreads();
      const int nx = (it + nb < 512) ? it + nb : it;
      p2_ab_load(p, nx, A);
      p2_ab(p, l, it, smem);
    }
  }
  for (int it = b; it < 128; it += nb) {
    asm volatile("" ::: "memory");
    p2_c(p, l, it, smem);
  }
  for (int it = (b + nb - (128 % nb)) % nb; it < 128; it += nb) {
    asm volatile("" ::: "memory");
    p2_s(p, l, it, red, (float*)smem);
  }
}

__device__ void phase4(const Params& p) {
  const int tid = otid();
  const float* ssq = p.sumsq + (size_t)2 * NTOK;
  for (int idx = blockIdx.x * NT + tid; idx < NTOK * 128; idx += gridDim.x * NT) {
    const int row = idx >> 7, c8 = idx & 127;
    uint4 v = *(const uint4*)(p.xb + (size_t)row * DM + c8 * 8);
    const float rs = rsqrtf(ssq[row] * (1.f / 1024.f) + EPS);
    float4 g0 = *(const float4*)(p.final_g + c8 * 8), g1 = *(const float4*)(p.final_g + c8 * 8 + 4);
    float f[8];
    unpack8(v, f);
    float* o = p.out + (size_t)row * DM + c8 * 8;
    *(float4*)o = make_float4(f[0] * rs * g0.x, f[1] * rs * g0.y, f[2] * rs * g0.z, f[3] * rs * g0.w);
    *(float4*)(o + 4) = make_float4(f[4] * rs * g1.x, f[5] * rs * g1.y, f[6] * rs * g1.z, f[7] * rs * g1.w);
  }
}

#define CEN_WORD(j) (XCD_BAR_WORDS + 64 * (j))
#define BAR_TOTAL_WORDS (XCD_BAR_WORDS + 64 * 16)
__global__ void __launch_bounds__(NT) fwd_megakernel(Params p) {
  extern __shared__ __attribute__((aligned(16))) char smem[];
  __shared__ uint4 xb_words;
  __shared__ uint4 sched_words;
  if (threadIdx.x == 0) {
    xb_words = make_uint4(0u, 0u, 0u, 0u);
    const unsigned x = xb_xcc_id();
    const unsigned slot = xb_add(&p.bar[CEN_WORD(x)], 1u);
    sched_words = make_uint4(slot, 1u, 0u, gridDim.x);
  }
  __syncthreads();
  XcdBarrier gb = xcd_barrier_post(p.bar, (volatile LAS unsigned*)&xb_words);
  const volatile LAS unsigned* sched = (const volatile LAS unsigned*)&sched_words;
  phase0(p, smem);
  xcd_barrier(gb);
  if (threadIdx.x == 0) {
    const unsigned x = xb_xcc_id();
    unsigned prefix = 0u, mine = 1u;
#pragma unroll
    for (unsigned j = 0; j < 16; ++j) {
      const unsigned c = xb_ld(&p.bar[CEN_WORD(j)]);
      prefix += (j < x) ? c : 0u;
      mine = (j == x) ? c : mine;
    }
    volatile LAS unsigned* sw = (volatile LAS unsigned*)&sched_words;
    sw[1] = mine;
    sw[2] = prefix;
  }
  __syncthreads();
#pragma unroll 1
  for (int l = 0; l < 2; l++) {
    phase1(p, l, smem);
    xcd_barrier(gb);
    phase2(p, l, smem);
    xcd_barrier(gb);
    phase3(p, l, smem);
    xcd_barrier(gb);
  }
  phase4(p);
}

extern "C" void kernel_launch(void* const* d_in, const int* in_sizes, int n_in, void* d_out, int out_size, void* d_ws,
                              size_t ws_size, hipStream_t stream) {
  static int grid_blocks = 0;
  if (!grid_blocks) {
    int dev = 0, cus = 0, per_cu = 0;
    hipGetDevice(&dev);
    hipDeviceGetAttribute(&cus, hipDeviceAttributeMultiprocessorCount, dev);
    hipFuncSetAttribute((const void*)fwd_megakernel, hipFuncAttributeMaxDynamicSharedMemorySize, LDS_BYTES);
    hipOccupancyMaxActiveBlocksPerMultiprocessor(&per_cu, (const void*)fwd_megakernel, NT, LDS_BYTES);
    if (per_cu < 1) { fprintf(stderr, "occupancy query returned %d\n", per_cu); per_cu = 1; }
    if (per_cu > 1) per_cu = 1;
    grid_blocks = cus * per_cu;
  }
  Params p{};
  p.x_prompt = (const float*)d_in[0];
  p.x_sample = (const float*)d_in[1];
  p.state_a = (const float*)d_in[2];
  p.state_b = (const float*)d_in[3];
  p.norm_g = (const float*)d_in[4];
  p.w_in = (const float*)d_in[5];
  p.a_conv_w = (const float*)d_in[6];
  p.a_conv_b = (const float*)d_in[7];
  p.a_ln_g = (const float*)d_in[8];
  p.a_ln_b = (const float*)d_in[9];
  p.b_conv_w = (const float*)d_in[10];
  p.c_ln_g = (const float*)d_in[11];
  p.c_ln_b = (const float*)d_in[12];
  p.c_ws = (const float*)d_in[13];
  p.c_bs = (const float*)d_in[14];
  p.w_out = (const float*)d_in[15];
  p.final_g = (const float*)d_in[16];
  p.out = (float*)d_out;
  char* ws = (char*)d_ws;
  size_t off = 0;
  auto take = [&](size_t bytes) { char* r = ws + off; off += (bytes + 255) & ~(size_t)255; return r; };
  p.win_b = (u16*)take((size_t)2 * 3584 * DM * 2);
  p.wout_b = (u16*)take((size_t)2 * DM * DM * 2);
  p.wc_b = (u16*)take((size_t)2 * 4 * 128 * 128 * 2);
  p.xb = (u16*)take((size_t)NTOK * DM * 2);
  p.inter = (u16*)take((size_t)NTOK * IW * 2);
  p.mix = (u16*)take((size_t)NTOK * DM * 2);
  p.sumsq = (float*)take((size_t)3 * NTOK * 4);
  p.rsw = (float*)take((size_t)2 * 4 * 128 * 4);
  p.bar = (unsigned*)take((size_t)BAR_TOTAL_WORDS * 4);
  hipMemsetAsync(p.bar, 0, (size_t)BAR_TOTAL_WORDS * 4, stream);
  void* args[] = {&p};
  hipError_t e = hipLaunchCooperativeKernel((const void*)fwd_megakernel, dim3(grid_blocks), dim3(NT), args, LDS_BYTES, stream);
  if (e != hipSuccess) fprintf(stderr, "cooperative launch failed: %s (grid %d)\n", hipGetErrorString(e), grid_blocks);
}
```

```cpp
#include <hip/hip_runtime.h>
#include <cstdio>
#include <cstdint>
#include <type_traits>

typedef unsigned short u16;
typedef short bf16x8 __attribute__((ext_vector_type(8)));
typedef float f32x16 __attribute__((ext_vector_type(16)));
typedef unsigned int u32x4 __attribute__((ext_vector_type(4)));

constexpr int NTOK = 16896, NPR = 16384, DM = 1024, INW = 3456, IW = 2048;
constexpr int NT = 512;
constexpr int INWP = 3584;
constexpr int LDS_BYTES = 131072;
constexpr float EPS = 1e-6f;

constexpr size_t O_SAP = 17301504, O_SBP = 17485824, O_SAS = 17498112, O_SBS = 20447232, O_SCV = 20643840;

struct Params {
  const float *x_prompt, *x_sample, *state_a, *state_b, *norm_g, *w_in, *a_conv_w, *a_conv_b, *a_ln_g, *a_ln_b,
      *b_conv_w, *c_ln_g, *c_ln_b, *c_ws, *c_bs, *w_out, *final_g;
  float* out;
  u16 *win_b, *wout_b, *wc_b, *xb, *inter, *mix;
  float *sumsq, *rsw;
  unsigned* bar;
};

__device__ __forceinline__ u16 f2bf(float f) {
  unsigned u = __float_as_uint(f);
  u += 0x7fffu + ((u >> 16) & 1u);
  return (u16)(u >> 16);
}
__device__ __forceinline__ float bf2f(u16 h) { return __uint_as_float(((unsigned)h) << 16); }
__device__ __forceinline__ unsigned pack2(float a, float b) {
  unsigned r;
  asm volatile("v_cvt_pk_bf16_f32 %0, %1, %2" : "=v"(r) : "v"(a), "v"(b));
  return r;
}
__device__ __forceinline__ float sigmoidf_(float x) { return __builtin_amdgcn_rcpf(1.f + __builtin_amdgcn_exp2f(-1.44269504f * x)); }
__device__ __forceinline__ float siluf_(float x) { return x * __builtin_amdgcn_rcpf(1.f + __builtin_amdgcn_exp2f(-1.44269504f * x)); }

__device__ __forceinline__ void unpack8(const uint4& v, float (&f)[8]) {
  f[0] = __uint_as_float(v.x << 16); f[1] = __uint_as_float(v.x & 0xffff0000u);
  f[2] = __uint_as_float(v.y << 16); f[3] = __uint_as_float(v.y & 0xffff0000u);
  f[4] = __uint_as_float(v.z << 16); f[5] = __uint_as_float(v.z & 0xffff0000u);
  f[6] = __uint_as_float(v.w << 16); f[7] = __uint_as_float(v.w & 0xffff0000u);
}
__device__ __forceinline__ uint4 pack8(const float (&f)[8]) {
  uint4 o;
  o.x = pack2(f[0], f[1]); o.y = pack2(f[2], f[3]); o.z = pack2(f[4], f[5]); o.w = pack2(f[6], f[7]);
  return o;
}

__device__ __forceinline__ __amdgpu_buffer_rsrc_t mk_rsrc(void* base, unsigned bytes) {
  return __builtin_amdgcn_make_buffer_rsrc(base, 0, bytes, 0x00020000);
}
__device__ __forceinline__ void st16_wt(__amdgpu_buffer_rsrc_t r, unsigned byte_off, const uint4& v) {
  u32x4 d = {v.x, v.y, v.z, v.w};
  __builtin_amdgcn_raw_buffer_store_b128(d, r, byte_off, 0, 16);
}

__device__ __forceinline__ int otid() {
  int t = threadIdx.x;
  asm volatile("" : "+v"(t));
  return t;
}

__device__ __forceinline__ int vcol_src(int vc);

#define XB_TMO      128
#define XB_XCNT(j)  (256  + 64 * (j))
#define XB_XSUB(j)  (1280 + 64 * (j))
#define XB_XGEN(j)  (2304 + 64 * (j))
#define XB_TOP      3328
#define XB_TOPGEN   3392
#define XCD_BAR_WORDS 3456
#define XB_SPIN_CAP (1u << 18)
#define LAS __attribute__((address_space(3)))

__device__ __forceinline__ unsigned xb_ld(unsigned* p)              { return __hip_atomic_load(p, __ATOMIC_RELAXED, __HIP_MEMORY_SCOPE_AGENT); }
__device__ __forceinline__ unsigned xb_add(unsigned* p, unsigned v) { return __hip_atomic_fetch_add(p, v, __ATOMIC_RELAXED, __HIP_MEMORY_SCOPE_AGENT); }
__device__ __forceinline__ unsigned xb_xcc_id() { return (unsigned)__builtin_amdgcn_s_getreg((3 << 11) | 20) & 0xFu; }
#define XB_SPIN(cond, bar) do { unsigned _sp = 0; while (cond) { __builtin_amdgcn_s_sleep(1); \
    if ((++_sp & 255u) == 0u) { if (xb_ld(&(bar)[XB_TMO])) break; if (_sp > XB_SPIN_CAP) { atomicAdd(&(bar)[XB_TMO], 1u); break; } } } } while (0)

struct XcdBarrier {
  unsigned* bar; unsigned x;
  volatile LAS unsigned* st;
};
__device__ __forceinline__ XcdBarrier xcd_barrier_post(unsigned* bar, volatile LAS unsigned* st) {
  XcdBarrier b; b.bar = bar; b.x = xb_xcc_id(); b.st = st;
  if (threadIdx.x == 0) (void)xb_add(&bar[XB_XCNT(b.x)], 1u);
  return b;
}
__device__ __forceinline__ void xcd_barrier_complete(unsigned* bar, unsigned x, unsigned& nloc, unsigned& nx) {
  const unsigned G = gridDim.x * gridDim.y * gridDim.z;
  unsigned sum, cnt, mine, sp = 0u;
  for (;;) {
    sum = 0u; cnt = 0u; mine = 0u;
#pragma unroll
    for (unsigned j = 0; j < 16; ++j) { const unsigned c = xb_ld(&bar[XB_XCNT(j)]); sum += c; cnt += (c > 0u) ? 1u : 0u; mine = (j == x) ? c : mine; }
    if (sum == G) break;
    __builtin_amdgcn_s_sleep(1);
    if ((++sp & 255u) == 0u) { if (xb_ld(&bar[XB_TMO])) break; if (sp > XB_SPIN_CAP) { atomicAdd(&bar[XB_TMO], 1u); break; } }
  }
  nloc = mine > 0u ? mine : 1u; nx = cnt > 0u ? cnt : 1u;
}
__device__ __forceinline__ void xcd_barrier(const XcdBarrier& b) {
  asm volatile("s_waitcnt vmcnt(0)" ::: "memory");
  __syncthreads();
  if (threadIdx.x == 0) {
    unsigned* bar = b.bar;
    __builtin_amdgcn_s_waitcnt(0);
    unsigned nloc = b.st[0], nx = b.st[1];
    if (nloc == 0u) { xcd_barrier_complete(bar, b.x, nloc, nx); b.st[0] = nloc; b.st[1] = nx; }
    const unsigned old = xb_add(&bar[XB_XSUB(b.x)], 1u);
    const unsigned gen = old / nloc;
    if (old + 1u == (gen + 1u) * nloc) {
      __builtin_amdgcn_fence(__ATOMIC_RELEASE, "agent");
      asm volatile("s_waitcnt vmcnt(0)" ::: "memory");
      const unsigned og = xb_add(&bar[XB_TOP], 1u);
      const unsigned tg = og / nx;
      if (og + 1u == (tg + 1u) * nx) xb_add(&bar[XB_TOPGEN], 1u);
      else XB_SPIN(xb_ld(&bar[XB_TOPGEN]) == tg, bar);
      __builtin_amdgcn_fence(__ATOMIC_ACQUIRE, "agent");
      xb_add(&bar[XB_XGEN(b.x)], 1u);
      asm volatile("s_waitcnt vmcnt(0)" ::: "memory");
    } else {
      XB_SPIN(xb_ld(&bar[XB_XGEN(b.x)]) == gen, bar);
      __builtin_amdgcn_fence(__ATOMIC_ACQUIRE, "agent");
      asm volatile("s_waitcnt vmcnt(0)" ::: "memory");
    }
  }
  __syncthreads();
}

__device__ void p0_transpose(const float* __restrict__ W, int ncols, const float* __restrict__ g, u16* __restrict__ outp,
                             int k0, int v0, bool mapv, float* tile) {
  int tid = otid();
  float vals[16];
#pragma unroll
  for (int i = 0; i < 16; i++) {
    int e = tid + i * NT;
    int kk = e >> 7, v = e & 127;
    int src = mapv ? vcol_src(v0 + v) : (v0 + v);
    float val = 0.f;
    if (src >= 0) val = __builtin_nontemporal_load(W + (size_t)(k0 + kk) * ncols + src);
    vals[i] = val;
  }
#pragma unroll
  for (int i = 0; i < 16; i++) {
    int e = tid + i * NT;
    int kk = e >> 7, v = e & 127;
    float val = vals[i];
    if (g) val *= g[k0 + kk];
    tile[kk * 129 + v] = val;
  }
  __syncthreads();
#pragma unroll
  for (int h = 0; h < 2; h++) {
    int v = (tid >> 3) + h * 64, kq = tid & 7;
    const float* tp = tile + (kq * 8) * 129 + v;
    uint4 o;
    o.x = pack2(tp[0], tp[129]);
    o.y = pack2(tp[2 * 129], tp[3 * 129]);
    o.z = pack2(tp[4 * 129], tp[5 * 129]);
    o.w = pack2(tp[6 * 129], tp[7 * 129]);
    *(uint4*)(outp + (size_t)(v0 + v) * 1024 + k0 + kq * 8) = o;
  }
  __syncthreads();
}

__device__ void p0_weights(const Params& p, int l, int rank, int nranks, float* tile) {
  for (int it = rank; it < 16 * 28; it += nranks) {
    int kb = it / 28, vb = it % 28;
    p0_transpose(p.w_in + (size_t)l * DM * INW, INW, p.norm_g + l * DM, p.win_b + (size_t)l * INWP * DM, kb * 64, vb * 128, true, tile);
  }
  for (int it = rank; it < 16 * 8; it += nranks) {
    int kb = it >> 3, vb = it & 7;
    p0_transpose(p.w_out + (size_t)l * DM * DM, DM, nullptr, p.wout_b + (size_t)l * DM * DM, kb * 64, vb * 128, false, tile);
  }
}

__device__ void phase0(const Params& p, char* smem) {
  float* tile = (float*)smem;
  int nb = gridDim.x, b = blockIdx.x, tid = otid();
  const int wave = tid >> 6, lane = tid & 63;
  for (int e = b * NT + tid; e < 2 * NTOK; e += nb * NT) p.sumsq[NTOK + e] = 0.f;
  for (int e = b * NT + tid; e < 2 * 4 * 128 * 128; e += nb * NT) {
    int s = e & 127, t = (e >> 7) & 127;
    p.wc_b[e] = (s <= t) ? f2bf(p.c_ws[e]) : (u16)0;
  }
  for (int r = b * 8 + wave; r < 2 * 4 * 128; r += nb * 8) {
    const int t = r & 127;
    const float* wr = p.c_ws + (size_t)r * 128;
    float s = 0.f;
    if (lane <= t) s += bf2f(f2bf(wr[lane]));
    if (lane + 64 <= t) s += bf2f(f2bf(wr[lane + 64]));
#pragma unroll
    for (int m = 32; m >= 1; m >>= 1) s += __shfl_xor(s, m);
    if (lane == 0) p.rsw[r] = s;
  }
  for (int row = (b * 8 + wave) * 2; row < NTOK; row += nb * 16) {
    const float* xr0 = (row < NPR) ? (p.x_prompt + (size_t)row * DM) : (p.x_sample + (size_t)(row - NPR) * DM);
    const float* xr1 = xr0 + DM;
    float4 v0[4], v1[4];
#pragma unroll
    for (int j = 0; j < 4; j++) {
      typedef float f4v __attribute__((ext_vector_type(4)));
      f4v a = __builtin_nontemporal_load((const f4v*)(xr0 + (j * 64 + lane) * 4));
      f4v c = __builtin_nontemporal_load((const f4v*)(xr1 + (j * 64 + lane) * 4));
      v0[j] = make_float4(a.x, a.y, a.z, a.w);
      v1[j] = make_float4(c.x, c.y, c.z, c.w);
    }
    float s0 = 0.f, s1 = 0.f;
#pragma unroll
    for (int j = 0; j < 4; j++) {
      s0 += v0[j].x * v0[j].x + v0[j].y * v0[j].y + v0[j].z * v0[j].z + v0[j].w * v0[j].w;
      s1 += v1[j].x * v1[j].x + v1[j].y * v1[j].y + v1[j].z * v1[j].z + v1[j].w * v1[j].w;
      *(uint2*)(p.xb + (size_t)row * DM + (j * 64 + lane) * 4) = make_uint2(pack2(v0[j].x, v0[j].y), pack2(v0[j].z, v0[j].w));
      *(uint2*)(p.xb + (size_t)(row + 1) * DM + (j * 64 + lane) * 4) = make_uint2(pack2(v1[j].x, v1[j].y), pack2(v1[j].z, v1[j].w));
    }
#pragma unroll
    for (int m = 32; m >= 1; m >>= 1) { s0 += __shfl_xor(s0, m); s1 += __shfl_xor(s1, m); }
    if (lane == 0) { p.sumsq[row] = s0; p.sumsq[row + 1] = s1; }
  }
  p0_weights(p, 0, b, nb, tile);
}

namespace pg8 {
#define PG8_LAS __attribute__((address_space(3)))
typedef unsigned short bf16_t;
typedef short bf16x8 __attribute__((ext_vector_type(8)));
typedef float f32x4 __attribute__((ext_vector_type(4)));
typedef unsigned u32x4 __attribute__((ext_vector_type(4)));
constexpr int BM = 256, BK = 64, HALF = 128, HTB = HALF * BK * 2  , STAGE_BYTES = 8 * HTB, NXCD = 8, WGM = 8;

__host__ __device__ __forceinline__ int lds_byte(int r, int c) { const int st = (r >> 4) * 2 + (c >> 5), rr = r & 15, cc = c & 31, ob = rr * 64 + cc * 2; return st * 1024 + (ob ^ (((ob >> 9) & 1) << 5)); }
__host__ __device__ __forceinline__ void stage_rc(int b, int& R, int& C) { const int st = b / 1024, sb = b % 1024, swz = sb ^ (((sb >> 9) & 1) << 5); R = (st >> 1) * 16 + swz / 64; C = (st & 1) * 32 + (swz % 64) / 2; }
__host__ __device__ __forceinline__ int perm32(int rho) { const int n = rho >> 4, i = rho & 15; return 8 * (i >> 2) + 4 * n + (i & 3); }

struct Unit { int pm, pn; };
struct Gemm { const bf16_t* A; const bf16_t* Bt; int M, N, K; };

struct StaticOrder {
    int nM, nN, nwg, G, c;
    __host__ __device__ void init(int M, int N, int G_, int c_) { nM = M / BM; nN = N / BM; nwg = nM * nN; G = G_; c = c_; }
    __host__ __device__ bool next(int i, Unit& u) const {
        const long L = (long)i * G + c; if (L >= nwg) return false;
        int wgid = (int)L; { const int q = nwg / NXCD, r = nwg % NXCD, xcd = wgid % NXCD, off = wgid / NXCD; wgid = (xcd < r ? xcd * (q + 1) : r * (q + 1) + (xcd - r) * q) + off; }
        const int nig = WGM * nN, gid = wgid / nig, fm = gid * WGM, gsz = (nM - fm) < WGM ? (nM - fm) : WGM;
        u.pm = fm + ((wgid % nig) % gsz); u.pn = (wgid % nig) / gsz; return true;
    }
    __device__ __forceinline__ void a_ready(const Unit&) const {}
    __device__ __forceinline__ void done(const Unit&) const {}
};
__device__ __forceinline__ unsigned cvt_pk_bf16(float lo, float hi) { unsigned r; asm volatile("v_cvt_pk_bf16_f32 %0, %1, %2" : "=v"(r) : "v"(lo), "v"(hi)); return r; }
template <class Epi, class Sched, bool STAMP = false>
__device__ __forceinline__ void gemm_phase(PG8_LAS unsigned char* lds, const Gemm g, const Sched& S, const Epi& E, unsigned long long* stamps) {
    const int tid = otid(), wid = __builtin_amdgcn_readfirstlane(tid >> 6), lane = tid & 63, wr = wid >> 2, wc = wid & 3, fr = lane & 15, fq = lane >> 4;
    const int K = g.K, nt = K / BK;
    int ts_lo = 0, ts_hi = 0, nts = 0; const unsigned long long rt_entry = STAMP ? (unsigned long long)wall_clock64() : 0ull;
#define PG8_STAMP() do { if (STAMP && wid == 0 && nts < 64) { const unsigned long long _c = (unsigned long long)clock64(); \
        ts_lo = (lane == nts) ? (int)(unsigned)_c : ts_lo; ts_hi = (lane == nts) ? (int)(unsigned)(_c >> 32) : ts_hi; ++nts; } } while (0)
    PG8_STAMP();
    unsigned voffA[2], voffB[2];
#pragma unroll
    for (int i = 0; i < 2; ++i) { int R, C; stage_rc(tid * 16 + i * 8192, R, C); const int Rb = Epi::PERM ? ((R & ~31) + perm32(R & 31)) : R;
        voffA[i] = (unsigned)(R * K + C) * 2u; voffB[i] = (unsigned)(Rb * K + C) * 2u; }
    const size_t kstep = (size_t)(BK * 2);
    const size_t hstep = (size_t)HALF * K * 2;
    const size_t tstep = 2 * hstep;
    const unsigned ldsw = (unsigned)wid * 1024u;
    const int aoff = lds_byte(wr * 64 + fr, fq * 8), boff = lds_byte(wc * 32 + fr, fq * 8);
#define PG8_SA(b, h) (((b) * 2 + (h)) * HTB)
#define PG8_SB(b, h) ((4 + (b) * 2 + (h)) * HTB)
#define PG8_STAGE(bufoff, gbase, voff) do { _Pragma("unroll") for (int _i = 0; _i < 2; ++_i) \
        __builtin_amdgcn_global_load_lds((const unsigned*)((const char*)(gbase) + (voff)[_i]), (PG8_LAS unsigned*)(lds + (bufoff) + ldsw + _i * 8192), 16, 0, 0); } while (0)
#define PG8_LDA(dst, b, h) do { _Pragma("unroll") for (int m = 0; m < 4; ++m) _Pragma("unroll") for (int k = 0; k < 2; ++k) dst[m][k] = *(const PG8_LAS bf16x8*)(lds + PG8_SA(b, h) + aoff + m * 2048 + k * 1024); } while (0)
#define PG8_LDB(dst, b, h) do { _Pragma("unroll") for (int n = 0; n < 2; ++n) _Pragma("unroll") for (int k = 0; k < 2; ++k) dst[n][k] = *(const PG8_LAS bf16x8*)(lds + PG8_SB(b, h) + boff + n * 2048 + k * 1024); } while (0)
#define PG8_MMA(ai, bj, At, Bt) do { __builtin_amdgcn_s_setprio(1); _Pragma("unroll") for (int m = 0; m < 4; ++m) _Pragma("unroll") for (int n = 0; n < 2; ++n) _Pragma("unroll") for (int k = 0; k < 2; ++k) \
        acc[ai][bj][m][n] = __builtin_amdgcn_mfma_f32_16x16x32_bf16(Bt[n][k], At[m][k], acc[ai][bj][m][n], 0, 0, 0); __builtin_amdgcn_s_setprio(0); } while (0)
#define PG8_WAIT_V(n) asm volatile("s_waitcnt vmcnt(" #n ")" ::: "memory")
#define PG8_WAIT_L(n) asm volatile("s_waitcnt lgkmcnt(" #n ")" ::: "memory")
#define PG8_BAR __builtin_amdgcn_s_barrier()
#define PG8_SCHED __builtin_amdgcn_sched_barrier(0)
    Unit cur, nxt; int ui = 0;
    if (!S.next(0, cur)) return;
    f32x4 acc[2][2][4][2];
#pragma unroll
    for (int a = 0; a < 2; ++a)
#pragma unroll
        for (int b = 0; b < 2; ++b)
#pragma unroll
            for (int m = 0; m < 4; ++m)
#pragma unroll
                for (int n = 0; n < 2; ++n) acc[a][b][m][n] = (f32x4){0.f, 0.f, 0.f, 0.f};
    bf16x8 At[4][2], B0[2][2], B1[2][2];
    const char* cA = (const char*)g.A + (size_t)cur.pm * tstep; const char* cB = (const char*)g.Bt + (size_t)cur.pn * tstep;
    typename Epi::Pre pre;
    E.preload(cur, wr, fr, pre);
    S.a_ready(cur);
    PG8_STAGE(PG8_SB(0, 0), cB, voffB); PG8_STAGE(PG8_SA(0, 0), cA, voffA); PG8_STAGE(PG8_SB(0, 1), cB + hstep, voffB); PG8_STAGE(PG8_SA(0, 1), cA + hstep, voffA);
    if (wr == 1) PG8_BAR;
    PG8_WAIT_V(4); PG8_BAR;
    PG8_STAGE(PG8_SB(1, 0), cB + kstep, voffB); PG8_STAGE(PG8_SA(1, 0), cA + kstep, voffA); PG8_STAGE(PG8_SB(1, 1), cB + hstep + kstep, voffB);
    PG8_WAIT_V(6); PG8_BAR;
    PG8_STAMP();
    for (;;) {
        const bool has_next = S.next(ui + 1, nxt);
        const char* nA = has_next ? (const char*)g.A + (size_t)nxt.pm * tstep : cA; const char* nB = has_next ? (const char*)g.Bt + (size_t)nxt.pn * tstep : cB;
        for (int t = 0; t < nt; t += 2) {
            const bool last = (t == nt - 2);
            const char* a1 = cA + (size_t)(t + 1) * kstep;
            const char* a2 = last ? nA : cA + (size_t)(t + 2) * kstep; const char* b2 = last ? nB : cB + (size_t)(t + 2) * kstep;
            const char* a3 = a2 + kstep; const char* b3 = b2 + kstep;
            if (last && has_next) S.a_ready(nxt);
            PG8_LDB(B0, 0, 0); PG8_SCHED; PG8_LDA(At, 0, 0); PG8_STAGE(PG8_SA(1, 1), a1 + hstep, voffA);
            PG8_WAIT_L(8); PG8_BAR; PG8_WAIT_L(0); PG8_MMA(0, 0, At, B0); PG8_BAR; PG8_SCHED;
            PG8_LDB(B1, 0, 1); PG8_STAGE(PG8_SB(0, 0), b2, voffB);
            PG8_BAR; PG8_WAIT_L(0); PG8_MMA(0, 1, At, B1); PG8_BAR;
            PG8_LDA(At, 0, 1); PG8_STAGE(PG8_SA(0, 0), a2, voffA);
            PG8_BAR; PG8_WAIT_L(0); PG8_MMA(1, 0, At, B0); PG8_BAR; PG8_SCHED;
            PG8_STAGE(PG8_SB(0, 1), b2 + hstep, voffB);
            PG8_WAIT_V(6); PG8_BAR; PG8_MMA(1, 1, At, B1); PG8_BAR;
            PG8_LDB(B0, 1, 0); PG8_SCHED; PG8_LDA(At, 1, 0); PG8_STAGE(PG8_SA(0, 1), a2 + hstep, voffA);
            PG8_WAIT_L(8); PG8_BAR; PG8_WAIT_L(0); PG8_MMA(0, 0, At, B0); PG8_BAR; PG8_SCHED;
            PG8_LDB(B1, 1, 1); PG8_STAGE(PG8_SB(1, 0), b3, voffB);
            PG8_BAR; PG8_WAIT_L(0); PG8_MMA(0, 1, At, B1); PG8_BAR;
            PG8_LDA(At, 1, 1); PG8_STAGE(PG8_SA(1, 0), a3, voffA);
            PG8_BAR; PG8_WAIT_L(0); PG8_MMA(1, 0, At, B0); PG8_BAR; PG8_SCHED;
            PG8_STAGE(PG8_SB(1, 1), b3 + hstep, voffB);
            PG8_WAIT_V(6); PG8_BAR; PG8_MMA(1, 1, At, B1); PG8_BAR;
        }
        PG8_STAMP();
        if constexpr (!Epi::AFTER_DRAIN) { E(acc, cur, wr, wc, fr, fq, pre); S.done(cur); }
        PG8_STAMP();
        if (!has_next) break;
#pragma unroll
        for (int a = 0; a < 2; ++a)
#pragma unroll
            for (int b = 0; b < 2; ++b)
#pragma unroll
                for (int m = 0; m < 4; ++m)
#pragma unroll
                    for (int n = 0; n < 2; ++n) acc[a][b][m][n] = (f32x4){0.f, 0.f, 0.f, 0.f};
        cur = nxt; cA = nA; cB = nB; ++ui;
        E.preload(cur, wr, fr, pre);
    }
    PG8_WAIT_V(0);
    if (wr == 0) PG8_BAR;
    PG8_BAR;
    if constexpr (Epi::AFTER_DRAIN) { E.fused(acc, cur, wr, wc, fr, fq, lds, wid, lane); S.done(cur); }
    PG8_STAMP();
    if (STAMP && wid == 0) { stamps[lane] = lane < nts ? (((unsigned long long)(unsigned)ts_hi << 32) | (unsigned)ts_lo) : 0ull;
        if (lane == 62) stamps[62] = rt_entry; if (lane == 63) stamps[63] = (unsigned long long)wall_clock64(); }
#undef PG8_STAMP
#undef PG8_SA
#undef PG8_SB
#undef PG8_STAGE
#undef PG8_LDA
#undef PG8_LDB
#undef PG8_MMA
#undef PG8_WAIT_V
#undef PG8_WAIT_L
#undef PG8_BAR
#undef PG8_SCHED
}
}


__device__ __forceinline__ int vcol_src(int vc) {
  const int un = vc >> 8, h = (vc >> 7) & 1, i = vc & 127;
  if (un < 3) return (h ? 384 : 0) + 128 * un + i;
  if (un < 6) return (h ? 1920 : 1152) + 128 * (un - 3) + i;
  if (un < 9) return (h ? 2304 : 1536) + 128 * (un - 6) + i;
  if (un < 11) return (h ? 3200 : 2688) + 128 * (un - 9) + i;
  if (un == 11) return 768 + 128 * h + i;
  if (un == 12) return h ? (2944 + i) : (768 + 256 + i);
  return h ? -1 : (2944 + 128 + i);
}

typedef float f32x4_ __attribute__((ext_vector_type(4)));
struct Epi1 {
  static constexpr bool PERM = true, AFTER_DRAIN = false;
  u16* inter; const float* ssq;
  struct Pre { float s[8]; };
  __device__ __forceinline__ void preload(const pg8::Unit& u, int wr, int fr, Pre& P) const {
#pragma unroll
    for (int ai = 0; ai < 2; ++ai)
#pragma unroll
      for (int m = 0; m < 4; ++m) P.s[ai * 4 + m] = ssq[u.pm * 256 + 64 * wr + fr + 128 * ai + 16 * m];
  }
  __device__ __forceinline__ void operator()(const pg8::f32x4 (&acc)[2][2][4][2], const pg8::Unit& u, int wr, int wc, int fr, int fq, const Pre& P) const {
    const int un = u.pn;
    int k0, ob0, k1 = -1, ob1 = 0;
    if (un < 3) { k0 = 0; ob0 = 128 * un; }
    else if (un < 6) { k0 = 2; ob0 = 768 + 128 * (un - 3); }
    else if (un < 9) { k0 = 3; ob0 = 1152 + 128 * (un - 6); }
    else if (un < 11) { k0 = 3; ob0 = 1536 + 128 * (un - 9); }
    else if (un == 11) { k0 = 1; ob0 = 384; k1 = 1; ob1 = 384 + 128; }
    else if (un == 12) { k0 = 1; ob0 = 384 + 256; k1 = 4; ob1 = 1792; }
    else { k0 = 4; ob0 = 1792 + 128; k1 = -2; }
    const int cl = 32 * wc + 8 * fq;
    const int rbase = u.pm * 256 + 64 * wr + fr;
    const __amdgpu_buffer_rsrc_t irs = mk_rsrc(inter, (unsigned)NTOK * IW * 2u);
    auto body = [&](auto K0c, auto K1c) {
      constexpr int K0 = decltype(K0c)::value, K1 = decltype(K1c)::value;
#pragma unroll
      for (int ai = 0; ai < 2; ++ai)
#pragma unroll
        for (int m = 0; m < 4; ++m) {
          const int row = rbase + 128 * ai + 16 * m;
          const float rs = rsqrtf(P.s[ai * 4 + m] * (1.f / 1024.f) + EPS);
          float a[8], b[8], o[8];
#pragma unroll
          for (int i = 0; i < 4; i++) {
            a[i] = acc[ai][0][m][0][i] * rs; a[4 + i] = acc[ai][0][m][1][i] * rs;
            b[i] = acc[ai][1][m][0][i] * rs; b[4 + i] = acc[ai][1][m][1][i] * rs;
          }
          const unsigned rpo = ((unsigned)row * IW + cl) * 2u;
          if (K1 == -1) {
#pragma unroll
            for (int i = 0; i < 8; i++) o[i] = (K0 == 0) ? a[i] * sigmoidf_(b[i]) : (K0 == 2) ? a[i] * b[i] : a[i] * siluf_(b[i]);
            st16_wt(irs, rpo + ob0 * 2u, pack8(o));
          } else {
#pragma unroll
            for (int i = 0; i < 8; i++) o[i] = (K0 == 1) ? siluf_(a[i]) : a[i];
            st16_wt(irs, rpo + ob0 * 2u, pack8(o));
            if (K1 != -2) {
#pragma unroll
              for (int i = 0; i < 8; i++) o[i] = (K1 == 1) ? siluf_(b[i]) : b[i];
              st16_wt(irs, rpo + ob1 * 2u, pack8(o));
            }
          }
        }
    };
    using std::integral_constant;
    if (k1 == -1) {
      if (k0 == 0) body(integral_constant<int, 0>{}, integral_constant<int, -1>{});
      else if (k0 == 2) body(integral_constant<int, 2>{}, integral_constant<int, -1>{});
      else body(integral_constant<int, 3>{}, integral_constant<int, -1>{});
    } else if (k1 == 1) body(integral_constant<int, 1>{}, integral_constant<int, 1>{});
    else if (k1 == 4) body(integral_constant<int, 1>{}, integral_constant<int, 4>{});
    else body(integral_constant<int, 4>{}, integral_constant<int, -2>{});
  }
};
struct Epi2 {
  static constexpr bool PERM = true, AFTER_DRAIN = false;
  u16* xb; float* ssq;
  struct Pre {};
  __device__ __forceinline__ void preload(const pg8::Unit&, int, int, Pre&) const {}
  __device__ __forceinline__ void operator()(const pg8::f32x4 (&acc)[2][2][4][2], const pg8::Unit& u, int wr, int wc, int fr, int fq, const Pre&) const {
    const int cl = u.pn * 256 + 32 * wc + 8 * fq;
    const __amdgpu_buffer_rsrc_t xrs = mk_rsrc(xb, (unsigned)NTOK * DM * 2u);
#pragma unroll
    for (int ai = 0; ai < 2; ++ai)
#pragma unroll
      for (int m = 0; m < 4; ++m) {
        const int row = u.pm * 256 + 128 * ai + 64 * wr + 16 * m + fr;
        u16* rp = xb + (size_t)row * DM + cl;
        uint4 o0 = *(const uint4*)(rp), o1 = *(const uint4*)(rp + 128);
        float x0[8], x1[8];
        unpack8(o0, x0);
        unpack8(o1, x1);
        float ss = 0.f;
#pragma unroll
        for (int i = 0; i < 4; i++) {
          x0[i] += acc[ai][0][m][0][i]; x0[4 + i] += acc[ai][0][m][1][i];
          x1[i] += acc[ai][1][m][0][i]; x1[4 + i] += acc[ai][1][m][1][i];
        }
#pragma unroll
        for (int i = 0; i < 8; i++) ss += x0[i] * x0[i] + x1[i] * x1[i];
        const unsigned xo = ((unsigned)row * DM + cl) * 2u;
        st16_wt(xrs, xo, pack8(x0));
        st16_wt(xrs, xo + 256u, pack8(x1));
        ss += __shfl_xor(ss, 16);
        ss += __shfl_xor(ss, 32);
        if (fq == 0) atomicAdd(ssq + row, ss);
      }
  }
};

__device__ void phase1(const Params& p, int l, char* smem) {
  pg8::Gemm g{p.xb, p.win_b + (size_t)l * INWP * DM, NTOK, INWP, DM};
  pg8::StaticOrder S;
  S.init(NTOK, INWP, (int)gridDim.x, (int)blockIdx.x);
  Epi1 E{p.inter, p.sumsq + (size_t)l * NTOK};
  pg8::gemm_phase<Epi1, pg8::StaticOrder, false>((PG8_LAS unsigned char*)smem, g, S, E, nullptr);
  if (l == 0) {
    const int G = (int)gridDim.x, c = (int)blockIdx.x;
    const int rem = ((NTOK / 256) * (INWP / 256)) % G;
    const int nidle = (rem == 0) ? G : G - rem;
    const int rank = (rem == 0) ? c : c - rem;
    if (rank >= 0) p0_weights(p, 1, rank, nidle, (float*)smem);
  }
}
__device__ void phase3_sample(const Params& p, int l, char* smem) {
  const int tid = otid();
  const int lane = tid & 63, w = tid >> 6;
  const int l32 = lane & 31, lh = lane >> 5;
  float* part = (float*)smem;
  float* ssq = p.sumsq + (size_t)(l + 1) * NTOK;
  for (int T = blockIdx.x; T < 256; T += gridDim.x) {
    const int row0 = NPR + (T >> 4) * 32, col0 = (T & 15) * 64;
    const u16* ap = p.mix + (size_t)(row0 + l32) * DM + w * 128 + lh * 8;
    const u16* bp = p.wout_b + ((size_t)l * DM + col0 + l32) * DM + w * 128 + lh * 8;
    bf16x8 af[8], b0[8], b1[8];
#pragma unroll
    for (int s = 0; s < 8; s++) {
      af[s] = *(const bf16x8*)(ap + s * 16);
      b0[s] = *(const bf16x8*)(bp + s * 16);
      b1[s] = *(const bf16x8*)(bp + (size_t)32 * DM + s * 16);
    }
    f32x16 acc0, acc1;
#pragma unroll
    for (int r = 0; r < 16; r++) { acc0[r] = 0.f; acc1[r] = 0.f; }
#pragma unroll
    for (int s = 0; s < 8; s++) {
      acc0 = __builtin_amdgcn_mfma_f32_32x32x16_bf16(b0[s], af[s], acc0, 0, 0, 0);
      acc1 = __builtin_amdgcn_mfma_f32_32x32x16_bf16(b1[s], af[s], acc1, 0, 0, 0);
    }
#pragma unroll
    for (int r = 0; r < 16; r++) {
      part[((w * 2 + 0) * 16 + r) * 64 + lane] = acc0[r];
      part[((w * 2 + 1) * 16 + r) * 64 + lane] = acc1[r];
    }
    __syncthreads();
    float ss = 0.f;
    const int row = row0 + l32;
#pragma unroll
    for (int ni = 0; ni < 2; ni++) {
#pragma unroll
      for (int rr = 0; rr < 2; rr++) {
        const int r = 2 * w + rr;
        float v = 0.f;
#pragma unroll
        for (int pw = 0; pw < 8; pw++) v += part[((pw * 2 + ni) * 16 + r) * 64 + lane];
        const int col = col0 + ni * 32 + (r & 3) + 8 * (r >> 2) + 4 * lh;
        u16* xp = p.xb + (size_t)row * DM + col;
        v += bf2f(*xp);
        ss += v * v;
        *xp = f2bf(v);
      }
    }
    ss += __shfl_xor(ss, 32);
    if (lh == 0) atomicAdd(ssq + row, ss);
    __syncthreads();
  }
}

__device__ void phase3(const Params& p, int l, char* smem) {
  phase3_sample(p, l, smem);
  pg8::Gemm g{p.mix, p.wout_b + (size_t)l * DM * DM, NPR, DM, DM};
  pg8::StaticOrder S;
  S.init(NPR, DM, (int)gridDim.x, (int)blockIdx.x);
  Epi2 E{p.xb, p.sumsq + (size_t)(l + 1) * NTOK};
  pg8::gemm_phase<Epi2, pg8::StaticOrder, false>((PG8_LAS unsigned char*)smem, g, S, E, nullptr);
}

__device__ void p2_stage_w(const Params& p, int l, char* smem) {
  const int tid = otid();
  const float4* src = (const float4*)(p.a_conv_w + (size_t)l * 31 * 384);
  for (int f = tid; f < 36 * 96; f += NT) {
    int j = f / 96, q = f - j * 96;
    float4 v = make_float4(0.f, 0.f, 0.f, 0.f);
    if (j < 31) v = src[f];
    ((float4*)smem)[(j * 2 + (q & 1)) * 48 + (q >> 1)] = v;
  }
}

struct ATileRegs { u32x4 r0, r1, r2, r3, r4, r5; };
__device__ __forceinline__ void p2_ab_load(const Params& p, int it, ATileRegs& A) {
  const int tid = otid();
  const int R0 = it * 32;
  const int spos = R0 & 2047;
  const u16* __restrict__ inter = p.inter;
  auto ld = [&](int i) -> u32x4 {
    const int e = tid + i * NT;
    const int r = e / 48, ch = e - r * 48;
    u32x4 v = {0u, 0u, 0u, 0u};
    if (r < 62 && spos - 30 + r >= 0) v = *(const u32x4*)(inter + (size_t)(R0 - 30 + r) * IW + ch * 8);
    return v;
  };
  A.r0 = ld(0); A.r1 = ld(1); A.r2 = ld(2); A.r3 = ld(3); A.r4 = ld(4); A.r5 = ld(5);
}
__device__ __forceinline__ void p2_ab_store(const ATileRegs& A, char* smem) {
  const int tid = otid();
  char* atile = smem + 55296 + tid * 16;
  *(u32x4*)(atile) = A.r0;
  *(u32x4*)(atile + 1 * NT * 16) = A.r1;
  *(u32x4*)(atile + 2 * NT * 16) = A.r2;
  *(u32x4*)(atile + 3 * NT * 16) = A.r3;
  *(u32x4*)(atile + 4 * NT * 16) = A.r4;
  *(u32x4*)(atile + 5 * NT * 16) = A.r5;
}

typedef float f32x2 __attribute__((ext_vector_type(2)));
__device__ void p2_ab(const Params& p, int l, int it, char* smem) {
  const int tid = otid();
  const int lane = tid & 63, w = tid >> 6;
  const bool active = lane < 48;
  const int o = active ? lane : 47;
  const int R0 = it * 32;
  const int spos = R0 & 2047;
  const int bseq = R0 >> 11;
  const bool last = (spos == 2016);
  const u16* __restrict__ inter = p.inter;
  char* atile = smem + 55296;
  const float4* wts = (const float4*)smem;
  const size_t rowq = (size_t)R0 + 4 * w;
  const __amdgpu_buffer_rsrc_t mrs = mk_rsrc(p.mix, (unsigned)NTOK * DM * 2u);
  uint4 szv[4], gbv[4], zv[6];
#pragma unroll
  for (int t = 0; t < 4; t++) {
    szv[t] = *(const uint4*)(inter + (rowq + t) * IW + 384 + 8 * o);
    gbv[t] = *(const uint4*)(inter + (rowq + t) * IW + 1152 + 8 * o);
  }
#pragma unroll
  for (int s2 = 0; s2 < 6; s2++) {
    zv[s2] = make_uint4(0, 0, 0, 0);
    if (spos + 4 * w - 2 + s2 >= 0) zv[s2] = *(const uint4*)(inter + (rowq - 2 + s2) * IW + 768 + 8 * o);
  }
  f32x2 acc2[4][4];
  {
    float4 b0 = *(const float4*)(p.a_conv_b + l * 384 + 8 * o), b1 = *(const float4*)(p.a_conv_b + l * 384 + 8 * o + 4);
#pragma unroll
    for (int t = 0; t < 4; t++) {
      acc2[t][0] = (f32x2){b0.x, b0.y}; acc2[t][1] = (f32x2){b0.z, b0.w};
      acc2[t][2] = (f32x2){b1.x, b1.y}; acc2[t][3] = (f32x2){b1.z, b1.w};
    }
  }
  f32x2 wwin[4][4];
#pragma unroll
  for (int u = 0; u < 4; u++)
#pragma unroll
    for (int c = 0; c < 4; c++) wwin[u][c] = (f32x2){0.f, 0.f};
  const char* arow = atile + (4 * w) * 768 + o * 16;
#pragma unroll 1
  for (int s4 = 0; s4 < 36; s4 += 4) {
    const char* ar = arow + s4 * 768;
    const float4* wr = wts + (s4 * 2) * 48 + o;
#pragma unroll
    for (int u = 0; u < 4; u++) {
      uint4 av = *(const uint4*)(ar + u * 768);
      float4 wa = wr[(u * 2) * 48], wb = wr[(u * 2 + 1) * 48];
      f32x2 v[4];
      v[0] = (f32x2){__uint_as_float(av.x << 16), __uint_as_float(av.x & 0xffff0000u)};
      v[1] = (f32x2){__uint_as_float(av.y << 16), __uint_as_float(av.y & 0xffff0000u)};
      v[2] = (f32x2){__uint_as_float(av.z << 16), __uint_as_float(av.z & 0xffff0000u)};
      v[3] = (f32x2){__uint_as_float(av.w << 16), __uint_as_float(av.w & 0xffff0000u)};
      wwin[u][0] = (f32x2){wa.x, wa.y}; wwin[u][1] = (f32x2){wa.z, wa.w};
      wwin[u][2] = (f32x2){wb.x, wb.y}; wwin[u][3] = (f32x2){wb.z, wb.w};
#pragma unroll
      for (int t = 0; t < 4; t++) {
#pragma unroll
        for (int c = 0; c < 4; c++) acc2[t][c] = __builtin_elementwise_fma(wwin[(u - t) & 3][c], v[c], acc2[t][c]);
      }
    }
  }
  if (last && active) {
#pragma unroll
    for (int t = 0; t < 4; t++) {
      int pp = spos + 4 * w + t;
      if (pp >= 2018) {
        float v[8];
        unpack8(*(const uint4*)(arow + (30 + t) * 768), v);
        float* so = p.out + O_SAP + ((size_t)(l * 8 + bseq) * 30 + (pp - 2018)) * 384 + 8 * o;
        *(float4*)so = make_float4(v[0], v[1], v[2], v[3]);
        *(float4*)(so + 4) = make_float4(v[4], v[5], v[6], v[7]);
      }
    }
  }
  float acc[4][8];
#pragma unroll
  for (int t = 0; t < 4; t++)
#pragma unroll
    for (int c = 0; c < 4; c++) { acc[t][2 * c] = acc2[t][c].x; acc[t][2 * c + 1] = acc2[t][c].y; }
  float s1[4], s2[4];
#pragma unroll
  for (int t = 0; t < 4; t++) {
    float a = 0.f, b = 0.f;
#pragma unroll
    for (int c = 0; c < 8; c++) { a += acc[t][c]; b += acc[t][c] * acc[t][c]; }
    s1[t] = active ? a : 0.f;
    s2[t] = active ? b : 0.f;
  }
#pragma unroll
  for (int t = 0; t < 4; t++) {
#pragma unroll
    for (int m = 32; m >= 1; m >>= 1) { s1[t] += __shfl_xor(s1[t], m); s2[t] += __shfl_xor(s2[t], m); }
  }
  {
    float g8[8], b8[8];
    {
      float4 a0 = *(const float4*)(p.a_ln_g + l * 384 + 8 * o), a1 = *(const float4*)(p.a_ln_g + l * 384 + 8 * o + 4);
      float4 c0 = *(const float4*)(p.a_ln_b + l * 384 + 8 * o), c1 = *(const float4*)(p.a_ln_b + l * 384 + 8 * o + 4);
      g8[0] = a0.x; g8[1] = a0.y; g8[2] = a0.z; g8[3] = a0.w; g8[4] = a1.x; g8[5] = a1.y; g8[6] = a1.z; g8[7] = a1.w;
      b8[0] = c0.x; b8[1] = c0.y; b8[2] = c0.z; b8[3] = c0.w; b8[4] = c1.x; b8[5] = c1.y; b8[6] = c1.z; b8[7] = c1.w;
    }
#pragma unroll
    for (int t = 0; t < 4; t++) {
      float mu = s1[t] * (1.f / 384.f);
      float var = s2[t] * (1.f / 384.f) - mu * mu;
      float rstd = rsqrtf(fmaxf(var, 0.f) + EPS);
      float sz[8], y[8];
      unpack8(szv[t], sz);
#pragma unroll
      for (int c = 0; c < 8; c++) y[c] = siluf_((acc[t][c] - mu) * rstd * g8[c] + b8[c]) * sz[c];
      if (active) st16_wt(mrs, ((unsigned)(rowq + t) * DM + 8 * o) * 2u, pack8(y));
    }
  }
  {
    float w0[8], w1[8], w2[8];
    {
      const float* bw = p.b_conv_w + (size_t)l * 3 * 384 + 8 * o;
      float4 a0 = *(const float4*)(bw), a1 = *(const float4*)(bw + 4);
      float4 c0 = *(const float4*)(bw + 384), c1 = *(const float4*)(bw + 384 + 4);
      float4 d0 = *(const float4*)(bw + 768), d1 = *(const float4*)(bw + 768 + 4);
      w0[0] = a0.x; w0[1] = a0.y; w0[2] = a0.z; w0[3] = a0.w; w0[4] = a1.x; w0[5] = a1.y; w0[6] = a1.z; w0[7] = a1.w;
      w1[0] = c0.x; w1[1] = c0.y; w1[2] = c0.z; w1[3] = c0.w; w1[4] = c1.x; w1[5] = c1.y; w1[6] = c1.z; w1[7] = c1.w;
      w2[0] = d0.x; w2[1] = d0.y; w2[2] = d0.z; w2[3] = d0.w; w2[4] = d1.x; w2[5] = d1.y; w2[6] = d1.z; w2[7] = d1.w;
    }
    float z[6][8];
#pragma unroll
    for (int s2i = 0; s2i < 6; s2i++) unpack8(zv[s2i], z[s2i]);
#pragma unroll
    for (int t = 0; t < 4; t++) {
      float gb[8], y[8];
      unpack8(gbv[t], gb);
#pragma unroll
      for (int c = 0; c < 8; c++) y[c] = gb[c] * (w0[c] * z[t][c] + w1[c] * z[t + 1][c] + w2[c] * z[t + 2][c]);
      if (active) st16_wt(mrs, ((unsigned)(rowq + t) * DM + 384 + 8 * o) * 2u, pack8(y));
    }
    if (last && w == 7 && active) {
#pragma unroll
      for (int i = 0; i < 2; i++) {
        float* so = p.out + O_SBP + ((size_t)(l * 8 + bseq) * 2 + i) * 384 + 8 * o;
        *(float4*)so = make_float4(z[4 + i][0], z[4 + i][1], z[4 + i][2], z[4 + i][3]);
        *(float4*)(so + 4) = make_float4(z[4 + i][4], z[4 + i][5], z[4 + i][6], z[4 + i][7]);
      }
    }
  }
  __syncthreads();
}

__device__ void p2_c(const Params& p, int l, int ci, char* smem) {
  const int tid = otid();
  const int lane = tid & 63, w = tid >> 6;
  const int l32 = lane & 31, lh = lane >> 5;
  const int R0 = ci * 128;
  const u16* __restrict__ inter = p.inter;
  bf16x8 wf[4][8];
  {
    const u16* wb = p.wc_b + ((size_t)(l * 4 + (w >> 1)) * 128 + l32) * 128 + lh * 8;
#pragma unroll
    for (int ks = 0; ks < 8; ks++)
#pragma unroll
      for (int ti = 0; ti < 4; ti++)
        if (ti >= (ks >> 1)) wf[ti][ks] = *(const bf16x8*)(wb + (size_t)ti * 32 * 128 + ks * 16);
  }
  {
    const int tok = tid >> 2, qd = tid & 3;
    const u16* src = inter + (size_t)(R0 + tok) * IW + 1792 + qd * 64;
    uint4 xv[8];
#pragma unroll
    for (int i = 0; i < 8; i++) xv[i] = *(const uint4*)(src + i * 8);
    float s1 = 0.f, s2 = 0.f;
#pragma unroll
    for (int i = 0; i < 8; i++) {
      float f[8];
      unpack8(xv[i], f);
#pragma unroll
      for (int k = 0; k < 8; k++) { s1 += f[k]; s2 += f[k] * f[k]; }
    }
    s1 += __shfl_xor(s1, 1); s2 += __shfl_xor(s2, 1);
    s1 += __shfl_xor(s1, 2); s2 += __shfl_xor(s2, 2);
    const float mu = s1 * (1.f / 256.f);
    const float rstd = rsqrtf(fmaxf(s2 * (1.f / 256.f) - mu * mu, 0.f) + EPS);
    const int tch = tok >> 3, tlo = (tok & 7) * 2;
#pragma unroll
    for (int i = 0; i < 8; i++) {
      float f[8];
      unpack8(xv[i], f);
#pragma unroll
      for (int k = 0; k < 8; k++) {
        const int c = qd * 64 + i * 8 + k;
        *(u16*)(smem + c * 256 + ((tch ^ (c & 15)) << 4) + tlo) = f2bf((f[k] - mu) * rstd);
      }
    }
  }
  __syncthreads();
  {
    const int h = w >> 1;
    const int cbase = h * 64 + (w & 1) * 32;
    const int c = cbase + l32;
    f32x16 acc[4];
#pragma unroll
    for (int ti = 0; ti < 4; ti++)
#pragma unroll
      for (int r = 0; r < 16; r++) acc[ti][r] = 0.f;
#pragma unroll
    for (int ks = 0; ks < 8; ks++) {
      bf16x8 vfrag = *(const bf16x8*)(smem + c * 256 + (((ks * 2 + lh) ^ (c & 15)) << 4));
#pragma unroll
      for (int ti = 0; ti < 4; ti++) {
        if (ti >= (ks >> 1)) acc[ti] = __builtin_amdgcn_mfma_f32_32x32x16_bf16(vfrag, wf[ti][ks], acc[ti], 0, 0, 0);
      }
    }
    float4 gl[4], bl[4];
#pragma unroll
    for (int g = 0; g < 4; g++) {
      gl[g] = *(const float4*)(p.c_ln_g + l * 256 + cbase + 8 * g + 4 * lh);
      bl[g] = *(const float4*)(p.c_ln_b + l * 256 + cbase + 8 * g + 4 * lh);
    }
#pragma unroll
    for (int ti = 0; ti < 4; ti++) {
      const int t = ti * 32 + l32;
      const size_t row = (size_t)R0 + t;
      const float rsw = p.rsw[(l * 4 + h) * 128 + t];
      const float bs = p.c_bs[(l * 4 + h) * 128 + t];
#pragma unroll
      for (int g = 0; g < 4; g++) {
        const int d0 = cbase + 8 * g + 4 * lh;
        uint2 gc = *(const uint2*)(inter + row * IW + 1536 + d0);
        float y0 = __uint_as_float(gc.x << 16) * (gl[g].x * acc[ti][4 * g + 0] + bl[g].x * rsw + bs);
        float y1 = __uint_as_float(gc.x & 0xffff0000u) * (gl[g].y * acc[ti][4 * g + 1] + bl[g].y * rsw + bs);
        float y2 = __uint_as_float(gc.y << 16) * (gl[g].z * acc[ti][4 * g + 2] + bl[g].z * rsw + bs);
        float y3 = __uint_as_float(gc.y & 0xffff0000u) * (gl[g].w * acc[ti][4 * g + 3] + bl[g].w * rsw + bs);
        *(uint2*)(p.mix + row * DM + 768 + d0) = make_uint2(pack2(y0, y1), pack2(y2, y3));
      }
    }
  }
  __syncthreads();
}

__device__ void p2_s(const Params& p, int l, int n, float* red, float* smem_f) {
  const int tid = otid();
  const int lane = tid & 63, w = tid >> 6;
  const int c = tid;
  const size_t Rs = NPR + (size_t)n * 4;
  const u16* __restrict__ inter = p.inter;
  float rv[16];
#pragma unroll
  for (int i = 0; i < 16; i++) rv[i] = 0.f;
  float o[4] = {0.f, 0.f, 0.f, 0.f};
  float zin[6] = {0.f, 0.f, 0.f, 0.f, 0.f, 0.f};
  float cvv[4] = {0.f, 0.f, 0.f, 0.f};
  if (c < 384) {
    float in[34], wv[31];
    const float* sa = p.state_a + ((size_t)(l * 128 + n) * 30) * 384 + c;
    float* so = p.out + O_SAS + ((size_t)(l * 128 + n) * 30) * 384 + c;
#pragma unroll
    for (int i = 0; i < 30; i++) in[i] = sa[i * 384];
#pragma unroll
    for (int t = 0; t < 4; t++) in[30 + t] = bf2f(inter[(Rs + t) * IW + c]);
#pragma unroll
    for (int j = 0; j < 31; j++) wv[j] = p.a_conv_w[(l * 31 + j) * 384 + c];
    const float bias = p.a_conv_b[l * 384 + c];
#pragma unroll
    for (int i = 0; i < 30; i++) so[i * 384] = in[4 + i];
#pragma unroll
    for (int t = 0; t < 4; t++) o[t] = bias;
#pragma unroll
    for (int j = 0; j < 31; j++) {
#pragma unroll
      for (int t = 0; t < 4; t++) o[t] += wv[j] * in[t + j];
    }
#pragma unroll
    for (int t = 0; t < 4; t++) { rv[t] = o[t]; rv[4 + t] = o[t] * o[t]; }
    const float* sb = p.state_b + ((size_t)(l * 128 + n) * 2) * 384 + c;
    zin[0] = sb[0]; zin[1] = sb[384];
#pragma unroll
    for (int t = 0; t < 4; t++) zin[2 + t] = bf2f(inter[(Rs + t) * IW + 768 + c]);
  }
  if (c < 256) {
#pragma unroll
    for (int t = 0; t < 4; t++) {
      cvv[t] = bf2f(inter[(Rs + t) * IW + 1792 + c]);
      rv[8 + t] = cvv[t];
      rv[12 + t] = cvv[t] * cvv[t];
    }
  }
#pragma unroll
  for (int i = 0; i < 16; i++) {
#pragma unroll
    for (int m = 32; m >= 1; m >>= 1) rv[i] += __shfl_xor(rv[i], m);
  }
  if (lane == 0) {
#pragma unroll
    for (int i = 0; i < 16; i++) red[w * 16 + i] = rv[i];
  }
  __syncthreads();
#pragma unroll
  for (int i = 0; i < 16; i++) {
    float s = 0.f;
#pragma unroll
    for (int ww = 0; ww < 8; ww++) s += red[ww * 16 + i];
    rv[i] = s;
  }
  if (c < 384) {
    const float g = p.a_ln_g[l * 384 + c], bb = p.a_ln_b[l * 384 + c];
    const float w0 = p.b_conv_w[(l * 3 + 0) * 384 + c], w1 = p.b_conv_w[(l * 3 + 1) * 384 + c], w2 = p.b_conv_w[(l * 3 + 2) * 384 + c];
#pragma unroll
    for (int t = 0; t < 4; t++) {
      float m_ = rv[t] * (1.f / 384.f);
      float var = rv[4 + t] * (1.f / 384.f) - m_ * m_;
      float rstd = rsqrtf(fmaxf(var, 0.f) + EPS);
      float y = (o[t] - m_) * rstd * g + bb;
      float ya = siluf_(y) * bf2f(inter[(Rs + t) * IW + 384 + c]);
      p.mix[(Rs + t) * DM + c] = f2bf(ya);
      float cv = w0 * zin[t] + w1 * zin[t + 1] + w2 * zin[t + 2];
      float yb = bf2f(inter[(Rs + t) * IW + 1152 + c]) * cv;
      p.mix[(Rs + t) * DM + 384 + c] = f2bf(yb);
    }
    p.out[O_SBS + ((size_t)(l * 128 + n) * 2 + 0) * 384 + c] = zin[4];
    p.out[O_SBS + ((size_t)(l * 128 + n) * 2 + 1) * 384 + c] = zin[5];
  }
  if (c < 256) {
    const float g = p.c_ln_g[l * 256 + c], bb = p.c_ln_b[l * 256 + c];
    const int h = c >> 6;
    float vn[4];
#pragma unroll
    for (int t = 0; t < 4; t++) {
      float m_ = rv[8 + t] * (1.f / 256.f);
      float var = rv[12 + t] * (1.f / 256.f) - m_ * m_;
      float rstd = rsqrtf(fmaxf(var, 0.f) + EPS);
      vn[t] = (cvv[t] - m_) * rstd * g + bb;
      p.out[O_SCV + ((size_t)(l * 128 + n) * 4 + t) * 256 + c] = vn[t];
    }
#pragma unroll
    for (int t = 0; t < 4; t++) {
      float acc = p.c_bs[(l * 4 + h) * 128 + t];
#pragma unroll
      for (int s = 0; s < 4; s++)
        if (s <= t) acc += p.c_ws[((size_t)(l * 4 + h) * 128 + t) * 128 + s] * vn[s];
      float yc = bf2f(inter[(Rs + t) * IW + 1536 + c]) * acc;
      p.mix[(Rs + t) * DM + 768 + c] = f2bf(yc);
    }
  }
  __syncthreads();
}

__device__ void phase2(const Params& p, int l, char* smem) {
  float* red = (float*)(smem + 90112);
  const int nb = gridDim.x, b = blockIdx.x;
  p2_stage_w(p, l, smem);
  {
    ATileRegs A;
    if (b < 512) p2_ab_load(p, b, A);
#pragma unroll 1
    for (int it = b; it < 512; it += nb) {
      p2_ab_store(A, smem);
      __syncthreads();
      const int nx = (it + nb < 512) ? it + nb : it;
      p2_ab_load(p, nx, A);
      p2_ab(p, l, it, smem);
    }
  }
  for (int it = b; it < 128; it += nb) {
    asm volatile("" ::: "memory");
    p2_c(p, l, it, smem);
  }
  for (int it = (b + nb - (128 % nb)) % nb; it < 128; it += nb) {
    asm volatile("" ::: "memory");
    p2_s(p, l, it, red, (float*)smem);
  }
}

__device__ void phase4(const Params& p) {
  const int tid = otid();
  const float* ssq = p.sumsq + (size_t)2 * NTOK;
  for (int idx = blockIdx.x * NT + tid; idx < NTOK * 128; idx += gridDim.x * NT) {
    const int row = idx >> 7, c8 = idx & 127;
    uint4 v = *(const uint4*)(p.xb + (size_t)row * DM + c8 * 8);
    const float rs = rsqrtf(ssq[row] * (1.f / 1024.f) + EPS);
    float4 g0 = *(const float4*)(p.final_g + c8 * 8), g1 = *(const float4*)(p.final_g + c8 * 8 + 4);
    float f[8];
    unpack8(v, f);
    float* o = p.out + (size_t)row * DM + c8 * 8;
    *(float4*)o = make_float4(f[0] * rs * g0.x, f[1] * rs * g0.y, f[2] * rs * g0.z, f[3] * rs * g0.w);
    *(float4*)(o + 4) = make_float4(f[4] * rs * g1.x, f[5] * rs * g1.y, f[6] * rs * g1.z, f[7] * rs * g1.w);
  }
}

#define CEN_WORD(j) (XCD_BAR_WORDS + 64 * (j))
#define BAR_TOTAL_WORDS (XCD_BAR_WORDS + 64 * 16)
__global__ void __launch_bounds__(NT) fwd_megakernel(Params p) {
  extern __shared__ __attribute__((aligned(16))) char smem[];
  __shared__ uint4 xb_words;
  __shared__ uint4 sched_words;
  if (threadIdx.x == 0) {
    xb_words = make_uint4(0u, 0u, 0u, 0u);
    const unsigned x = xb_xcc_id();
    const unsigned slot = xb_add(&p.bar[CEN_WORD(x)], 1u);
    sched_words = make_uint4(slot, 1u, 0u, gridDim.x);
  }
  __syncthreads();
  XcdBarrier gb = xcd_barrier_post(p.bar, (volatile LAS unsigned*)&xb_words);
  const volatile LAS unsigned* sched = (const volatile LAS unsigned*)&sched_words;
  phase0(p, smem);
  xcd_barrier(gb);
  if (threadIdx.x == 0) {
    const unsigned x = xb_xcc_id();
    unsigned prefix = 0u, mine = 1u;
#pragma unroll
    for (unsigned j = 0; j < 16; ++j) {
      const unsigned c = xb_ld(&p.bar[CEN_WORD(j)]);
      prefix += (j < x) ? c : 0u;
      mine = (j == x) ? c : mine;
    }
    volatile LAS unsigned* sw = (volatile LAS unsigned*)&sched_words;
    sw[1] = mine;
    sw[2] = prefix;
  }
  __syncthreads();
#pragma unroll 1
  for (int l = 0; l < 2; l++) {
    phase1(p, l, smem);
    xcd_barrier(gb);
    phase2(p, l, smem);
    xcd_barrier(gb);
    phase3(p, l, smem);
    xcd_barrier(gb);
  }
  phase4(p);
}

extern "C" void kernel_launch(void* const* d_in, const int* in_sizes, int n_in, void* d_out, int out_size, void* d_ws,
                              size_t ws_size, hipStream_t stream) {
  static int grid_blocks = 0;
  if (!grid_blocks) {
    int dev = 0, cus = 0, per_cu = 0;
    hipGetDevice(&dev);
    hipDeviceGetAttribute(&cus, hipDeviceAttributeMultiprocessorCount, dev);
    hipFuncSetAttribute((const void*)fwd_megakernel, hipFuncAttributeMaxDynamicSharedMemorySize, LDS_BYTES);
    hipOccupancyMaxActiveBlocksPerMultiprocessor(&per_cu, (const void*)fwd_megakernel, NT, LDS_BYTES);
    if (per_cu < 1) { fprintf(stderr, "occupancy query returned %d\n", per_cu); per_cu = 1; }
    if (per_cu > 1) per_cu = 1;
    grid_blocks = cus * per_cu;
  }
  Params p{};
  p.x_prompt = (const float*)d_in[0];
  p.x_sample = (const float*)d_in[1];
  p.state_a = (const float*)d_in[2];
  p.state_b = (const float*)d_in[3];
  p.norm_g = (const float*)d_in[4];
  p.w_in = (const float*)d_in[5];
  p.a_conv_w = (const float*)d_in[6];
  p.a_conv_b = (const float*)d_in[7];
  p.a_ln_g = (const float*)d_in[8];
  p.a_ln_b = (const float*)d_in[9];
  p.b_conv_w = (const float*)d_in[10];
  p.c_ln_g = (const float*)d_in[11];
  p.c_ln_b = (const float*)d_in[12];
  p.c_ws = (const float*)d_in[13];
  p.c_bs = (const float*)d_in[14];
  p.w_out = (const float*)d_in[15];
  p.final_g = (const float*)d_in[16];
  p.out = (float*)d_out;
  char* ws = (char*)d_ws;
  size_t off = 0;
  auto take = [&](size_t bytes) { char* r = ws + off; off += (bytes + 255) & ~(size_t)255; return r; };
  p.win_b = (u16*)take((size_t)2 * 3584 * DM * 2);
  p.wout_b = (u16*)take((size_t)2 * DM * DM * 2);
  p.wc_b = (u16*)take((size_t)2 * 4 * 128 * 128 * 2);
  p.xb = (u16*)take((size_t)NTOK * DM * 2);
  p.inter = (u16*)take((size_t)NTOK * IW * 2);
  p.mix = (u16*)take((size_t)NTOK * DM * 2);
  p.sumsq = (float*)take((size_t)3 * NTOK * 4);
  p.rsw = (float*)take((size_t)2 * 4 * 128 * 4);
  p.bar = (unsigned*)take((size_t)BAR_TOTAL_WORDS * 4);
  hipMemsetAsync(p.bar, 0, (size_t)BAR_TOTAL_WORDS * 4, stream);
  void* args[] = {&p};
  hipError_t e = hipLaunchCooperativeKernel((const void*)fwd_megakernel, dim3(grid_blocks), dim3(NT), args, LDS_BYTES, stream);
  if (e != hipSuccess) fprintf(stderr, "cooperative launch failed: %s (grid %d)\n", hipGetErrorString(e), grid_blocks);
}
```

```cpp
#include <hip/hip_runtime.h>
#include <cstdio>
#include <cstdint>
#include <type_traits>

typedef unsigned short u16;
typedef short bf16x8 __attribute__((ext_vector_type(8)));
typedef float f32x16 __attribute__((ext_vector_type(16)));
typedef unsigned int u32x4 __attribute__((ext_vector_type(4)));

constexpr int NTOK = 16896, NPR = 16384, DM = 1024, INW = 3456, IW = 2048;
constexpr int NT = 512;
constexpr int INWP = 3584;
constexpr int LDS_BYTES = 131072;
constexpr float EPS = 1e-6f;

constexpr size_t O_SAP = 17301504, O_SBP = 17485824, O_SAS = 17498112, O_SBS = 20447232, O_SCV = 20643840;

struct Params {
  const float *x_prompt, *x_sample, *state_a, *state_b, *norm_g, *w_in, *a_conv_w, *a_conv_b, *a_ln_g, *a_ln_b,
      *b_conv_w, *c_ln_g, *c_ln_b, *c_ws, *c_bs, *w_out, *final_g;
  float* out;
  u16 *win_b, *wout_b, *wc_b, *xb, *inter, *mix;
  float *sumsq, *rsw;
  unsigned* bar;
};

__device__ __forceinline__ u16 f2bf(float f) {
  unsigned u = __float_as_uint(f);
  u += 0x7fffu + ((u >> 16) & 1u);
  return (u16)(u >> 16);
}
__device__ __forceinline__ float bf2f(u16 h) { return __uint_as_float(((unsigned)h) << 16); }
__device__ __forceinline__ unsigned pack2(float a, float b) {
  unsigned r;
  asm volatile("v_cvt_pk_bf16_f32 %0, %1, %2" : "=v"(r) : "v"(a), "v"(b));
  return r;
}
__device__ __forceinline__ float sigmoidf_(float x) { return __builtin_amdgcn_rcpf(1.f + __builtin_amdgcn_exp2f(-1.44269504f * x)); }
__device__ __forceinline__ float siluf_(float x) { return x * __builtin_amdgcn_rcpf(1.f + __builtin_amdgcn_exp2f(-1.44269504f * x)); }

__device__ __forceinline__ void unpack8(const uint4& v, float (&f)[8]) {
  f[0] = __uint_as_float(v.x << 16); f[1] = __uint_as_float(v.x & 0xffff0000u);
  f[2] = __uint_as_float(v.y << 16); f[3] = __uint_as_float(v.y & 0xffff0000u);
  f[4] = __uint_as_float(v.z << 16); f[5] = __uint_as_float(v.z & 0xffff0000u);
  f[6] = __uint_as_float(v.w << 16); f[7] = __uint_as_float(v.w & 0xffff0000u);
}
__device__ __forceinline__ uint4 pack8(const float (&f)[8]) {
  uint4 o;
  o.x = pack2(f[0], f[1]); o.y = pack2(f[2], f[3]); o.z = pack2(f[4], f[5]); o.w = pack2(f[6], f[7]);
  return o;
}

__device__ __forceinline__ __amdgpu_buffer_rsrc_t mk_rsrc(void* base, unsigned bytes) {
  return __builtin_amdgcn_make_buffer_rsrc(base, 0, bytes, 0x00020000);
}
__device__ __forceinline__ void st16_wt(__amdgpu_buffer_rsrc_t r, unsigned byte_off, const uint4& v) {
  u32x4 d = {v.x, v.y, v.z, v.w};
  __builtin_amdgcn_raw_buffer_store_b128(d, r, byte_off, 0, 16);
}

__device__ __forceinline__ int otid() {
  int t = threadIdx.x;
  asm volatile("" : "+v"(t));
  return t;
}

__device__ __forceinline__ int vcol_src(int vc);

#define XB_TMO      128
#define XB_XCNT(j)  (256  + 64 * (j))
#define XB_XSUB(j)  (1280 + 64 * (j))
#define XB_XGEN(j)  (2304 + 64 * (j))
#define XB_TOP      3328
#define XB_TOPGEN   3392
#define XCD_BAR_WORDS 3456
#define XB_SPIN_CAP (1u << 18)
#define LAS __attribute__((address_space(3)))

__device__ __forceinline__ unsigned xb_ld(unsigned* p)              { return __hip_atomic_load(p, __ATOMIC_RELAXED, __HIP_MEMORY_SCOPE_AGENT); }
__device__ __forceinline__ unsigned xb_add(unsigned* p, unsigned v) { return __hip_atomic_fetch_add(p, v, __ATOMIC_RELAXED, __HIP_MEMORY_SCOPE_AGENT); }
__device__ __forceinline__ unsigned xb_xcc_id() { return (unsigned)__builtin_amdgcn_s_getreg((3 << 11) | 20) & 0xFu; }
#define XB_SPIN(cond, bar) do { unsigned _sp = 0; while (cond) { __builtin_amdgcn_s_sleep(1); \
    if ((++_sp & 255u) == 0u) { if (xb_ld(&(bar)[XB_TMO])) break; if (_sp > XB_SPIN_CAP) { atomicAdd(&(bar)[XB_TMO], 1u); break; } } } } while (0)

struct XcdBarrier {
  unsigned* bar; unsigned x;
  volatile LAS unsigned* st;
};
__device__ __forceinline__ XcdBarrier xcd_barrier_post(unsigned* bar, volatile LAS unsigned* st) {
  XcdBarrier b; b.bar = bar; b.x = xb_xcc_id(); b.st = st;
  if (threadIdx.x == 0) (void)xb_add(&bar[XB_XCNT(b.x)], 1u);
  return b;
}
__device__ __forceinline__ void xcd_barrier_complete(unsigned* bar, unsigned x, unsigned& nloc, unsigned& nx) {
  const unsigned G = gridDim.x * gridDim.y * gridDim.z;
  unsigned sum, cnt, mine, sp = 0u;
  for (;;) {
    sum = 0u; cnt = 0u; mine = 0u;
#pragma unroll
    for (unsigned j = 0; j < 16; ++j) { const unsigned c = xb_ld(&bar[XB_XCNT(j)]); sum += c; cnt += (c > 0u) ? 1u : 0u; mine = (j == x) ? c : mine; }
    if (sum == G) break;
    __builtin_amdgcn_s_sleep(1);
    if ((++sp & 255u) == 0u) { if (xb_ld(&bar[XB_TMO])) break; if (sp > XB_SPIN_CAP) { atomicAdd(&bar[XB_TMO], 1u); break; } }
  }
  nloc = mine > 0u ? mine : 1u; nx = cnt > 0u ? cnt : 1u;
}
__device__ __forceinline__ void xcd_barrier(const XcdBarrier& b) {
  asm volatile("s_waitcnt vmcnt(0)" ::: "memory");
  __syncthreads();
  if (threadIdx.x == 0) {
    unsigned* bar = b.bar;
    __builtin_amdgcn_s_waitcnt(0);
    unsigned nloc = b.st[0], nx = b.st[1];
    if (nloc == 0u) { xcd_barrier_complete(bar, b.x, nloc, nx); b.st[0] = nloc; b.st[1] = nx; }
    const unsigned old = xb_add(&bar[XB_XSUB(b.x)], 1u);
    const unsigned gen = old / nloc;
    if (old + 1u == (gen + 1u) * nloc) {
      __builtin_amdgcn_fence(__ATOMIC_RELEASE, "agent");
      asm volatile("s_waitcnt vmcnt(0)" ::: "memory");
      const unsigned og = xb_add(&bar[XB_TOP], 1u);
      const unsigned tg = og / nx;
      if (og + 1u == (tg + 1u) * nx) xb_add(&bar[XB_TOPGEN], 1u);
      else XB_SPIN(xb_ld(&bar[XB_TOPGEN]) == tg, bar);
      __builtin_amdgcn_fence(__ATOMIC_ACQUIRE, "agent");
      xb_add(&bar[XB_XGEN(b.x)], 1u);
      asm volatile("s_waitcnt vmcnt(0)" ::: "memory");
    } else {
      XB_SPIN(xb_ld(&bar[XB_XGEN(b.x)]) == gen, bar);
      __builtin_amdgcn_fence(__ATOMIC_ACQUIRE, "agent");
      asm volatile("s_waitcnt vmcnt(0)" ::: "memory");
    }
  }
  __syncthreads();
}

__device__ void p0_transpose(const float* __restrict__ W, int ncols, const float* __restrict__ g, u16* __restrict__ outp,
                             int k0, int v0, bool mapv, float* tile) {
  int tid = otid();
  float vals[16];
#pragma unroll
  for (int i = 0; i < 16; i++) {
    int e = tid + i * NT;
    int kk = e >> 7, v = e & 127;
    int src = mapv ? vcol_src(v0 + v) : (v0 + v);
    float val = 0.f;
    if (src >= 0) val = __builtin_nontemporal_load(W + (size_t)(k0 + kk) * ncols + src);
    vals[i] = val;
  }
#pragma unroll
  for (int i = 0; i < 16; i++) {
    int e = tid + i * NT;
    int kk = e >> 7, v = e & 127;
    float val = vals[i];
    if (g) val *= g[k0 + kk];
    tile[kk * 129 + v] = val;
  }
  __syncthreads();
#pragma unroll
  for (int h = 0; h < 2; h++) {
    int v = (tid >> 3) + h * 64, kq = tid & 7;
    const float* tp = tile + (kq * 8) * 129 + v;
    uint4 o;
    o.x = pack2(tp[0], tp[129]);
    o.y = pack2(tp[2 * 129], tp[3 * 129]);
    o.z = pack2(tp[4 * 129], tp[5 * 129]);
    o.w = pack2(tp[6 * 129], tp[7 * 129]);
    *(uint4*)(outp + (size_t)(v0 + v) * 1024 + k0 + kq * 8) = o;
  }
  __syncthreads();
}

__device__ void p0_weights(const Params& p, int l, int rank, int nranks, float* tile) {
  for (int it = rank; it < 16 * 28; it += nranks) {
    int kb = it / 28, vb = it % 28;
    p0_transpose(p.w_in + (size_t)l * DM * INW, INW, p.norm_g + l * DM, p.win_b + (size_t)l * INWP * DM, kb * 64, vb * 128, true, tile);
  }
  for (int it = rank; it < 16 * 8; it += nranks) {
    int kb = it >> 3, vb = it & 7;
    p0_transpose(p.w_out + (size_t)l * DM * DM, DM, nullptr, p.wout_b + (size_t)l * DM * DM, kb * 64, vb * 128, false, tile);
  }
}

__device__ void phase0(const Params& p, char* smem) {
  float* tile = (float*)smem;
  int nb = gridDim.x, b = blockIdx.x, tid = otid();
  const int wave = tid >> 6, lane = tid & 63;
  for (int e = b * NT + tid; e < 2 * NTOK; e += nb * NT) p.sumsq[NTOK + e] = 0.f;
  for (int e = b * NT + tid; e < 2 * 4 * 128 * 128; e += nb * NT) {
    int s = e & 127, t = (e >> 7) & 127;
    p.wc_b[e] = (s <= t) ? f2bf(p.c_ws[e]) : (u16)0;
  }
  for (int r = b * 8 + wave; r < 2 * 4 * 128; r += nb * 8) {
    const int t = r & 127;
    const float* wr = p.c_ws + (size_t)r * 128;
    float s = 0.f;
    if (lane <= t) s += bf2f(f2bf(wr[lane]));
    if (lane + 64 <= t) s += bf2f(f2bf(wr[lane + 64]));
#pragma unroll
    for (int m = 32; m >= 1; m >>= 1) s += __shfl_xor(s, m);
    if (lane == 0) p.rsw[r] = s;
  }
  const bool wfirst = (b & 1) != 0;
  if (wfirst) p0_weights(p, 0, b, nb, tile);
  for (int row = (b * 8 + wave) * 2; row < NTOK; row += nb * 16) {
    const float* xr0 = (row < NPR) ? (p.x_prompt + (size_t)row * DM) : (p.x_sample + (size_t)(row - NPR) * DM);
    const float* xr1 = xr0 + DM;
    float4 v0[4], v1[4];
#pragma unroll
    for (int j = 0; j < 4; j++) {
      typedef float f4v __attribute__((ext_vector_type(4)));
      f4v a = __builtin_nontemporal_load((const f4v*)(xr0 + (j * 64 + lane) * 4));
      f4v c = __builtin_nontemporal_load((const f4v*)(xr1 + (j * 64 + lane) * 4));
      v0[j] = make_float4(a.x, a.y, a.z, a.w);
      v1[j] = make_float4(c.x, c.y, c.z, c.w);
    }
    float s0 = 0.f, s1 = 0.f;
#pragma unroll
    for (int j = 0; j < 4; j++) {
      s0 += v0[j].x * v0[j].x + v0[j].y * v0[j].y + v0[j].z * v0[j].z + v0[j].w * v0[j].w;
      s1 += v1[j].x * v1[j].x + v1[j].y * v1[j].y + v1[j].z * v1[j].z + v1[j].w * v1[j].w;
      *(uint2*)(p.xb + (size_t)row * DM + (j * 64 + lane) * 4) = make_uint2(pack2(v0[j].x, v0[j].y), pack2(v0[j].z, v0[j].w));
      *(uint2*)(p.xb + (size_t)(row + 1) * DM + (j * 64 + lane) * 4) = make_uint2(pack2(v1[j].x, v1[j].y), pack2(v1[j].z, v1[j].w));
    }
#pragma unroll
    for (int m = 32; m >= 1; m >>= 1) { s0 += __shfl_xor(s0, m); s1 += __shfl_xor(s1, m); }
    if (lane == 0) { p.sumsq[row] = s0; p.sumsq[row + 1] = s1; }
  }
  if (!wfirst) p0_weights(p, 0, b, nb, tile);
}

namespace pg8 {
#define PG8_LAS __attribute__((address_space(3)))
typedef unsigned short bf16_t;
typedef short bf16x8 __attribute__((ext_vector_type(8)));
typedef float f32x4 __attribute__((ext_vector_type(4)));
typedef unsigned u32x4 __attribute__((ext_vector_type(4)));
constexpr int BM = 256, BK = 64, HALF = 128, HTB = HALF * BK * 2  , STAGE_BYTES = 8 * HTB, NXCD = 8, WGM = 8;

__host__ __device__ __forceinline__ int lds_byte(int r, int c) { const int st = (r >> 4) * 2 + (c >> 5), rr = r & 15, cc = c & 31, ob = rr * 64 + cc * 2; return st * 1024 + (ob ^ (((ob >> 9) & 1) << 5)); }
__host__ __device__ __forceinline__ void stage_rc(int b, int& R, int& C) { const int st = b / 1024, sb = b % 1024, swz = sb ^ (((sb >> 9) & 1) << 5); R = (st >> 1) * 16 + swz / 64; C = (st & 1) * 32 + (swz % 64) / 2; }
__host__ __device__ __forceinline__ int perm32(int rho) { const int n = rho >> 4, i = rho & 15; return 8 * (i >> 2) + 4 * n + (i & 3); }

struct Unit { int pm, pn; };
struct Gemm { const bf16_t* A; const bf16_t* Bt; int M, N, K; };

struct StaticOrder {
    int nM, nN, nwg, G, c;
    __host__ __device__ void init(int M, int N, int G_, int c_) { nM = M / BM; nN = N / BM; nwg = nM * nN; G = G_; c = c_; }
    __host__ __device__ bool next(int i, Unit& u) const {
        const long L = (long)i * G + c; if (L >= nwg) return false;
        int wgid = (int)L; { const int q = nwg / NXCD, r = nwg % NXCD, xcd = wgid % NXCD, off = wgid / NXCD; wgid = (xcd < r ? xcd * (q + 1) : r * (q + 1) + (xcd - r) * q) + off; }
        const int nig = WGM * nN, gid = wgid / nig, fm = gid * WGM, gsz = (nM - fm) < WGM ? (nM - fm) : WGM;
        u.pm = fm + ((wgid % nig) % gsz); u.pn = (wgid % nig) / gsz; return true;
    }
    __device__ __forceinline__ void a_ready(const Unit&) const {}
    __device__ __forceinline__ void done(const Unit&) const {}
};
__device__ __forceinline__ unsigned cvt_pk_bf16(float lo, float hi) { unsigned r; asm volatile("v_cvt_pk_bf16_f32 %0, %1, %2" : "=v"(r) : "v"(lo), "v"(hi)); return r; }
template <class Epi, class Sched, bool STAMP = false>
__device__ __forceinline__ void gemm_phase(PG8_LAS unsigned char* lds, const Gemm g, const Sched& S, const Epi& E, unsigned long long* stamps) {
    const int tid = otid(), wid = __builtin_amdgcn_readfirstlane(tid >> 6), lane = tid & 63, wr = wid >> 2, wc = wid & 3, fr = lane & 15, fq = lane >> 4;
    const int K = g.K, nt = K / BK;
    int ts_lo = 0, ts_hi = 0, nts = 0; const unsigned long long rt_entry = STAMP ? (unsigned long long)wall_clock64() : 0ull;
#define PG8_STAMP() do { if (STAMP && wid == 0 && nts < 64) { const unsigned long long _c = (unsigned long long)clock64(); \
        ts_lo = (lane == nts) ? (int)(unsigned)_c : ts_lo; ts_hi = (lane == nts) ? (int)(unsigned)(_c >> 32) : ts_hi; ++nts; } } while (0)
    PG8_STAMP();
    unsigned voffA[2], voffB[2];
#pragma unroll
    for (int i = 0; i < 2; ++i) { int R, C; stage_rc(tid * 16 + i * 8192, R, C); const int Rb = Epi::PERM ? ((R & ~31) + perm32(R & 31)) : R;
        voffA[i] = (unsigned)(R * K + C) * 2u; voffB[i] = (unsigned)(Rb * K + C) * 2u; }
    const size_t kstep = (size_t)(BK * 2);
    const size_t hstep = (size_t)HALF * K * 2;
    const size_t tstep = 2 * hstep;
    const unsigned ldsw = (unsigned)wid * 1024u;
    const int aoff = lds_byte(wr * 64 + fr, fq * 8), boff = lds_byte(wc * 32 + fr, fq * 8);
#define PG8_SA(b, h) (((b) * 2 + (h)) * HTB)
#define PG8_SB(b, h) ((4 + (b) * 2 + (h)) * HTB)
#define PG8_STAGE(bufoff, gbase, voff) do { _Pragma("unroll") for (int _i = 0; _i < 2; ++_i) \
        __builtin_amdgcn_global_load_lds((const unsigned*)((const char*)(gbase) + (voff)[_i]), (PG8_LAS unsigned*)(lds + (bufoff) + ldsw + _i * 8192), 16, 0, 0); } while (0)
#define PG8_LDA(dst, b, h) do { _Pragma("unroll") for (int m = 0; m < 4; ++m) _Pragma("unroll") for (int k = 0; k < 2; ++k) dst[m][k] = *(const PG8_LAS bf16x8*)(lds + PG8_SA(b, h) + aoff + m * 2048 + k * 1024); } while (0)
#define PG8_LDB(dst, b, h) do { _Pragma("unroll") for (int n = 0; n < 2; ++n) _Pragma("unroll") for (int k = 0; k < 2; ++k) dst[n][k] = *(const PG8_LAS bf16x8*)(lds + PG8_SB(b, h) + boff + n * 2048 + k * 1024); } while (0)
#define PG8_MMA(ai, bj, At, Bt) do { __builtin_amdgcn_s_setprio(1); _Pragma("unroll") for (int m = 0; m < 4; ++m) _Pragma("unroll") for (int n = 0; n < 2; ++n) _Pragma("unroll") for (int k = 0; k < 2; ++k) \
        acc[ai][bj][m][n] = __builtin_amdgcn_mfma_f32_16x16x32_bf16(Bt[n][k], At[m][k], acc[ai][bj][m][n], 0, 0, 0); __builtin_amdgcn_s_setprio(0); } while (0)
#define PG8_WAIT_V(n) asm volatile("s_waitcnt vmcnt(" #n ")" ::: "memory")
#define PG8_WAIT_L(n) asm volatile("s_waitcnt lgkmcnt(" #n ")" ::: "memory")
#define PG8_BAR __builtin_amdgcn_s_barrier()
#define PG8_SCHED __builtin_amdgcn_sched_barrier(0)
    Unit cur, nxt; int ui = 0;
    if (!S.next(0, cur)) return;
    f32x4 acc[2][2][4][2];
#pragma unroll
    for (int a = 0; a < 2; ++a)
#pragma unroll
        for (int b = 0; b < 2; ++b)
#pragma unroll
            for (int m = 0; m < 4; ++m)
#pragma unroll
                for (int n = 0; n < 2; ++n) acc[a][b][m][n] = (f32x4){0.f, 0.f, 0.f, 0.f};
    bf16x8 At[4][2], B0[2][2], B1[2][2];
    const char* cA = (const char*)g.A + (size_t)cur.pm * tstep; const char* cB = (const char*)g.Bt + (size_t)cur.pn * tstep;
    typename Epi::Pre pre;
    E.preload(cur, wr, fr, pre);
    S.a_ready(cur);
    PG8_STAGE(PG8_SB(0, 0), cB, voffB); PG8_STAGE(PG8_SA(0, 0), cA, voffA); PG8_STAGE(PG8_SB(0, 1), cB + hstep, voffB); PG8_STAGE(PG8_SA(0, 1), cA + hstep, voffA);
    if (wr == 1) PG8_BAR;
    PG8_WAIT_V(4); PG8_BAR;
    PG8_STAGE(PG8_SB(1, 0), cB + kstep, voffB); PG8_STAGE(PG8_SA(1, 0), cA + kstep, voffA); PG8_STAGE(PG8_SB(1, 1), cB + hstep + kstep, voffB);
    PG8_WAIT_V(6); PG8_BAR;
    PG8_STAMP();
    for (;;) {
        const bool has_next = S.next(ui + 1, nxt);
        const char* nA = has_next ? (const char*)g.A + (size_t)nxt.pm * tstep : cA; const char* nB = has_next ? (const char*)g.Bt + (size_t)nxt.pn * tstep : cB;
        for (int t = 0; t < nt; t += 2) {
            const bool last = (t == nt - 2);
            const char* a1 = cA + (size_t)(t + 1) * kstep;
            const char* a2 = last ? nA : cA + (size_t)(t + 2) * kstep; const char* b2 = last ? nB : cB + (size_t)(t + 2) * kstep;
            const char* a3 = a2 + kstep; const char* b3 = b2 + kstep;
            if (last && has_next) S.a_ready(nxt);
            PG8_LDB(B0, 0, 0); PG8_SCHED; PG8_LDA(At, 0, 0); PG8_STAGE(PG8_SA(1, 1), a1 + hstep, voffA);
            PG8_WAIT_L(8); PG8_BAR; PG8_WAIT_L(0); PG8_MMA(0, 0, At, B0); PG8_BAR; PG8_SCHED;
            PG8_LDB(B1, 0, 1); PG8_STAGE(PG8_SB(0, 0), b2, voffB);
            PG8_BAR; PG8_WAIT_L(0); PG8_MMA(0, 1, At, B1); PG8_BAR;
            PG8_LDA(At, 0, 1); PG8_STAGE(PG8_SA(0, 0), a2, voffA);
            PG8_BAR; PG8_WAIT_L(0); PG8_MMA(1, 0, At, B0); PG8_BAR; PG8_SCHED;
            PG8_STAGE(PG8_SB(0, 1), b2 + hstep, voffB);
            PG8_WAIT_V(6); PG8_BAR; PG8_MMA(1, 1, At, B1); PG8_BAR;
            PG8_LDB(B0, 1, 0); PG8_SCHED; PG8_LDA(At, 1, 0); PG8_STAGE(PG8_SA(0, 1), a2 + hstep, voffA);
            PG8_WAIT_L(8); PG8_BAR; PG8_WAIT_L(0); PG8_MMA(0, 0, At, B0); PG8_BAR; PG8_SCHED;
            PG8_LDB(B1, 1, 1); PG8_STAGE(PG8_SB(1, 0), b3, voffB);
            PG8_BAR; PG8_WAIT_L(0); PG8_MMA(0, 1, At, B1); PG8_BAR;
            PG8_LDA(At, 1, 1); PG8_STAGE(PG8_SA(1, 0), a3, voffA);
            PG8_BAR; PG8_WAIT_L(0); PG8_MMA(1, 0, At, B0); PG8_BAR; PG8_SCHED;
            PG8_STAGE(PG8_SB(1, 1), b3 + hstep, voffB);
            PG8_WAIT_V(6); PG8_BAR; PG8_MMA(1, 1, At, B1); PG8_BAR;
        }
        PG8_STAMP();
        if constexpr (!Epi::AFTER_DRAIN) { E(acc, cur, wr, wc, fr, fq, pre); S.done(cur); }
        PG8_STAMP();
        if (!has_next) break;
#pragma unroll
        for (int a = 0; a < 2; ++a)
#pragma unroll
            for (int b = 0; b < 2; ++b)
#pragma unroll
                for (int m = 0; m < 4; ++m)
#pragma unroll
                    for (int n = 0; n < 2; ++n) acc[a][b][m][n] = (f32x4){0.f, 0.f, 0.f, 0.f};
        cur = nxt; cA = nA; cB = nB; ++ui;
        E.preload(cur, wr, fr, pre);
    }
    PG8_WAIT_V(0);
    if (wr == 0) PG8_BAR;
    PG8_BAR;
    if constexpr (Epi::AFTER_DRAIN) { E.fused(acc, cur, wr, wc, fr, fq, lds, wid, lane); S.done(cur); }
    PG8_STAMP();
    if (STAMP && wid == 0) { stamps[lane] = lane < nts ? (((unsigned long long)(unsigned)ts_hi << 32) | (unsigned)ts_lo) : 0ull;
        if (lane == 62) stamps[62] = rt_entry; if (lane == 63) stamps[63] = (unsigned long long)wall_clock64(); }
#undef PG8_STAMP
#undef PG8_SA
#undef PG8_SB
#undef PG8_STAGE
#undef PG8_LDA
#undef PG8_LDB
#undef PG8_MMA
#undef PG8_WAIT_V
#undef PG8_WAIT_L
#undef PG8_BAR
#undef PG8_SCHED
}
}


__device__ __forceinline__ int vcol_src(int vc) {
  const int un = vc >> 8, h = (vc >> 7) & 1, i = vc & 127;
  if (un < 3) return (h ? 384 : 0) + 128 * un + i;
  if (un < 6) return (h ? 1920 : 1152) + 128 * (un - 3) + i;
  if (un < 9) return (h ? 2304 : 1536) + 128 * (un - 6) + i;
  if (un < 11) return (h ? 3200 : 2688) + 128 * (un - 9) + i;
  if (un == 11) return 768 + 128 * h + i;
  if (un == 12) return h ? (2944 + i) : (768 + 256 + i);
  return h ? -1 : (2944 + 128 + i);
}

typedef float f32x4_ __attribute__((ext_vector_type(4)));
struct Epi1 {
  static constexpr bool PERM = true, AFTER_DRAIN = false;
  u16* inter; const float* ssq;
  struct Pre { float s[8]; };
  __device__ __forceinline__ void preload(const pg8::Unit& u, int wr, int fr, Pre& P) const {
#pragma unroll
    for (int ai = 0; ai < 2; ++ai)
#pragma unroll
      for (int m = 0; m < 4; ++m) P.s[ai * 4 + m] = ssq[u.pm * 256 + 64 * wr + fr + 128 * ai + 16 * m];
  }
  __device__ __forceinline__ void operator()(const pg8::f32x4 (&acc)[2][2][4][2], const pg8::Unit& u, int wr, int wc, int fr, int fq, const Pre& P) const {
    const int un = u.pn;
    int k0, ob0, k1 = -1, ob1 = 0;
    if (un < 3) { k0 = 0; ob0 = 128 * un; }
    else if (un < 6) { k0 = 2; ob0 = 768 + 128 * (un - 3); }
    else if (un < 9) { k0 = 3; ob0 = 1152 + 128 * (un - 6); }
    else if (un < 11) { k0 = 3; ob0 = 1536 + 128 * (un - 9); }
    else if (un == 11) { k0 = 1; ob0 = 384; k1 = 1; ob1 = 384 + 128; }
    else if (un == 12) { k0 = 1; ob0 = 384 + 256; k1 = 4; ob1 = 1792; }
    else { k0 = 4; ob0 = 1792 + 128; k1 = -2; }
    const int cl = 32 * wc + 8 * fq;
    const int rbase = u.pm * 256 + 64 * wr + fr;
    const __amdgpu_buffer_rsrc_t irs = mk_rsrc(inter, (unsigned)NTOK * IW * 2u);
    auto body = [&](auto K0c, auto K1c) {
      constexpr int K0 = decltype(K0c)::value, K1 = decltype(K1c)::value;
#pragma unroll
      for (int ai = 0; ai < 2; ++ai)
#pragma unroll
        for (int m = 0; m < 4; ++m) {
          const int row = rbase + 128 * ai + 16 * m;
          const float rs = rsqrtf(P.s[ai * 4 + m] * (1.f / 1024.f) + EPS);
          float a[8], b[8], o[8];
#pragma unroll
          for (int i = 0; i < 4; i++) {
            a[i] = acc[ai][0][m][0][i] * rs; a[4 + i] = acc[ai][0][m][1][i] * rs;
            b[i] = acc[ai][1][m][0][i] * rs; b[4 + i] = acc[ai][1][m][1][i] * rs;
          }
          const unsigned rpo = ((unsigned)row * IW + cl) * 2u;
          if (K1 == -1) {
#pragma unroll
            for (int i = 0; i < 8; i++) o[i] = (K0 == 0) ? a[i] * sigmoidf_(b[i]) : (K0 == 2) ? a[i] * b[i] : a[i] * siluf_(b[i]);
            st16_wt(irs, rpo + ob0 * 2u, pack8(o));
          } else {
#pragma unroll
            for (int i = 0; i < 8; i++) o[i] = (K0 == 1) ? siluf_(a[i]) : a[i];
            st16_wt(irs, rpo + ob0 * 2u, pack8(o));
            if (K1 != -2) {
#pragma unroll
              for (int i = 0; i < 8; i++) o[i] = (K1 == 1) ? siluf_(b[i]) : b[i];
              st16_wt(irs, rpo + ob1 * 2u, pack8(o));
            }
          }
        }
    };
    using std::integral_constant;
    if (k1 == -1) {
      if (k0 == 0) body(integral_constant<int, 0>{}, integral_constant<int, -1>{});
      else if (k0 == 2) body(integral_constant<int, 2>{}, integral_constant<int, -1>{});
      else body(integral_constant<int, 3>{}, integral_constant<int, -1>{});
    } else if (k1 == 1) body(integral_constant<int, 1>{}, integral_constant<int, 1>{});
    else if (k1 == 4) body(integral_constant<int, 1>{}, integral_constant<int, 4>{});
    else body(integral_constant<int, 4>{}, integral_constant<int, -2>{});
  }
};
struct Epi2 {
  static constexpr bool PERM = true, AFTER_DRAIN = false;
  u16* xb; float* ssq;
  struct Pre {};
  __device__ __forceinline__ void preload(const pg8::Unit&, int, int, Pre&) const {}
  __device__ __forceinline__ void operator()(const pg8::f32x4 (&acc)[2][2][4][2], const pg8::Unit& u, int wr, int wc, int fr, int fq, const Pre&) const {
    const int cl = u.pn * 256 + 32 * wc + 8 * fq;
    const __amdgpu_buffer_rsrc_t xrs = mk_rsrc(xb, (unsigned)NTOK * DM * 2u);
#pragma unroll
    for (int ai = 0; ai < 2; ++ai)
#pragma unroll
      for (int m = 0; m < 4; ++m) {
        const int row = u.pm * 256 + 128 * ai + 64 * wr + 16 * m + fr;
        u16* rp = xb + (size_t)row * DM + cl;
        uint4 o0 = *(const uint4*)(rp), o1 = *(const uint4*)(rp + 128);
        float x0[8], x1[8];
        unpack8(o0, x0);
        unpack8(o1, x1);
        float ss = 0.f;
#pragma unroll
        for (int i = 0; i < 4; i++) {
          x0[i] += acc[ai][0][m][0][i]; x0[4 + i] += acc[ai][0][m][1][i];
          x1[i] += acc[ai][1][m][0][i]; x1[4 + i] += acc[ai][1][m][1][i];
        }
#pragma unroll
        for (int i = 0; i < 8; i++) ss += x0[i] * x0[i] + x1[i] * x1[i];
        const unsigned xo = ((unsigned)row * DM + cl) * 2u;
        st16_wt(xrs, xo, pack8(x0));
        st16_wt(xrs, xo + 256u, pack8(x1));
        ss += __shfl_xor(ss, 16);
        ss += __shfl_xor(ss, 32);
        if (fq == 0) atomicAdd(ssq + row, ss);
      }
  }
};

__device__ void phase1(const Params& p, int l, char* smem) {
  pg8::Gemm g{p.xb, p.win_b + (size_t)l * INWP * DM, NTOK, INWP, DM};
  pg8::StaticOrder S;
  S.init(NTOK, INWP, (int)gridDim.x, (int)blockIdx.x);
  Epi1 E{p.inter, p.sumsq + (size_t)l * NTOK};
  pg8::gemm_phase<Epi1, pg8::StaticOrder, false>((PG8_LAS unsigned char*)smem, g, S, E, nullptr);
  if (l == 0) {
    const int G = (int)gridDim.x, c = (int)blockIdx.x;
    const int rem = ((NTOK / 256) * (INWP / 256)) % G;
    const int nidle = (rem == 0) ? G : G - rem;
    const int rank = (rem == 0) ? c : c - rem;
    if (rank >= 0) p0_weights(p, 1, rank, nidle, (float*)smem);
  }
}
__device__ void phase3_sample(const Params& p, int l, char* smem) {
  const int tid = otid();
  const int lane = tid & 63, w = tid >> 6;
  const int l32 = lane & 31, lh = lane >> 5;
  float* part = (float*)smem;
  float* ssq = p.sumsq + (size_t)(l + 1) * NTOK;
  for (int T = blockIdx.x; T < 256; T += gridDim.x) {
    const int row0 = NPR + (T >> 4) * 32, col0 = (T & 15) * 64;
    const u16* ap = p.mix + (size_t)(row0 + l32) * DM + w * 128 + lh * 8;
    const u16* bp = p.wout_b + ((size_t)l * DM + col0 + l32) * DM + w * 128 + lh * 8;
    bf16x8 af[8], b0[8], b1[8];
#pragma unroll
    for (int s = 0; s < 8; s++) {
      af[s] = *(const bf16x8*)(ap + s * 16);
      b0[s] = *(const bf16x8*)(bp + s * 16);
      b1[s] = *(const bf16x8*)(bp + (size_t)32 * DM + s * 16);
    }
    f32x16 acc0, acc1;
#pragma unroll
    for (int r = 0; r < 16; r++) { acc0[r] = 0.f; acc1[r] = 0.f; }
#pragma unroll
    for (int s = 0; s < 8; s++) {
      acc0 = __builtin_amdgcn_mfma_f32_32x32x16_bf16(b0[s], af[s], acc0, 0, 0, 0);
      acc1 = __builtin_amdgcn_mfma_f32_32x32x16_bf16(b1[s], af[s], acc1, 0, 0, 0);
    }
#pragma unroll
    for (int r = 0; r < 16; r++) {
      part[((w * 2 + 0) * 16 + r) * 64 + lane] = acc0[r];
      part[((w * 2 + 1) * 16 + r) * 64 + lane] = acc1[r];
    }
    __syncthreads();
    float ss = 0.f;
    const int row = row0 + l32;
#pragma unroll
    for (int ni = 0; ni < 2; ni++) {
#pragma unroll
      for (int rr = 0; rr < 2; rr++) {
        const int r = 2 * w + rr;
        float v = 0.f;
#pragma unroll
        for (int pw = 0; pw < 8; pw++) v += part[((pw * 2 + ni) * 16 + r) * 64 + lane];
        const int col = col0 + ni * 32 + (r & 3) + 8 * (r >> 2) + 4 * lh;
        u16* xp = p.xb + (size_t)row * DM + col;
        v += bf2f(*xp);
        ss += v * v;
        *xp = f2bf(v);
      }
    }
    ss += __shfl_xor(ss, 32);
    if (lh == 0) atomicAdd(ssq + row, ss);
    __syncthreads();
  }
}

__device__ void phase3(const Params& p, int l, char* smem) {
  phase3_sample(p, l, smem);
  pg8::Gemm g{p.mix, p.wout_b + (size_t)l * DM * DM, NPR, DM, DM};
  pg8::StaticOrder S;
  S.init(NPR, DM, (int)gridDim.x, (int)blockIdx.x);
  Epi2 E{p.xb, p.sumsq + (size_t)(l + 1) * NTOK};
  pg8::gemm_phase<Epi2, pg8::StaticOrder, false>((PG8_LAS unsigned char*)smem, g, S, E, nullptr);
}

__device__ void p2_stage_w(const Params& p, int l, char* smem) {
  const int tid = otid();
  const float4* src = (const float4*)(p.a_conv_w + (size_t)l * 31 * 384);
  for (int f = tid; f < 36 * 96; f += NT) {
    int j = f / 96, q = f - j * 96;
    float4 v = make_float4(0.f, 0.f, 0.f, 0.f);
    if (j < 31) v = src[f];
    ((float4*)smem)[(j * 2 + (q & 1)) * 48 + (q >> 1)] = v;
  }
}

struct ATileRegs { u32x4 r0, r1, r2, r3, r4, r5; };
__device__ __forceinline__ void p2_ab_load(const Params& p, int it, ATileRegs& A) {
  const int tid = otid();
  const int R0 = it * 32;
  const int spos = R0 & 2047;
  const u16* __restrict__ inter = p.inter;
  auto ld = [&](int i) -> u32x4 {
    const int e = tid + i * NT;
    const int r = e / 48, ch = e - r * 48;
    u32x4 v = {0u, 0u, 0u, 0u};
    if (r < 62 && spos - 30 + r >= 0) v = *(const u32x4*)(inter + (size_t)(R0 - 30 + r) * IW + ch * 8);
    return v;
  };
  A.r0 = ld(0); A.r1 = ld(1); A.r2 = ld(2); A.r3 = ld(3); A.r4 = ld(4); A.r5 = ld(5);
}
__device__ __forceinline__ void p2_ab_store(const ATileRegs& A, char* smem) {
  const int tid = otid();
  char* atile = smem + 55296 + tid * 16;
  *(u32x4*)(atile) = A.r0;
  *(u32x4*)(atile + 1 * NT * 16) = A.r1;
  *(u32x4*)(atile + 2 * NT * 16) = A.r2;
  *(u32x4*)(atile + 3 * NT * 16) = A.r3;
  *(u32x4*)(atile + 4 * NT * 16) = A.r4;
  *(u32x4*)(atile + 5 * NT * 16) = A.r5;
}

typedef float f32x2 __attribute__((ext_vector_type(2)));
__device__ void p2_ab(const Params& p, int l, int it, char* smem) {
  const int tid = otid();
  const int lane = tid & 63, w = tid >> 6;
  const bool active = lane < 48;
  const int o = active ? lane : 47;
  const int R0 = it * 32;
  const int spos = R0 & 2047;
  const int bseq = R0 >> 11;
  const bool last = (spos == 2016);
  const u16* __restrict__ inter = p.inter;
  char* atile = smem + 55296;
  const float4* wts = (const float4*)smem;
  const size_t rowq = (size_t)R0 + 4 * w;
  const __amdgpu_buffer_rsrc_t mrs = mk_rsrc(p.mix, (unsigned)NTOK * DM * 2u);
  uint4 szv[4], gbv[4], zv[6];
#pragma unroll
  for (int t = 0; t < 4; t++) {
    szv[t] = *(const uint4*)(inter + (rowq + t) * IW + 384 + 8 * o);
    gbv[t] = *(const uint4*)(inter + (rowq + t) * IW + 1152 + 8 * o);
  }
#pragma unroll
  for (int s2 = 0; s2 < 6; s2++) {
    zv[s2] = make_uint4(0, 0, 0, 0);
    if (spos + 4 * w - 2 + s2 >= 0) zv[s2] = *(const uint4*)(inter + (rowq - 2 + s2) * IW + 768 + 8 * o);
  }
  f32x2 acc2[4][4];
  {
    float4 b0 = *(const float4*)(p.a_conv_b + l * 384 + 8 * o), b1 = *(const float4*)(p.a_conv_b + l * 384 + 8 * o + 4);
#pragma unroll
    for (int t = 0; t < 4; t++) {
      acc2[t][0] = (f32x2){b0.x, b0.y}; acc2[t][1] = (f32x2){b0.z, b0.w};
      acc2[t][2] = (f32x2){b1.x, b1.y}; acc2[t][3] = (f32x2){b1.z, b1.w};
    }
  }
  f32x2 wwin[4][4];
#pragma unroll
  for (int u = 0; u < 4; u++)
#pragma unroll
    for (int c = 0; c < 4; c++) wwin[u][c] = (f32x2){0.f, 0.f};
  const char* arow = atile + (4 * w) * 768 + o * 16;
#pragma unroll 1
  for (int s4 = 0; s4 < 36; s4 += 4) {
    const char* ar = arow + s4 * 768;
    const float4* wr = wts + (s4 * 2) * 48 + o;
#pragma unroll
    for (int u = 0; u < 4; u++) {
      uint4 av = *(const uint4*)(ar + u * 768);
      float4 wa = wr[(u * 2) * 48], wb = wr[(u * 2 + 1) * 48];
      f32x2 v[4];
      v[0] = (f32x2){__uint_as_float(av.x << 16), __uint_as_float(av.x & 0xffff0000u)};
      v[1] = (f32x2){__uint_as_float(av.y << 16), __uint_as_float(av.y & 0xffff0000u)};
      v[2] = (f32x2){__uint_as_float(av.z << 16), __uint_as_float(av.z & 0xffff0000u)};
      v[3] = (f32x2){__uint_as_float(av.w << 16), __uint_as_float(av.w & 0xffff0000u)};
      wwin[u][0] = (f32x2){wa.x, wa.y}; wwin[u][1] = (f32x2){wa.z, wa.w};
      wwin[u][2] = (f32x2){wb.x, wb.y}; wwin[u][3] = (f32x2){wb.z, wb.w};
#pragma unroll
      for (int t = 0; t < 4; t++) {
#pragma unroll
        for (int c = 0; c < 4; c++) acc2[t][c] = __builtin_elementwise_fma(wwin[(u - t) & 3][c], v[c], acc2[t][c]);
      }
    }
  }
  if (last && active) {
#pragma unroll
    for (int t = 0; t < 4; t++) {
      int pp = spos + 4 * w + t;
      if (pp >= 2018) {
        float v[8];
        unpack8(*(const uint4*)(arow + (30 + t) * 768), v);
        float* so = p.out + O_SAP + ((size_t)(l * 8 + bseq) * 30 + (pp - 2018)) * 384 + 8 * o;
        *(float4*)so = make_float4(v[0], v[1], v[2], v[3]);
        *(float4*)(so + 4) = make_float4(v[4], v[5], v[6], v[7]);
      }
    }
  }
  float acc[4][8];
#pragma unroll
  for (int t = 0; t < 4; t++)
#pragma unroll
    for (int c = 0; c < 4; c++) { acc[t][2 * c] = acc2[t][c].x; acc[t][2 * c + 1] = acc2[t][c].y; }
  float s1[4], s2[4];
#pragma unroll
  for (int t = 0; t < 4; t++) {
    float a = 0.f, b = 0.f;
#pragma unroll
    for (int c = 0; c < 8; c++) { a += acc[t][c]; b += acc[t][c] * acc[t][c]; }
    s1[t] = active ? a : 0.f;
    s2[t] = active ? b : 0.f;
  }
#pragma unroll
  for (int t = 0; t < 4; t++) {
#pragma unroll
    for (int m = 32; m >= 1; m >>= 1) { s1[t] += __shfl_xor(s1[t], m); s2[t] += __shfl_xor(s2[t], m); }
  }
  {
    float g8[8], b8[8];
    {
      float4 a0 = *(const float4*)(p.a_ln_g + l * 384 + 8 * o), a1 = *(const float4*)(p.a_ln_g + l * 384 + 8 * o + 4);
      float4 c0 = *(const float4*)(p.a_ln_b + l * 384 + 8 * o), c1 = *(const float4*)(p.a_ln_b + l * 384 + 8 * o + 4);
      g8[0] = a0.x; g8[1] = a0.y; g8[2] = a0.z; g8[3] = a0.w; g8[4] = a1.x; g8[5] = a1.y; g8[6] = a1.z; g8[7] = a1.w;
      b8[0] = c0.x; b8[1] = c0.y; b8[2] = c0.z; b8[3] = c0.w; b8[4] = c1.x; b8[5] = c1.y; b8[6] = c1.z; b8[7] = c1.w;
    }
#pragma unroll
    for (int t = 0; t < 4; t++) {
      float mu = s1[t] * (1.f / 384.f);
      float var = s2[t] * (1.f / 384.f) - mu * mu;
      float rstd = rsqrtf(fmaxf(var, 0.f) + EPS);
      float sz[8], y[8];
      unpack8(szv[t], sz);
#pragma unroll
      for (int c = 0; c < 8; c++) y[c] = siluf_((acc[t][c] - mu) * rstd * g8[c] + b8[c]) * sz[c];
      if (active) st16_wt(mrs, ((unsigned)(rowq + t) * DM + 8 * o) * 2u, pack8(y));
    }
  }
  {
    float w0[8], w1[8], w2[8];
    {
      const float* bw = p.b_conv_w + (size_t)l * 3 * 384 + 8 * o;
      float4 a0 = *(const float4*)(bw), a1 = *(const float4*)(bw + 4);
      float4 c0 = *(const float4*)(bw + 384), c1 = *(const float4*)(bw + 384 + 4);
      float4 d0 = *(const float4*)(bw + 768), d1 = *(const float4*)(bw + 768 + 4);
      w0[0] = a0.x; w0[1] = a0.y; w0[2] = a0.z; w0[3] = a0.w; w0[4] = a1.x; w0[5] = a1.y; w0[6] = a1.z; w0[7] = a1.w;
      w1[0] = c0.x; w1[1] = c0.y; w1[2] = c0.z; w1[3] = c0.w; w1[4] = c1.x; w1[5] = c1.y; w1[6] = c1.z; w1[7] = c1.w;
      w2[0] = d0.x; w2[1] = d0.y; w2[2] = d0.z; w2[3] = d0.w; w2[4] = d1.x; w2[5] = d1.y; w2[6] = d1.z; w2[7] = d1.w;
    }
    float z[6][8];
#pragma unroll
    for (int s2i = 0; s2i < 6; s2i++) unpack8(zv[s2i], z[s2i]);
#pragma unroll
    for (int t = 0; t < 4; t++) {
      float gb[8], y[8];
      unpack8(gbv[t], gb);
#pragma unroll
      for (int c = 0; c < 8; c++) y[c] = gb[c] * (w0[c] * z[t][c] + w1[c] * z[t + 1][c] + w2[c] * z[t + 2][c]);
      if (active) st16_wt(mrs, ((unsigned)(rowq + t) * DM + 384 + 8 * o) * 2u, pack8(y));
    }
    if (last && w == 7 && active) {
#pragma unroll
      for (int i = 0; i < 2; i++) {
        float* so = p.out + O_SBP + ((size_t)(l * 8 + bseq) * 2 + i) * 384 + 8 * o;
        *(float4*)so = make_float4(z[4 + i][0], z[4 + i][1], z[4 + i][2], z[4 + i][3]);
        *(float4*)(so + 4) = make_float4(z[4 + i][4], z[4 + i][5], z[4 + i][6], z[4 + i][7]);
      }
    }
  }
  __syncthreads();
}

__device__ void p2_c(const Params& p, int l, int ci, char* smem) {
  const int tid = otid();
  const int lane = tid & 63, w = tid >> 6;
  const int l32 = lane & 31, lh = lane >> 5;
  const int R0 = ci * 128;
  const u16* __restrict__ inter = p.inter;
  bf16x8 wf[4][8];
  {
    const u16* wb = p.wc_b + ((size_t)(l * 4 + (w >> 1)) * 128 + l32) * 128 + lh * 8;
#pragma unroll
    for (int ks = 0; ks < 8; ks++)
#pragma unroll
      for (int ti = 0; ti < 4; ti++)
        if (ti >= (ks >> 1)) wf[ti][ks] = *(const bf16x8*)(wb + (size_t)ti * 32 * 128 + ks * 16);
  }
  {
    const int tok = tid >> 2, qd = tid & 3;
    const u16* src = inter + (size_t)(R0 + tok) * IW + 1792 + qd * 64;
    uint4 xv[8];
#pragma unroll
    for (int i = 0; i < 8; i++) xv[i] = *(const uint4*)(src + i * 8);
    float s1 = 0.f, s2 = 0.f;
#pragma unroll
    for (int i = 0; i < 8; i++) {
      float f[8];
      unpack8(xv[i], f);
#pragma unroll
      for (int k = 0; k < 8; k++) { s1 += f[k]; s2 += f[k] * f[k]; }
    }
    s1 += __shfl_xor(s1, 1); s2 += __shfl_xor(s2, 1);
    s1 += __shfl_xor(s1, 2); s2 += __shfl_xor(s2, 2);
    const float mu = s1 * (1.f / 256.f);
    const float rstd = rsqrtf(fmaxf(s2 * (1.f / 256.f) - mu * mu, 0.f) + EPS);
    const int tch = tok >> 3, tlo = (tok & 7) * 2;
#pragma unroll
    for (int i = 0; i < 8; i++) {
      float f[8];
      unpack8(xv[i], f);
#pragma unroll
      for (int k = 0; k < 8; k++) {
        const int c = qd * 64 + i * 8 + k;
        *(u16*)(smem + c * 256 + ((tch ^ (c & 15)) << 4) + tlo) = f2bf((f[k] - mu) * rstd);
      }
    }
  }
  __syncthreads();
  {
    const int h = w >> 1;
    const int cbase = h * 64 + (w & 1) * 32;
    const int c = cbase + l32;
    f32x16 acc[4];
#pragma unroll
    for (int ti = 0; ti < 4; ti++)
#pragma unroll
      for (int r = 0; r < 16; r++) acc[ti][r] = 0.f;
#pragma unroll
    for (int ks = 0; ks < 8; ks++) {
      bf16x8 vfrag = *(const bf16x8*)(smem + c * 256 + (((ks * 2 + lh) ^ (c & 15)) << 4));
#pragma unroll
      for (int ti = 0; ti < 4; ti++) {
        if (ti >= (ks >> 1)) acc[ti] = __builtin_amdgcn_mfma_f32_32x32x16_bf16(vfrag, wf[ti][ks], acc[ti], 0, 0, 0);
      }
    }
    float4 gl[4], bl[4];
#pragma unroll
    for (int g = 0; g < 4; g++) {
      gl[g] = *(const float4*)(p.c_ln_g + l * 256 + cbase + 8 * g + 4 * lh);
      bl[g] = *(const float4*)(p.c_ln_b + l * 256 + cbase + 8 * g + 4 * lh);
    }
#pragma unroll
    for (int ti = 0; ti < 4; ti++) {
      const int t = ti * 32 + l32;
      const size_t row = (size_t)R0 + t;
      const float rsw = p.rsw[(l * 4 + h) * 128 + t];
      const float bs = p.c_bs[(l * 4 + h) * 128 + t];
#pragma unroll
      for (int g = 0; g < 4; g++) {
        const int d0 = cbase + 8 * g + 4 * lh;
        uint2 gc = *(const uint2*)(inter + row * IW + 1536 + d0);
        float y0 = __uint_as_float(gc.x << 16) * (gl[g].x * acc[ti][4 * g + 0] + bl[g].x * rsw + bs);
        float y1 = __uint_as_float(gc.x & 0xffff0000u) * (gl[g].y * acc[ti][4 * g + 1] + bl[g].y * rsw + bs);
        float y2 = __uint_as_float(gc.y << 16) * (gl[g].z * acc[ti][4 * g + 2] + bl[g].z * rsw + bs);
        float y3 = __uint_as_float(gc.y & 0xffff0000u) * (gl[g].w * acc[ti][4 * g + 3] + bl[g].w * rsw + bs);
        *(uint2*)(p.mix + row * DM + 768 + d0) = make_uint2(pack2(y0, y1), pack2(y2, y3));
      }
    }
  }
  __syncthreads();
}

__device__ void p2_s(const Params& p, int l, int n, float* red, float* smem_f) {
  const int tid = otid();
  const int lane = tid & 63, w = tid >> 6;
  const int c = tid;
  const size_t Rs = NPR + (size_t)n * 4;
  const u16* __restrict__ inter = p.inter;
  float rv[16];
#pragma unroll
  for (int i = 0; i < 16; i++) rv[i] = 0.f;
  float o[4] = {0.f, 0.f, 0.f, 0.f};
  float zin[6] = {0.f, 0.f, 0.f, 0.f, 0.f, 0.f};
  float cvv[4] = {0.f, 0.f, 0.f, 0.f};
  if (c < 384) {
    float in[34], wv[31];
    const float* sa = p.state_a + ((size_t)(l * 128 + n) * 30) * 384 + c;
    float* so = p.out + O_SAS + ((size_t)(l * 128 + n) * 30) * 384 + c;
#pragma unroll
    for (int i = 0; i < 30; i++) in[i] = sa[i * 384];
#pragma unroll
    for (int t = 0; t < 4; t++) in[30 + t] = bf2f(inter[(Rs + t) * IW + c]);
#pragma unroll
    for (int j = 0; j < 31; j++) wv[j] = p.a_conv_w[(l * 31 + j) * 384 + c];
    const float bias = p.a_conv_b[l * 384 + c];
#pragma unroll
    for (int i = 0; i < 30; i++) so[i * 384] = in[4 + i];
#pragma unroll
    for (int t = 0; t < 4; t++) o[t] = bias;
#pragma unroll
    for (int j = 0; j < 31; j++) {
#pragma unroll
      for (int t = 0; t < 4; t++) o[t] += wv[j] * in[t + j];
    }
#pragma unroll
    for (int t = 0; t < 4; t++) { rv[t] = o[t]; rv[4 + t] = o[t] * o[t]; }
    const float* sb = p.state_b + ((size_t)(l * 128 + n) * 2) * 384 + c;
    zin[0] = sb[0]; zin[1] = sb[384];
#pragma unroll
    for (int t = 0; t < 4; t++) zin[2 + t] = bf2f(inter[(Rs + t) * IW + 768 + c]);
  }
  if (c < 256) {
#pragma unroll
    for (int t = 0; t < 4; t++) {
      cvv[t] = bf2f(inter[(Rs + t) * IW + 1792 + c]);
      rv[8 + t] = cvv[t];
      rv[12 + t] = cvv[t] * cvv[t];
    }
  }
#pragma unroll
  for (int i = 0; i < 16; i++) {
#pragma unroll
    for (int m = 32; m >= 1; m >>= 1) rv[i] += __shfl_xor(rv[i], m);
  }
  if (lane == 0) {
#pragma unroll
    for (int i = 0; i < 16; i++) red[w * 16 + i] = rv[i];
  }
  __syncthreads();
#pragma unroll
  for (int i = 0; i < 16; i++) {
    float s = 0.f;
#pragma unroll
    for (int ww = 0; ww < 8; ww++) s += red[ww * 16 + i];
    rv[i] = s;
  }
  if (c < 384) {
    const float g = p.a_ln_g[l * 384 + c], bb = p.a_ln_b[l * 384 + c];
    const float w0 = p.b_conv_w[(l * 3 + 0) * 384 + c], w1 = p.b_conv_w[(l * 3 + 1) * 384 + c], w2 = p.b_conv_w[(l * 3 + 2) * 384 + c];
#pragma unroll
    for (int t = 0; t < 4; t++) {
      float m_ = rv[t] * (1.f / 384.f);
      float var = rv[4 + t] * (1.f / 384.f) - m_ * m_;
      float rstd = rsqrtf(fmaxf(var, 0.f) + EPS);
      float y = (o[t] - m_) * rstd * g + bb;
      float ya = siluf_(y) * bf2f(inter[(Rs + t) * IW + 384 + c]);
      p.mix[(Rs + t) * DM + c] = f2bf(ya);
      float cv = w0 * zin[t] + w1 * zin[t + 1] + w2 * zin[t + 2];
      float yb = bf2f(inter[(Rs + t) * IW + 1152 + c]) * cv;
      p.mix[(Rs + t) * DM + 384 + c] = f2bf(yb);
    }
    p.out[O_SBS + ((size_t)(l * 128 + n) * 2 + 0) * 384 + c] = zin[4];
    p.out[O_SBS + ((size_t)(l * 128 + n) * 2 + 1) * 384 + c] = zin[5];
  }
  if (c < 256) {
    const float g = p.c_ln_g[l * 256 + c], bb = p.c_ln_b[l * 256 + c];
    const int h = c >> 6;
    float vn[4];
#pragma unroll
    for (int t = 0; t < 4; t++) {
      float m_ = rv[8 + t] * (1.f / 256.f);
      float var = rv[12 + t] * (1.f / 256.f) - m_ * m_;
      float rstd = rsqrtf(fmaxf(var, 0.f) + EPS);
      vn[t] = (cvv[t] - m_) * rstd * g + bb;
      p.out[O_SCV + ((size_t)(l * 128 + n) * 4 + t) * 256 + c] = vn[t];
    }
#pragma unroll
    for (int t = 0; t < 4; t++) {
      float acc = p.c_bs[(l * 4 + h) * 128 + t];
#pragma unroll
      for (int s = 0; s < 4; s++)
        if (s <= t) acc += p.c_ws[((size_t)(l * 4 + h) * 128 + t) * 128 + s] * vn[s];
      float yc = bf2f(inter[(Rs + t) * IW + 1536 + c]) * acc;
      p.mix[(Rs + t) * DM + 768 + c] = f2bf(yc);
    }
  }
  __syncthreads();
}

__device__ void phase2(const Params& p, int l, char* smem) {
  float* red = (float*)(smem + 90112);
  const int nb = gridDim.x, b = blockIdx.x;
  p2_stage_w(p, l, smem);
  {
    ATileRegs A;
    if (b < 512) p2_ab_load(p, b, A);
#pragma unroll 1
    for (int it = b; it < 512; it += nb) {
      p2_ab_store(A, smem);
      __syncthreads();
      const int nx = (it + nb < 512) ? it + nb : it;
      p2_ab_load(p, nx, A);
      p2_ab(p, l, it, smem);
    }
  }
  for (int it = b; it < 128; it += nb) {
    asm volatile("" ::: "memory");
    p2_c(p, l, it, smem);
  }
  for (int it = (b + nb - (128 % nb)) % nb; it < 128; it += nb) {
    asm volatile("" ::: "memory");
    p2_s(p, l, it, red, (float*)smem);
  }
}

__device__ void phase4(const Params& p) {
  const int tid = otid();
  const float* ssq = p.sumsq + (size_t)2 * NTOK;
  for (int idx = blockIdx.x * NT + tid; idx < NTOK * 128; idx += gridDim.x * NT) {
    const int row = idx >> 7, c8 = idx & 127;
    uint4 v = *(const uint4*)(p.xb + (size_t)row * DM + c8 * 8);
    const float rs = rsqrtf(ssq[row] * (1.f / 1024.f) + EPS);
    float4 g0 = *(const float4*)(p.final_g + c8 * 8), g1 = *(const float4*)(p.final_g + c8 * 8 + 4);
    float f[8];
    unpack8(v, f);
    float* o = p.out + (size_t)row * DM + c8 * 8;
    *(float4*)o = make_float4(f[0] * rs * g0.x, f[1] * rs * g0.y, f[2] * rs * g0.z, f[3] * rs * g0.w);
    *(float4*)(o + 4) = make_float4(f[4] * rs * g1.x, f[5] * rs * g1.y, f[6] * rs * g1.z, f[7] * rs * g1.w);
  }
}

#define CEN_WORD(j) (XCD_BAR_WORDS + 64 * (j))
#define BAR_TOTAL_WORDS (XCD_BAR_WORDS + 64 * 16)
__global__ void __launch_bounds__(NT) fwd_megakernel(Params p) {
  extern __shared__ __attribute__((aligned(16))) char smem[];
  __shared__ uint4 xb_words;
  __shared__ uint4 sched_words;
  if (threadIdx.x == 0) {
    xb_words = make_uint4(0u, 0u, 0u, 0u);
    const unsigned x = xb_xcc_id();
    const unsigned slot = xb_add(&p.bar[CEN_WORD(x)], 1u);
    sched_words = make_uint4(slot, 1u, 0u, gridDim.x);
  }
  __syncthreads();
  XcdBarrier gb = xcd_barrier_post(p.bar, (volatile LAS unsigned*)&xb_words);
  const volatile LAS unsigned* sched = (const volatile LAS unsigned*)&sched_words;
  phase0(p, smem);
  xcd_barrier(gb);
  if (threadIdx.x == 0) {
    const unsigned x = xb_xcc_id();
    unsigned prefix = 0u, mine = 1u;
#pragma unroll
    for (unsigned j = 0; j < 16; ++j) {
      const unsigned c = xb_ld(&p.bar[CEN_WORD(j)]);
      prefix += (j < x) ? c : 0u;
      mine = (j == x) ? c : mine;
    }
    volatile LAS unsigned* sw = (volatile LAS unsigned*)&sched_words;
    sw[1] = mine;
    sw[2] = prefix;
  }
  __syncthreads();
#pragma unroll 1
  for (int l = 0; l < 2; l++) {
    phase1(p, l, smem);
    xcd_barrier(gb);
    phase2(p, l, smem);
    xcd_barrier(gb);
    phase3(p, l, smem);
    xcd_barrier(gb);
  }
  phase4(p);
}

extern "C" void kernel_launch(void* const* d_in, const int* in_sizes, int n_in, void* d_out, int out_size, void* d_ws,
                              size_t ws_size, hipStream_t stream) {
  static int grid_blocks = 0;
  if (!grid_blocks) {
    int dev = 0, cus = 0, per_cu = 0;
    hipGetDevice(&dev);
    hipDeviceGetAttribute(&cus, hipDeviceAttributeMultiprocessorCount, dev);
    hipFuncSetAttribute((const void*)fwd_megakernel, hipFuncAttributeMaxDynamicSharedMemorySize, LDS_BYTES);
    hipOccupancyMaxActiveBlocksPerMultiprocessor(&per_cu, (const void*)fwd_megakernel, NT, LDS_BYTES);
    if (per_cu < 1) { fprintf(stderr, "occupancy query returned %d\n", per_cu); per_cu = 1; }
    if (per_cu > 1) per_cu = 1;
    grid_blocks = cus * per_cu;
  }
  Params p{};
  p.x_prompt = (const float*)d_in[0];
  p.x_sample = (const float*)d_in[1];
  p.state_a = (const float*)d_in[2];
  p.state_b = (const float*)d_in[3];
  p.norm_g = (const float*)d_in[4];
  p.w_in = (const float*)d_in[5];
  p.a_conv_w = (const float*)d_in[6];
  p.a_conv_b = (const float*)d_in[7];
  p.a_ln_g = (const float*)d_in[8];
  p.a_ln_b = (const float*)d_in[9];
  p.b_conv_w = (const float*)d_in[10];
  p.c_ln_g = (const float*)d_in[11];
  p.c_ln_b = (const float*)d_in[12];
  p.c_ws = (const float*)d_in[13];
  p.c_bs = (const float*)d_in[14];
  p.w_out = (const float*)d_in[15];
  p.final_g = (const float*)d_in[16];
  p.out = (float*)d_out;
  char* ws = (char*)d_ws;
  size_t off = 0;
  auto take = [&](size_t bytes) { char* r = ws + off; off += (bytes + 255) & ~(size_t)255; return r; };
  p.win_b = (u16*)take((size_t)2 * 3584 * DM * 2);
  p.wout_b = (u16*)take((size_t)2 * DM * DM * 2);
  p.wc_b = (u16*)take((size_t)2 * 4 * 128 * 128 * 2);
  p.xb = (u16*)take((size_t)NTOK * DM * 2);
  p.inter = (u16*)take((size_t)NTOK * IW * 2);
  p.mix = (u16*)take((size_t)NTOK * DM * 2);
  p.sumsq = (float*)take((size_t)3 * NTOK * 4);
  p.rsw = (float*)take((size_t)2 * 4 * 128 * 4);
  p.bar = (unsigned*)take((size_t)BAR_TOTAL_WORDS * 4);
  hipMemsetAsync(p.bar, 0, (size_t)BAR_TOTAL_WORDS * 4, stream);
  void* args[] = {&p};
  hipError_t e = hipLaunchCooperativeKernel((const void*)fwd_megakernel, dim3(grid_blocks), dim3(NT), args, LDS_BYTES, stream);
  if (e != hipSuccess) fprintf(stderr, "cooperative launch failed: %s (grid %d)\n", hipGetErrorString(e), grid_blocks);
}
```

```cpp
#include <hip/hip_runtime.h>
#include <cstdio>
#include <cstdint>
#include <type_traits>

typedef unsigned short u16;
typedef short bf16x8 __attribute__((ext_vector_type(8)));
typedef float f32x16 __attribute__((ext_vector_type(16)));
typedef unsigned int u32x4 __attribute__((ext_vector_type(4)));

constexpr int NTOK = 16896, NPR = 16384, DM = 1024, INW = 3456, IW = 2048;
constexpr int NT = 512;
constexpr int INWP = 3584;
constexpr int LDS_BYTES = 131072;
constexpr float EPS = 1e-6f;

constexpr size_t O_SAP = 17301504, O_SBP = 17485824, O_SAS = 17498112, O_SBS = 20447232, O_SCV = 20643840;

struct Params {
  const float *x_prompt, *x_sample, *state_a, *state_b, *norm_g, *w_in, *a_conv_w, *a_conv_b, *a_ln_g, *a_ln_b,
      *b_conv_w, *c_ln_g, *c_ln_b, *c_ws, *c_bs, *w_out, *final_g;
  float* out;
  u16 *win_b, *wout_b, *wc_b, *xb, *inter, *mix;
  float *sumsq, *rsw;
  unsigned* bar;
};

__device__ __forceinline__ u16 f2bf(float f) {
  unsigned u = __float_as_uint(f);
  u += 0x7fffu + ((u >> 16) & 1u);
  return (u16)(u >> 16);
}
__device__ __forceinline__ float bf2f(u16 h) { return __uint_as_float(((unsigned)h) << 16); }
__device__ __forceinline__ unsigned pack2(float a, float b) {
  unsigned r;
  asm volatile("v_cvt_pk_bf16_f32 %0, %1, %2" : "=v"(r) : "v"(a), "v"(b));
  return r;
}
__device__ __forceinline__ float sigmoidf_(float x) { return __builtin_amdgcn_rcpf(1.f + __builtin_amdgcn_exp2f(-1.44269504f * x)); }
__device__ __forceinline__ float siluf_(float x) { return x * __builtin_amdgcn_rcpf(1.f + __builtin_amdgcn_exp2f(-1.44269504f * x)); }

__device__ __forceinline__ void unpack8(const uint4& v, float (&f)[8]) {
  f[0] = __uint_as_float(v.x << 16); f[1] = __uint_as_float(v.x & 0xffff0000u);
  f[2] = __uint_as_float(v.y << 16); f[3] = __uint_as_float(v.y & 0xffff0000u);
  f[4] = __uint_as_float(v.z << 16); f[5] = __uint_as_float(v.z & 0xffff0000u);
  f[6] = __uint_as_float(v.w << 16); f[7] = __uint_as_float(v.w & 0xffff0000u);
}
__device__ __forceinline__ uint4 pack8(const float (&f)[8]) {
  uint4 o;
  o.x = pack2(f[0], f[1]); o.y = pack2(f[2], f[3]); o.z = pack2(f[4], f[5]); o.w = pack2(f[6], f[7]);
  return o;
}

__device__ __forceinline__ __amdgpu_buffer_rsrc_t mk_rsrc(void* base, unsigned bytes) {
  return __builtin_amdgcn_make_buffer_rsrc(base, 0, bytes, 0x00020000);
}
__device__ __forceinline__ void st16_wt(__amdgpu_buffer_rsrc_t r, unsigned byte_off, const uint4& v) {
  u32x4 d = {v.x, v.y, v.z, v.w};
  __builtin_amdgcn_raw_buffer_store_b128(d, r, byte_off, 0, 16);
}

__device__ __forceinline__ int otid() {
  int t = threadIdx.x;
  asm volatile("" : "+v"(t));
  return t;
}

__device__ __forceinline__ int vcol_src(int vc);

#define XB_TMO      128
#define XB_XCNT(j)  (256  + 64 * (j))
#define XB_XSUB(j)  (1280 + 64 * (j))
#define XB_XGEN(j)  (2304 + 64 * (j))
#define XB_TOP      3328
#define XB_TOPGEN   3392
#define XCD_BAR_WORDS 3456
#define XB_SPIN_CAP (1u << 18)
#define LAS __attribute__((address_space(3)))

__device__ __forceinline__ unsigned xb_ld(unsigned* p)              { return __hip_atomic_load(p, __ATOMIC_RELAXED, __HIP_MEMORY_SCOPE_AGENT); }
__device__ __forceinline__ unsigned xb_add(unsigned* p, unsigned v) { return __hip_atomic_fetch_add(p, v, __ATOMIC_RELAXED, __HIP_MEMORY_SCOPE_AGENT); }
__device__ __forceinline__ unsigned xb_xcc_id() { return (unsigned)__builtin_amdgcn_s_getreg((3 << 11) | 20) & 0xFu; }
#define XB_SPIN(cond, bar) do { unsigned _sp = 0; while (cond) { __builtin_amdgcn_s_sleep(1); \
    if ((++_sp & 255u) == 0u) { if (xb_ld(&(bar)[XB_TMO])) break; if (_sp > XB_SPIN_CAP) { atomicAdd(&(bar)[XB_TMO], 1u); break; } } } } while (0)

struct XcdBarrier {
  unsigned* bar; unsigned x;
  volatile LAS unsigned* st;
};
__device__ __forceinline__ XcdBarrier xcd_barrier_post(unsigned* bar, volatile LAS unsigned* st) {
  XcdBarrier b; b.bar = bar; b.x = xb_xcc_id(); b.st = st;
  if (threadIdx.x == 0) (void)xb_add(&bar[XB_XCNT(b.x)], 1u);
  return b;
}
__device__ __forceinline__ void xcd_barrier_complete(unsigned* bar, unsigned x, unsigned& nloc, unsigned& nx) {
  const unsigned G = gridDim.x * gridDim.y * gridDim.z;
  unsigned sum, cnt, mine, sp = 0u;
  for (;;) {
    sum = 0u; cnt = 0u; mine = 0u;
#pragma unroll
    for (unsigned j = 0; j < 16; ++j) { const unsigned c = xb_ld(&bar[XB_XCNT(j)]); sum += c; cnt += (c > 0u) ? 1u : 0u; mine = (j == x) ? c : mine; }
    if (sum == G) break;
    __builtin_amdgcn_s_sleep(1);
    if ((++sp & 255u) == 0u) { if (xb_ld(&bar[XB_TMO])) break; if (sp > XB_SPIN_CAP) { atomicAdd(&bar[XB_TMO], 1u); break; } }
  }
  nloc = mine > 0u ? mine : 1u; nx = cnt > 0u ? cnt : 1u;
}
__device__ __forceinline__ void xcd_barrier(const XcdBarrier& b) {
  asm volatile("s_waitcnt vmcnt(0)" ::: "memory");
  __syncthreads();
  if (threadIdx.x == 0) {
    unsigned* bar = b.bar;
    __builtin_amdgcn_s_waitcnt(0);
    unsigned nloc = b.st[0], nx = b.st[1];
    if (nloc == 0u) { xcd_barrier_complete(bar, b.x, nloc, nx); b.st[0] = nloc; b.st[1] = nx; }
    const unsigned old = xb_add(&bar[XB_XSUB(b.x)], 1u);
    const unsigned gen = old / nloc;
    if (old + 1u == (gen + 1u) * nloc) {
      __builtin_amdgcn_fence(__ATOMIC_RELEASE, "agent");
      asm volatile("s_waitcnt vmcnt(0)" ::: "memory");
      const unsigned og = xb_add(&bar[XB_TOP], 1u);
      const unsigned tg = og / nx;
      if (og + 1u == (tg + 1u) * nx) xb_add(&bar[XB_TOPGEN], 1u);
      else XB_SPIN(xb_ld(&bar[XB_TOPGEN]) == tg, bar);
      __builtin_amdgcn_fence(__ATOMIC_ACQUIRE, "agent");
      xb_add(&bar[XB_XGEN(b.x)], 1u);
      asm volatile("s_waitcnt vmcnt(0)" ::: "memory");
    } else {
      XB_SPIN(xb_ld(&bar[XB_XGEN(b.x)]) == gen, bar);
      __builtin_amdgcn_fence(__ATOMIC_ACQUIRE, "agent");
      asm volatile("s_waitcnt vmcnt(0)" ::: "memory");
    }
  }
  __syncthreads();
}

__device__ void p0_transpose(const float* __restrict__ W, int ncols, const float* __restrict__ g, u16* __restrict__ outp,
                             int k0, int v0, bool mapv, float* tile) {
  int tid = otid();
  float vals[16];
#pragma unroll
  for (int i = 0; i < 16; i++) {
    int e = tid + i * NT;
    int kk = e >> 7, v = e & 127;
    int src = mapv ? vcol_src(v0 + v) : (v0 + v);
    float val = 0.f;
    if (src >= 0) val = __builtin_nontemporal_load(W + (size_t)(k0 + kk) * ncols + src);
    vals[i] = val;
  }
#pragma unroll
  for (int i = 0; i < 16; i++) {
    int e = tid + i * NT;
    int kk = e >> 7, v = e & 127;
    float val = vals[i];
    if (g) val *= g[k0 + kk];
    tile[kk * 129 + v] = val;
  }
  __syncthreads();
#pragma unroll
  for (int h = 0; h < 2; h++) {
    int v = (tid >> 3) + h * 64, kq = tid & 7;
    const float* tp = tile + (kq * 8) * 129 + v;
    uint4 o;
    o.x = pack2(tp[0], tp[129]);
    o.y = pack2(tp[2 * 129], tp[3 * 129]);
    o.z = pack2(tp[4 * 129], tp[5 * 129]);
    o.w = pack2(tp[6 * 129], tp[7 * 129]);
    *(uint4*)(outp + (size_t)(v0 + v) * 1024 + k0 + kq * 8) = o;
  }
  __syncthreads();
}

__device__ void p0_weights(const Params& p, int l, int rank, int nranks, float* tile) {
  for (int it = rank; it < 16 * 28; it += nranks) {
    int kb = it / 28, vb = it % 28;
    p0_transpose(p.w_in + (size_t)l * DM * INW, INW, p.norm_g + l * DM, p.win_b + (size_t)l * INWP * DM, kb * 64, vb * 128, true, tile);
  }
  for (int it = rank; it < 16 * 8; it += nranks) {
    int kb = it >> 3, vb = it & 7;
    p0_transpose(p.w_out + (size_t)l * DM * DM, DM, nullptr, p.wout_b + (size_t)l * DM * DM, kb * 64, vb * 128, false, tile);
  }
}

__device__ void phase0(const Params& p, char* smem) {
  float* tile = (float*)smem;
  int nb = gridDim.x, b = blockIdx.x, tid = otid();
  const int wave = tid >> 6, lane = tid & 63;
  for (int e = b * NT + tid; e < 2 * NTOK; e += nb * NT) p.sumsq[NTOK + e] = 0.f;
  for (int e = b * NT + tid; e < 2 * 4 * 128 * 128; e += nb * NT) {
    int s = e & 127, t = (e >> 7) & 127;
    p.wc_b[e] = (s <= t) ? f2bf(p.c_ws[e]) : (u16)0;
  }
  for (int r = b * 8 + wave; r < 2 * 4 * 128; r += nb * 8) {
    const int t = r & 127;
    const float* wr = p.c_ws + (size_t)r * 128;
    float s = 0.f;
    if (lane <= t) s += bf2f(f2bf(wr[lane]));
    if (lane + 64 <= t) s += bf2f(f2bf(wr[lane + 64]));
#pragma unroll
    for (int m = 32; m >= 1; m >>= 1) s += __shfl_xor(s, m);
    if (lane == 0) p.rsw[r] = s;
  }
  const bool wfirst = (b & 1) != 0;
  if (wfirst) p0_weights(p, 0, b, nb, tile);
  for (int row = (b * 8 + wave) * 2; row < NTOK; row += nb * 16) {
    const float* xr0 = (row < NPR) ? (p.x_prompt + (size_t)row * DM) : (p.x_sample + (size_t)(row - NPR) * DM);
    const float* xr1 = xr0 + DM;
    float4 v0[4], v1[4];
#pragma unroll
    for (int j = 0; j < 4; j++) {
      typedef float f4v __attribute__((ext_vector_type(4)));
      f4v a = __builtin_nontemporal_load((const f4v*)(xr0 + (j * 64 + lane) * 4));
      f4v c = __builtin_nontemporal_load((const f4v*)(xr1 + (j * 64 + lane) * 4));
      v0[j] = make_float4(a.x, a.y, a.z, a.w);
      v1[j] = make_float4(c.x, c.y, c.z, c.w);
    }
    float s0 = 0.f, s1 = 0.f;
#pragma unroll
    for (int j = 0; j < 4; j++) {
      s0 += v0[j].x * v0[j].x + v0[j].y * v0[j].y + v0[j].z * v0[j].z + v0[j].w * v0[j].w;
      s1 += v1[j].x * v1[j].x + v1[j].y * v1[j].y + v1[j].z * v1[j].z + v1[j].w * v1[j].w;
      *(uint2*)(p.xb + (size_t)row * DM + (j * 64 + lane) * 4) = make_uint2(pack2(v0[j].x, v0[j].y), pack2(v0[j].z, v0[j].w));
      *(uint2*)(p.xb + (size_t)(row + 1) * DM + (j * 64 + lane) * 4) = make_uint2(pack2(v1[j].x, v1[j].y), pack2(v1[j].z, v1[j].w));
    }
#pragma unroll
    for (int m = 32; m >= 1; m >>= 1) { s0 += __shfl_xor(s0, m); s1 += __shfl_xor(s1, m); }
    if (lane == 0) { p.sumsq[row] = s0; p.sumsq[row + 1] = s1; }
  }
  if (!wfirst) p0_weights(p, 0, b, nb, tile);
}

namespace pg8 {
#define PG8_LAS __attribute__((address_space(3)))
typedef unsigned short bf16_t;
typedef short bf16x8 __attribute__((ext_vector_type(8)));
typedef float f32x4 __attribute__((ext_vector_type(4)));
typedef unsigned u32x4 __attribute__((ext_vector_type(4)));
constexpr int BM = 256, BK = 64, HALF = 128, HTB = HALF * BK * 2  , STAGE_BYTES = 8 * HTB, NXCD = 8, WGM = 8;

__host__ __device__ __forceinline__ int lds_byte(int r, int c) { const int st = (r >> 4) * 2 + (c >> 5), rr = r & 15, cc = c & 31, ob = rr * 64 + cc * 2; return st * 1024 + (ob ^ (((ob >> 9) & 1) << 5)); }
__host__ __device__ __forceinline__ void stage_rc(int b, int& R, int& C) { const int st = b / 1024, sb = b % 1024, swz = sb ^ (((sb >> 9) & 1) << 5); R = (st >> 1) * 16 + swz / 64; C = (st & 1) * 32 + (swz % 64) / 2; }
__host__ __device__ __forceinline__ int perm32(int rho) { const int n = rho >> 4, i = rho & 15; return 8 * (i >> 2) + 4 * n + (i & 3); }

struct Unit { int pm, pn; };
struct Gemm { const bf16_t* A; const bf16_t* Bt; int M, N, K; };

struct StaticOrder {
    int nM, nN, nwg, G, c;
    __host__ __device__ void init(int M, int N, int G_, int c_) { nM = M / BM; nN = N / BM; nwg = nM * nN; G = G_; c = c_; }
    __host__ __device__ bool next(int i, Unit& u) const {
        const long L = (long)i * G + c; if (L >= nwg) return false;
        int wgid = (int)L; { const int q = nwg / NXCD, r = nwg % NXCD, xcd = wgid % NXCD, off = wgid / NXCD; wgid = (xcd < r ? xcd * (q + 1) : r * (q + 1) + (xcd - r) * q) + off; }
        const int nig = WGM * nN, gid = wgid / nig, fm = gid * WGM, gsz = (nM - fm) < WGM ? (nM - fm) : WGM;
        u.pm = fm + ((wgid % nig) % gsz); u.pn = (wgid % nig) / gsz; return true;
    }
    __device__ __forceinline__ void a_ready(const Unit&) const {}
    __device__ __forceinline__ void done(const Unit&) const {}
};
__device__ __forceinline__ unsigned cvt_pk_bf16(float lo, float hi) { unsigned r; asm volatile("v_cvt_pk_bf16_f32 %0, %1, %2" : "=v"(r) : "v"(lo), "v"(hi)); return r; }
template <class Epi, class Sched, bool STAMP = false>
__device__ __forceinline__ void gemm_phase(PG8_LAS unsigned char* lds, const Gemm g, const Sched& S, const Epi& E, unsigned long long* stamps) {
    const int tid = otid(), wid = __builtin_amdgcn_readfirstlane(tid >> 6), lane = tid & 63, wr = wid >> 2, wc = wid & 3, fr = lane & 15, fq = lane >> 4;
    const int K = g.K, nt = K / BK;
    int ts_lo = 0, ts_hi = 0, nts = 0; const unsigned long long rt_entry = STAMP ? (unsigned long long)wall_clock64() : 0ull;
#define PG8_STAMP() do { if (STAMP && wid == 0 && nts < 64) { const unsigned long long _c = (unsigned long long)clock64(); \
        ts_lo = (lane == nts) ? (int)(unsigned)_c : ts_lo; ts_hi = (lane == nts) ? (int)(unsigned)(_c >> 32) : ts_hi; ++nts; } } while (0)
    PG8_STAMP();
    unsigned voffA[2], voffB[2];
#pragma unroll
    for (int i = 0; i < 2; ++i) { int R, C; stage_rc(tid * 16 + i * 8192, R, C); const int Rb = Epi::PERM ? ((R & ~31) + perm32(R & 31)) : R;
        voffA[i] = (unsigned)(R * K + C) * 2u; voffB[i] = (unsigned)(Rb * K + C) * 2u; }
    const size_t kstep = (size_t)(BK * 2);
    const size_t hstep = (size_t)HALF * K * 2;
    const size_t tstep = 2 * hstep;
    const unsigned ldsw = (unsigned)wid * 1024u;
    const int aoff = lds_byte(wr * 64 + fr, fq * 8), boff = lds_byte(wc * 32 + fr, fq * 8);
#define PG8_SA(b, h) (((b) * 2 + (h)) * HTB)
#define PG8_SB(b, h) ((4 + (b) * 2 + (h)) * HTB)
#define PG8_STAGE(bufoff, gbase, voff) do { _Pragma("unroll") for (int _i = 0; _i < 2; ++_i) \
        __builtin_amdgcn_global_load_lds((const unsigned*)((const char*)(gbase) + (voff)[_i]), (PG8_LAS unsigned*)(lds + (bufoff) + ldsw + _i * 8192), 16, 0, 0); } while (0)
#define PG8_LDA(dst, b, h) do { _Pragma("unroll") for (int m = 0; m < 4; ++m) _Pragma("unroll") for (int k = 0; k < 2; ++k) dst[m][k] = *(const PG8_LAS bf16x8*)(lds + PG8_SA(b, h) + aoff + m * 2048 + k * 1024); } while (0)
#define PG8_LDB(dst, b, h) do { _Pragma("unroll") for (int n = 0; n < 2; ++n) _Pragma("unroll") for (int k = 0; k < 2; ++k) dst[n][k] = *(const PG8_LAS bf16x8*)(lds + PG8_SB(b, h) + boff + n * 2048 + k * 1024); } while (0)
#define PG8_MMA(ai, bj, At, Bt) do { __builtin_amdgcn_s_setprio(1); _Pragma("unroll") for (int m = 0; m < 4; ++m) _Pragma("unroll") for (int n = 0; n < 2; ++n) _Pragma("unroll") for (int k = 0; k < 2; ++k) \
        acc[ai][bj][m][n] = __builtin_amdgcn_mfma_f32_16x16x32_bf16(Bt[n][k], At[m][k], acc[ai][bj][m][n], 0, 0, 0); __builtin_amdgcn_s_setprio(0); } while (0)
#define PG8_WAIT_V(n) asm volatile("s_waitcnt vmcnt(" #n ")" ::: "memory")
#define PG8_WAIT_L(n) asm volatile("s_waitcnt lgkmcnt(" #n ")" ::: "memory")
#define PG8_BAR __builtin_amdgcn_s_barrier()
#define PG8_SCHED __builtin_amdgcn_sched_barrier(0)
    Unit cur, nxt; int ui = 0;
    if (!S.next(0, cur)) return;
    f32x4 acc[2][2][4][2];
#pragma unroll
    for (int a = 0; a < 2; ++a)
#pragma unroll
        for (int b = 0; b < 2; ++b)
#pragma unroll
            for (int m = 0; m < 4; ++m)
#pragma unroll
                for (int n = 0; n < 2; ++n) acc[a][b][m][n] = (f32x4){0.f, 0.f, 0.f, 0.f};
    bf16x8 At[4][2], B0[2][2], B1[2][2];
    const char* cA = (const char*)g.A + (size_t)cur.pm * tstep; const char* cB = (const char*)g.Bt + (size_t)cur.pn * tstep;
    typename Epi::Pre pre;
    E.preload(cur, wr, fr, pre);
    S.a_ready(cur);
    PG8_STAGE(PG8_SB(0, 0), cB, voffB); PG8_STAGE(PG8_SA(0, 0), cA, voffA); PG8_STAGE(PG8_SB(0, 1), cB + hstep, voffB); PG8_STAGE(PG8_SA(0, 1), cA + hstep, voffA);
    if (wr == 1) PG8_BAR;
    PG8_WAIT_V(4); PG8_BAR;
    PG8_STAGE(PG8_SB(1, 0), cB + kstep, voffB); PG8_STAGE(PG8_SA(1, 0), cA + kstep, voffA); PG8_STAGE(PG8_SB(1, 1), cB + hstep + kstep, voffB);
    PG8_WAIT_V(6); PG8_BAR;
    PG8_STAMP();
    for (;;) {
        const bool has_next = S.next(ui + 1, nxt);
        const char* nA = has_next ? (const char*)g.A + (size_t)nxt.pm * tstep : cA; const char* nB = has_next ? (const char*)g.Bt + (size_t)nxt.pn * tstep : cB;
        for (int t = 0; t < nt; t += 2) {
            const bool last = (t == nt - 2);
            const char* a1 = cA + (size_t)(t + 1) * kstep;
            const char* a2 = last ? nA : cA + (size_t)(t + 2) * kstep; const char* b2 = last ? nB : cB + (size_t)(t + 2) * kstep;
            const char* a3 = a2 + kstep; const char* b3 = b2 + kstep;
            if (last && has_next) S.a_ready(nxt);
            PG8_LDB(B0, 0, 0); PG8_SCHED; PG8_LDA(At, 0, 0); PG8_STAGE(PG8_SA(1, 1), a1 + hstep, voffA);
            PG8_WAIT_L(8); PG8_BAR; PG8_WAIT_L(0); PG8_MMA(0, 0, At, B0); PG8_BAR; PG8_SCHED;
            PG8_LDB(B1, 0, 1); PG8_STAGE(PG8_SB(0, 0), b2, voffB);
            PG8_BAR; PG8_WAIT_L(0); PG8_MMA(0, 1, At, B1); PG8_BAR;
            PG8_LDA(At, 0, 1); PG8_STAGE(PG8_SA(0, 0), a2, voffA);
            PG8_BAR; PG8_WAIT_L(0); PG8_MMA(1, 0, At, B0); PG8_BAR; PG8_SCHED;
            PG8_STAGE(PG8_SB(0, 1), b2 + hstep, voffB);
            PG8_WAIT_V(6); PG8_BAR; PG8_MMA(1, 1, At, B1); PG8_BAR;
            PG8_LDB(B0, 1, 0); PG8_SCHED; PG8_LDA(At, 1, 0); PG8_STAGE(PG8_SA(0, 1), a2 + hstep, voffA);
            PG8_WAIT_L(8); PG8_BAR; PG8_WAIT_L(0); PG8_MMA(0, 0, At, B0); PG8_BAR; PG8_SCHED;
            PG8_LDB(B1, 1, 1); PG8_STAGE(PG8_SB(1, 0), b3, voffB);
            PG8_BAR; PG8_WAIT_L(0); PG8_MMA(0, 1, At, B1); PG8_BAR;
            PG8_LDA(At, 1, 1); PG8_STAGE(PG8_SA(1, 0), a3, voffA);
            PG8_BAR; PG8_WAIT_L(0); PG8_MMA(1, 0, At, B0); PG8_BAR; PG8_SCHED;
            PG8_STAGE(PG8_SB(1, 1), b3 + hstep, voffB);
            PG8_WAIT_V(6); PG8_BAR; PG8_MMA(1, 1, At, B1); PG8_BAR;
        }
        PG8_STAMP();
        if constexpr (!Epi::AFTER_DRAIN) { E(acc, cur, wr, wc, fr, fq, pre); S.done(cur); }
        PG8_STAMP();
        if (!has_next) break;
#pragma unroll
        for (int a = 0; a < 2; ++a)
#pragma unroll
            for (int b = 0; b < 2; ++b)
#pragma unroll
                for (int m = 0; m < 4; ++m)
#pragma unroll
                    for (int n = 0; n < 2; ++n) acc[a][b][m][n] = (f32x4){0.f, 0.f, 0.f, 0.f};
        cur = nxt; cA = nA; cB = nB; ++ui;
        E.preload(cur, wr, fr, pre);
    }
    PG8_WAIT_V(0);
    if (wr == 0) PG8_BAR;
    PG8_BAR;
    if constexpr (Epi::AFTER_DRAIN) { E.fused(acc, cur, wr, wc, fr, fq, lds, wid, lane); S.done(cur); }
    PG8_STAMP();
    if (STAMP && wid == 0) { stamps[lane] = lane < nts ? (((unsigned long long)(unsigned)ts_hi << 32) | (unsigned)ts_lo) : 0ull;
        if (lane == 62) stamps[62] = rt_entry; if (lane == 63) stamps[63] = (unsigned long long)wall_clock64(); }
#undef PG8_STAMP
#undef PG8_SA
#undef PG8_SB
#undef PG8_STAGE
#undef PG8_LDA
#undef PG8_LDB
#undef PG8_MMA
#undef PG8_WAIT_V
#undef PG8_WAIT_L
#undef PG8_BAR
#undef PG8_SCHED
}
}


__device__ __forceinline__ int vcol_src(int vc) {
  const int un = vc >> 8, h = (vc >> 7) & 1, i = vc & 127;
  if (un < 3) return (h ? 384 : 0) + 128 * un + i;
  if (un < 6) return (h ? 1920 : 1152) + 128 * (un - 3) + i;
  if (un < 9) return (h ? 2304 : 1536) + 128 * (un - 6) + i;
  if (un < 11) return (h ? 3200 : 2688) + 128 * (un - 9) + i;
  if (un == 11) return 768 + 128 * h + i;
  if (un == 12) return h ? (2944 + i) : (768 + 256 + i);
  return h ? -1 : (2944 + 128 + i);
}

typedef float f32x4_ __attribute__((ext_vector_type(4)));
struct Epi1 {
  static constexpr bool PERM = true, AFTER_DRAIN = false;
  u16* inter; const float* ssq;
  struct Pre { float s[8]; };
  __device__ __forceinline__ void preload(const pg8::Unit& u, int wr, int fr, Pre& P) const {
#pragma unroll
    for (int ai = 0; ai < 2; ++ai)
#pragma unroll
      for (int m = 0; m < 4; ++m) P.s[ai * 4 + m] = ssq[u.pm * 256 + 64 * wr + fr + 128 * ai + 16 * m];
  }
  __device__ __forceinline__ void operator()(const pg8::f32x4 (&acc)[2][2][4][2], const pg8::Unit& u, int wr, int wc, int fr, int fq, const Pre& P) const {
    const int un = u.pn;
    int k0, ob0, k1 = -1, ob1 = 0;
    if (un < 3) { k0 = 0; ob0 = 128 * un; }
    else if (un < 6) { k0 = 2; ob0 = 768 + 128 * (un - 3); }
    else if (un < 9) { k0 = 3; ob0 = 1152 + 128 * (un - 6); }
    else if (un < 11) { k0 = 3; ob0 = 1536 + 128 * (un - 9); }
    else if (un == 11) { k0 = 1; ob0 = 384; k1 = 1; ob1 = 384 + 128; }
    else if (un == 12) { k0 = 1; ob0 = 384 + 256; k1 = 4; ob1 = 1792; }
    else { k0 = 4; ob0 = 1792 + 128; k1 = -2; }
    const int cl = 32 * wc + 8 * fq;
    const int rbase = u.pm * 256 + 64 * wr + fr;
    const __amdgpu_buffer_rsrc_t irs = mk_rsrc(inter, (unsigned)NTOK * IW * 2u);
    auto body = [&](auto K0c, auto K1c) {
      constexpr int K0 = decltype(K0c)::value, K1 = decltype(K1c)::value;
#pragma unroll
      for (int ai = 0; ai < 2; ++ai)
#pragma unroll
        for (int m = 0; m < 4; ++m) {
          const int row = rbase + 128 * ai + 16 * m;
          const float rs = rsqrtf(P.s[ai * 4 + m] * (1.f / 1024.f) + EPS);
          float a[8], b[8], o[8];
#pragma unroll
          for (int i = 0; i < 4; i++) {
            a[i] = acc[ai][0][m][0][i] * rs; a[4 + i] = acc[ai][0][m][1][i] * rs;
            b[i] = acc[ai][1][m][0][i] * rs; b[4 + i] = acc[ai][1][m][1][i] * rs;
          }
          const unsigned rpo = ((unsigned)row * IW + cl) * 2u;
          if (K1 == -1) {
#pragma unroll
            for (int i = 0; i < 8; i++) o[i] = (K0 == 0) ? a[i] * sigmoidf_(b[i]) : (K0 == 2) ? a[i] * b[i] : a[i] * siluf_(b[i]);
            st16_wt(irs, rpo + ob0 * 2u, pack8(o));
          } else {
#pragma unroll
            for (int i = 0; i < 8; i++) o[i] = (K0 == 1) ? siluf_(a[i]) : a[i];
            st16_wt(irs, rpo + ob0 * 2u, pack8(o));
            if (K1 != -2) {
#pragma unroll
              for (int i = 0; i < 8; i++) o[i] = (K1 == 1) ? siluf_(b[i]) : b[i];
              st16_wt(irs, rpo + ob1 * 2u, pack8(o));
            }
          }
        }
    };
    using std::integral_constant;
    if (k1 == -1) {
      if (k0 == 0) body(integral_constant<int, 0>{}, integral_constant<int, -1>{});
      else if (k0 == 2) body(integral_constant<int, 2>{}, integral_constant<int, -1>{});
      else body(integral_constant<int, 3>{}, integral_constant<int, -1>{});
    } else if (k1 == 1) body(integral_constant<int, 1>{}, integral_constant<int, 1>{});
    else if (k1 == 4) body(integral_constant<int, 1>{}, integral_constant<int, 4>{});
    else body(integral_constant<int, 4>{}, integral_constant<int, -2>{});
  }
};
struct Epi2 {
  static constexpr bool PERM = true, AFTER_DRAIN = false;
  u16* xb; float* ssq;
  struct Pre {};
  __device__ __forceinline__ void preload(const pg8::Unit&, int, int, Pre&) const {}
  __device__ __forceinline__ void operator()(const pg8::f32x4 (&acc)[2][2][4][2], const pg8::Unit& u, int wr, int wc, int fr, int fq, const Pre&) const {
    const int cl = u.pn * 256 + 32 * wc + 8 * fq;
    const __amdgpu_buffer_rsrc_t xrs = mk_rsrc(xb, (unsigned)NTOK * DM * 2u);
#pragma unroll
    for (int ai = 0; ai < 2; ++ai)
#pragma unroll
      for (int m = 0; m < 4; ++m) {
        const int row = u.pm * 256 + 128 * ai + 64 * wr + 16 * m + fr;
        u16* rp = xb + (size_t)row * DM + cl;
        uint4 o0 = *(const uint4*)(rp), o1 = *(const uint4*)(rp + 128);
        float x0[8], x1[8];
        unpack8(o0, x0);
        unpack8(o1, x1);
        float ss = 0.f;
#pragma unroll
        for (int i = 0; i < 4; i++) {
          x0[i] += acc[ai][0][m][0][i]; x0[4 + i] += acc[ai][0][m][1][i];
          x1[i] += acc[ai][1][m][0][i]; x1[4 + i] += acc[ai][1][m][1][i];
        }
#pragma unroll
        for (int i = 0; i < 8; i++) ss += x0[i] * x0[i] + x1[i] * x1[i];
        const unsigned xo = ((unsigned)row * DM + cl) * 2u;
        st16_wt(xrs, xo, pack8(x0));
        st16_wt(xrs, xo + 256u, pack8(x1));
        ss += __shfl_xor(ss, 16);
        ss += __shfl_xor(ss, 32);
        if (fq == 0) atomicAdd(ssq + row, ss);
      }
  }
};

__device__ void phase1(const Params& p, int l, char* smem) {
  pg8::Gemm g{p.xb, p.win_b + (size_t)l * INWP * DM, NTOK, INWP, DM};
  pg8::StaticOrder S;
  S.init(NTOK, INWP, (int)gridDim.x, (int)blockIdx.x);
  Epi1 E{p.inter, p.sumsq + (size_t)l * NTOK};
  pg8::gemm_phase<Epi1, pg8::StaticOrder, false>((PG8_LAS unsigned char*)smem, g, S, E, nullptr);
  if (l == 0) {
    const int G = (int)gridDim.x, c = (int)blockIdx.x;
    const int rem = ((NTOK / 256) * (INWP / 256)) % G;
    const int nidle = (rem == 0) ? G : G - rem;
    const int rank = (rem == 0) ? c : c - rem;
    if (rank >= 0) p0_weights(p, 1, rank, nidle, (float*)smem);
  }
}
__device__ void phase3_sample(const Params& p, int l, char* smem) {
  const int tid = otid();
  const int lane = tid & 63, w = tid >> 6;
  const int l32 = lane & 31, lh = lane >> 5;
  float* part = (float*)smem;
  float* ssq = p.sumsq + (size_t)(l + 1) * NTOK;
  for (int T = blockIdx.x; T < 256; T += gridDim.x) {
    const int row0 = NPR + (T >> 4) * 32, col0 = (T & 15) * 64;
    const u16* ap = p.mix + (size_t)(row0 + l32) * DM + w * 128 + lh * 8;
    const u16* bp = p.wout_b + ((size_t)l * DM + col0 + l32) * DM + w * 128 + lh * 8;
    bf16x8 af[8], b0[8], b1[8];
#pragma unroll
    for (int s = 0; s < 8; s++) {
      af[s] = *(const bf16x8*)(ap + s * 16);
      b0[s] = *(const bf16x8*)(bp + s * 16);
      b1[s] = *(const bf16x8*)(bp + (size_t)32 * DM + s * 16);
    }
    f32x16 acc0, acc1;
#pragma unroll
    for (int r = 0; r < 16; r++) { acc0[r] = 0.f; acc1[r] = 0.f; }
#pragma unroll
    for (int s = 0; s < 8; s++) {
      acc0 = __builtin_amdgcn_mfma_f32_32x32x16_bf16(b0[s], af[s], acc0, 0, 0, 0);
      acc1 = __builtin_amdgcn_mfma_f32_32x32x16_bf16(b1[s], af[s], acc1, 0, 0, 0);
    }
#pragma unroll
    for (int r = 0; r < 16; r++) {
      part[((w * 2 + 0) * 16 + r) * 64 + lane] = acc0[r];
      part[((w * 2 + 1) * 16 + r) * 64 + lane] = acc1[r];
    }
    __syncthreads();
    float ss = 0.f;
    const int row = row0 + l32;
#pragma unroll
    for (int ni = 0; ni < 2; ni++) {
#pragma unroll
      for (int rr = 0; rr < 2; rr++) {
        const int r = 2 * w + rr;
        float v = 0.f;
#pragma unroll
        for (int pw = 0; pw < 8; pw++) v += part[((pw * 2 + ni) * 16 + r) * 64 + lane];
        const int col = col0 + ni * 32 + (r & 3) + 8 * (r >> 2) + 4 * lh;
        u16* xp = p.xb + (size_t)row * DM + col;
        v += bf2f(*xp);
        ss += v * v;
        *xp = f2bf(v);
      }
    }
    ss += __shfl_xor(ss, 32);
    if (lh == 0) atomicAdd(ssq + row, ss);
    __syncthreads();
  }
}

__device__ void phase3(const Params& p, int l, char* smem) {
  const bool late = (blockIdx.x & 1) != 0;
  if (!late) phase3_sample(p, l, smem);
  pg8::Gemm g{p.mix, p.wout_b + (size_t)l * DM * DM, NPR, DM, DM};
  pg8::StaticOrder S;
  S.init(NPR, DM, (int)gridDim.x, (int)blockIdx.x);
  Epi2 E{p.xb, p.sumsq + (size_t)(l + 1) * NTOK};
  pg8::gemm_phase<Epi2, pg8::StaticOrder, false>((PG8_LAS unsigned char*)smem, g, S, E, nullptr);
  if (late) phase3_sample(p, l, smem);
}

__device__ void p2_stage_w(const Params& p, int l, char* smem) {
  const int tid = otid();
  const float4* src = (const float4*)(p.a_conv_w + (size_t)l * 31 * 384);
  for (int f = tid; f < 36 * 96; f += NT) {
    int j = f / 96, q = f - j * 96;
    float4 v = make_float4(0.f, 0.f, 0.f, 0.f);
    if (j < 31) v = src[f];
    ((float4*)smem)[(j * 2 + (q & 1)) * 48 + (q >> 1)] = v;
  }
}

struct ATileRegs { u32x4 r0, r1, r2, r3, r4, r5; };
__device__ __forceinline__ void p2_ab_load(const Params& p, int it, ATileRegs& A) {
  const int tid = otid();
  const int R0 = it * 32;
  const int spos = R0 & 2047;
  const u16* __restrict__ inter = p.inter;
  auto ld = [&](int i) -> u32x4 {
    const int e = tid + i * NT;
    const int r = e / 48, ch = e - r * 48;
    u32x4 v = {0u, 0u, 0u, 0u};
    if (r < 62 && spos - 30 + r >= 0) v = *(const u32x4*)(inter + (size_t)(R0 - 30 + r) * IW + ch * 8);
    return v;
  };
  A.r0 = ld(0); A.r1 = ld(1); A.r2 = ld(2); A.r3 = ld(3); A.r4 = ld(4); A.r5 = ld(5);
}
__device__ __forceinline__ void p2_ab_store(const ATileRegs& A, char* smem) {
  const int tid = otid();
  char* atile = smem + 55296 + tid * 16;
  *(u32x4*)(atile) = A.r0;
  *(u32x4*)(atile + 1 * NT * 16) = A.r1;
  *(u32x4*)(atile + 2 * NT * 16) = A.r2;
  *(u32x4*)(atile + 3 * NT * 16) = A.r3;
  *(u32x4*)(atile + 4 * NT * 16) = A.r4;
  *(u32x4*)(atile + 5 * NT * 16) = A.r5;
}

typedef float f32x2 __attribute__((ext_vector_type(2)));
__device__ void p2_ab(const Params& p, int l, int it, char* smem) {
  const int tid = otid();
  const int lane = tid & 63, w = tid >> 6;
  const bool active = lane < 48;
  const int o = active ? lane : 47;
  const int R0 = it * 32;
  const int spos = R0 & 2047;
  const int bseq = R0 >> 11;
  const bool last = (spos == 2016);
  const u16* __restrict__ inter = p.inter;
  char* atile = smem + 55296;
  const float4* wts = (const float4*)smem;
  const size_t rowq = (size_t)R0 + 4 * w;
  const __amdgpu_buffer_rsrc_t mrs = mk_rsrc(p.mix, (unsigned)NTOK * DM * 2u);
  uint4 szv[4], gbv[4], zv[6];
#pragma unroll
  for (int t = 0; t < 4; t++) {
    szv[t] = *(const uint4*)(inter + (rowq + t) * IW + 384 + 8 * o);
    gbv[t] = *(const uint4*)(inter + (rowq + t) * IW + 1152 + 8 * o);
  }
#pragma unroll
  for (int s2 = 0; s2 < 6; s2++) {
    zv[s2] = make_uint4(0, 0, 0, 0);
    if (spos + 4 * w - 2 + s2 >= 0) zv[s2] = *(const uint4*)(inter + (rowq - 2 + s2) * IW + 768 + 8 * o);
  }
  f32x2 acc2[4][4];
  {
    float4 b0 = *(const float4*)(p.a_conv_b + l * 384 + 8 * o), b1 = *(const float4*)(p.a_conv_b + l * 384 + 8 * o + 4);
#pragma unroll
    for (int t = 0; t < 4; t++) {
      acc2[t][0] = (f32x2){b0.x, b0.y}; acc2[t][1] = (f32x2){b0.z, b0.w};
      acc2[t][2] = (f32x2){b1.x, b1.y}; acc2[t][3] = (f32x2){b1.z, b1.w};
    }
  }
  f32x2 wwin[4][4];
#pragma unroll
  for (int u = 0; u < 4; u++)
#pragma unroll
    for (int c = 0; c < 4; c++) wwin[u][c] = (f32x2){0.f, 0.f};
  const char* arow = atile + (4 * w) * 768 + o * 16;
#pragma unroll 1
  for (int s4 = 0; s4 < 36; s4 += 4) {
    const char* ar = arow + s4 * 768;
    const float4* wr = wts + (s4 * 2) * 48 + o;
#pragma unroll
    for (int u = 0; u < 4; u++) {
      uint4 av = *(const uint4*)(ar + u * 768);
      float4 wa = wr[(u * 2) * 48], wb = wr[(u * 2 + 1) * 48];
      f32x2 v[4];
      v[0] = (f32x2){__uint_as_float(av.x << 16), __uint_as_float(av.x & 0xffff0000u)};
      v[1] = (f32x2){__uint_as_float(av.y << 16), __uint_as_float(av.y & 0xffff0000u)};
      v[2] = (f32x2){__uint_as_float(av.z << 16), __uint_as_float(av.z & 0xffff0000u)};
      v[3] = (f32x2){__uint_as_float(av.w << 16), __uint_as_float(av.w & 0xffff0000u)};
      wwin[u][0] = (f32x2){wa.x, wa.y}; wwin[u][1] = (f32x2){wa.z, wa.w};
      wwin[u][2] = (f32x2){wb.x, wb.y}; wwin[u][3] = (f32x2){wb.z, wb.w};
#pragma unroll
      for (int t = 0; t < 4; t++) {
#pragma unroll
        for (int c = 0; c < 4; c++) acc2[t][c] = __builtin_elementwise_fma(wwin[(u - t) & 3][c], v[c], acc2[t][c]);
      }
    }
  }
  if (last && active) {
#pragma unroll
    for (int t = 0; t < 4; t++) {
      int pp = spos + 4 * w + t;
      if (pp >= 2018) {
        float v[8];
        unpack8(*(const uint4*)(arow + (30 + t) * 768), v);
        float* so = p.out + O_SAP + ((size_t)(l * 8 + bseq) * 30 + (pp - 2018)) * 384 + 8 * o;
        *(float4*)so = make_float4(v[0], v[1], v[2], v[3]);
        *(float4*)(so + 4) = make_float4(v[4], v[5], v[6], v[7]);
      }
    }
  }
  float acc[4][8];
#pragma unroll
  for (int t = 0; t < 4; t++)
#pragma unroll
    for (int c = 0; c < 4; c++) { acc[t][2 * c] = acc2[t][c].x; acc[t][2 * c + 1] = acc2[t][c].y; }
  float s1[4], s2[4];
#pragma unroll
  for (int t = 0; t < 4; t++) {
    float a = 0.f, b = 0.f;
#pragma unroll
    for (int c = 0; c < 8; c++) { a += acc[t][c]; b += acc[t][c] * acc[t][c]; }
    s1[t] = active ? a : 0.f;
    s2[t] = active ? b : 0.f;
  }
#pragma unroll
  for (int t = 0; t < 4; t++) {
#pragma unroll
    for (int m = 32; m >= 1; m >>= 1) { s1[t] += __shfl_xor(s1[t], m); s2[t] += __shfl_xor(s2[t], m); }
  }
  {
    float g8[8], b8[8];
    {
      float4 a0 = *(const float4*)(p.a_ln_g + l * 384 + 8 * o), a1 = *(const float4*)(p.a_ln_g + l * 384 + 8 * o + 4);
      float4 c0 = *(const float4*)(p.a_ln_b + l * 384 + 8 * o), c1 = *(const float4*)(p.a_ln_b + l * 384 + 8 * o + 4);
      g8[0] = a0.x; g8[1] = a0.y; g8[2] = a0.z; g8[3] = a0.w; g8[4] = a1.x; g8[5] = a1.y; g8[6] = a1.z; g8[7] = a1.w;
      b8[0] = c0.x; b8[1] = c0.y; b8[2] = c0.z; b8[3] = c0.w; b8[4] = c1.x; b8[5] = c1.y; b8[6] = c1.z; b8[7] = c1.w;
    }
#pragma unroll
    for (int t = 0; t < 4; t++) {
      float mu = s1[t] * (1.f / 384.f);
      float var = s2[t] * (1.f / 384.f) - mu * mu;
      float rstd = rsqrtf(fmaxf(var, 0.f) + EPS);
      float sz[8], y[8];
      unpack8(szv[t], sz);
#pragma unroll
      for (int c = 0; c < 8; c++) y[c] = siluf_((acc[t][c] - mu) * rstd * g8[c] + b8[c]) * sz[c];
      if (active) st16_wt(mrs, ((unsigned)(rowq + t) * DM + 8 * o) * 2u, pack8(y));
    }
  }
  {
    float w0[8], w1[8], w2[8];
    {
      const float* bw = p.b_conv_w + (size_t)l * 3 * 384 + 8 * o;
      float4 a0 = *(const float4*)(bw), a1 = *(const float4*)(bw + 4);
      float4 c0 = *(const float4*)(bw + 384), c1 = *(const float4*)(bw + 384 + 4);
      float4 d0 = *(const float4*)(bw + 768), d1 = *(const float4*)(bw + 768 + 4);
      w0[0] = a0.x; w0[1] = a0.y; w0[2] = a0.z; w0[3] = a0.w; w0[4] = a1.x; w0[5] = a1.y; w0[6] = a1.z; w0[7] = a1.w;
      w1[0] = c0.x; w1[1] = c0.y; w1[2] = c0.z; w1[3] = c0.w; w1[4] = c1.x; w1[5] = c1.y; w1[6] = c1.z; w1[7] = c1.w;
      w2[0] = d0.x; w2[1] = d0.y; w2[2] = d0.z; w2[3] = d0.w; w2[4] = d1.x; w2[5] = d1.y; w2[6] = d1.z; w2[7] = d1.w;
    }
    float z[6][8];
#pragma unroll
    for (int s2i = 0; s2i < 6; s2i++) unpack8(zv[s2i], z[s2i]);
#pragma unroll
    for (int t = 0; t < 4; t++) {
      float gb[8], y[8];
      unpack8(gbv[t], gb);
#pragma unroll
      for (int c = 0; c < 8; c++) y[c] = gb[c] * (w0[c] * z[t][c] + w1[c] * z[t + 1][c] + w2[c] * z[t + 2][c]);
      if (active) st16_wt(mrs, ((unsigned)(rowq + t) * DM + 384 + 8 * o) * 2u, pack8(y));
    }
    if (last && w == 7 && active) {
#pragma unroll
      for (int i = 0; i < 2; i++) {
        float* so = p.out + O_SBP + ((size_t)(l * 8 + bseq) * 2 + i) * 384 + 8 * o;
        *(float4*)so = make_float4(z[4 + i][0], z[4 + i][1], z[4 + i][2], z[4 + i][3]);
        *(float4*)(so + 4) = make_float4(z[4 + i][4], z[4 + i][5], z[4 + i][6], z[4 + i][7]);
      }
    }
  }
  __syncthreads();
}

__device__ void p2_c(const Params& p, int l, int ci, char* smem) {
  const int tid = otid();
  const int lane = tid & 63, w = tid >> 6;
  const int l32 = lane & 31, lh = lane >> 5;
  const int R0 = ci * 128;
  const u16* __restrict__ inter = p.inter;
  bf16x8 wf[4][8];
  {
    const u16* wb = p.wc_b + ((size_t)(l * 4 + (w >> 1)) * 128 + l32) * 128 + lh * 8;
#pragma unroll
    for (int ks = 0; ks < 8; ks++)
#pragma unroll
      for (int ti = 0; ti < 4; ti++)
        if (ti >= (ks >> 1)) wf[ti][ks] = *(const bf16x8*)(wb + (size_t)ti * 32 * 128 + ks * 16);
  }
  {
    const int tok = tid >> 2, qd = tid & 3;
    const u16* src = inter + (size_t)(R0 + tok) * IW + 1792 + qd * 64;
    uint4 xv[8];
#pragma unroll
    for (int i = 0; i < 8; i++) xv[i] = *(const uint4*)(src + i * 8);
    float s1 = 0.f, s2 = 0.f;
#pragma unroll
    for (int i = 0; i < 8; i++) {
      float f[8];
      unpack8(xv[i], f);
#pragma unroll
      for (int k = 0; k < 8; k++) { s1 += f[k]; s2 += f[k] * f[k]; }
    }
    s1 += __shfl_xor(s1, 1); s2 += __shfl_xor(s2, 1);
    s1 += __shfl_xor(s1, 2); s2 += __shfl_xor(s2, 2);
    const float mu = s1 * (1.f / 256.f);
    const float rstd = rsqrtf(fmaxf(s2 * (1.f / 256.f) - mu * mu, 0.f) + EPS);
    const int tch = tok >> 3, tlo = (tok & 7) * 2;
#pragma unroll
    for (int i = 0; i < 8; i++) {
      float f[8];
      unpack8(xv[i], f);
#pragma unroll
      for (int k = 0; k < 8; k++) {
        const int c = qd * 64 + i * 8 + k;
        *(u16*)(smem + c * 256 + ((tch ^ (c & 15)) << 4) + tlo) = f2bf((f[k] - mu) * rstd);
      }
    }
  }
  __syncthreads();
  {
    const int h = w >> 1;
    const int cbase = h * 64 + (w & 1) * 32;
    const int c = cbase + l32;
    f32x16 acc[4];
#pragma unroll
    for (int ti = 0; ti < 4; ti++)
#pragma unroll
      for (int r = 0; r < 16; r++) acc[ti][r] = 0.f;
#pragma unroll
    for (int ks = 0; ks < 8; ks++) {
      bf16x8 vfrag = *(const bf16x8*)(smem + c * 256 + (((ks * 2 + lh) ^ (c & 15)) << 4));
#pragma unroll
      for (int ti = 0; ti < 4; ti++) {
        if (ti >= (ks >> 1)) acc[ti] = __builtin_amdgcn_mfma_f32_32x32x16_bf16(vfrag, wf[ti][ks], acc[ti], 0, 0, 0);
      }
    }
    float4 gl[4], bl[4];
#pragma unroll
    for (int g = 0; g < 4; g++) {
      gl[g] = *(const float4*)(p.c_ln_g + l * 256 + cbase + 8 * g + 4 * lh);
      bl[g] = *(const float4*)(p.c_ln_b + l * 256 + cbase + 8 * g + 4 * lh);
    }
#pragma unroll
    for (int ti = 0; ti < 4; ti++) {
      const int t = ti * 32 + l32;
      const size_t row = (size_t)R0 + t;
      const float rsw = p.rsw[(l * 4 + h) * 128 + t];
      const float bs = p.c_bs[(l * 4 + h) * 128 + t];
#pragma unroll
      for (int g = 0; g < 4; g++) {
        const int d0 = cbase + 8 * g + 4 * lh;
        uint2 gc = *(const uint2*)(inter + row * IW + 1536 + d0);
        float y0 = __uint_as_float(gc.x << 16) * (gl[g].x * acc[ti][4 * g + 0] + bl[g].x * rsw + bs);
        float y1 = __uint_as_float(gc.x & 0xffff0000u) * (gl[g].y * acc[ti][4 * g + 1] + bl[g].y * rsw + bs);
        float y2 = __uint_as_float(gc.y << 16) * (gl[g].z * acc[ti][4 * g + 2] + bl[g].z * rsw + bs);
        float y3 = __uint_as_float(gc.y & 0xffff0000u) * (gl[g].w * acc[ti][4 * g + 3] + bl[g].w * rsw + bs);
        *(uint2*)(p.mix + row * DM + 768 + d0) = make_uint2(pack2(y0, y1), pack2(y2, y3));
      }
    }
  }
  __syncthreads();
}

__device__ void p2_s(const Params& p, int l, int n, float* red, float* smem_f) {
  const int tid = otid();
  const int lane = tid & 63, w = tid >> 6;
  const int c = tid;
  const size_t Rs = NPR + (size_t)n * 4;
  const u16* __restrict__ inter = p.inter;
  float rv[16];
#pragma unroll
  for (int i = 0; i < 16; i++) rv[i] = 0.f;
  float o[4] = {0.f, 0.f, 0.f, 0.f};
  float zin[6] = {0.f, 0.f, 0.f, 0.f, 0.f, 0.f};
  float cvv[4] = {0.f, 0.f, 0.f, 0.f};
  if (c < 384) {
    float in[34], wv[31];
    const float* sa = p.state_a + ((size_t)(l * 128 + n) * 30) * 384 + c;
    float* so = p.out + O_SAS + ((size_t)(l * 128 + n) * 30) * 384 + c;
#pragma unroll
    for (int i = 0; i < 30; i++) in[i] = sa[i * 384];
#pragma unroll
    for (int t = 0; t < 4; t++) in[30 + t] = bf2f(inter[(Rs + t) * IW + c]);
#pragma unroll
    for (int j = 0; j < 31; j++) wv[j] = p.a_conv_w[(l * 31 + j) * 384 + c];
    const float bias = p.a_conv_b[l * 384 + c];
#pragma unroll
    for (int i = 0; i < 30; i++) so[i * 384] = in[4 + i];
#pragma unroll
    for (int t = 0; t < 4; t++) o[t] = bias;
#pragma unroll
    for (int j = 0; j < 31; j++) {
#pragma unroll
      for (int t = 0; t < 4; t++) o[t] += wv[j] * in[t + j];
    }
#pragma unroll
    for (int t = 0; t < 4; t++) { rv[t] = o[t]; rv[4 + t] = o[t] * o[t]; }
    const float* sb = p.state_b + ((size_t)(l * 128 + n) * 2) * 384 + c;
    zin[0] = sb[0]; zin[1] = sb[384];
#pragma unroll
    for (int t = 0; t < 4; t++) zin[2 + t] = bf2f(inter[(Rs + t) * IW + 768 + c]);
  }
  if (c < 256) {
#pragma unroll
    for (int t = 0; t < 4; t++) {
      cvv[t] = bf2f(inter[(Rs + t) * IW + 1792 + c]);
      rv[8 + t] = cvv[t];
      rv[12 + t] = cvv[t] * cvv[t];
    }
  }
#pragma unroll
  for (int i = 0; i < 16; i++) {
#pragma unroll
    for (int m = 32; m >= 1; m >>= 1) rv[i] += __shfl_xor(rv[i], m);
  }
  if (lane == 0) {
#pragma unroll
    for (int i = 0; i < 16; i++) red[w * 16 + i] = rv[i];
  }
  __syncthreads();
#pragma unroll
  for (int i = 0; i < 16; i++) {
    float s = 0.f;
#pragma unroll
    for (int ww = 0; ww < 8; ww++) s += red[ww * 16 + i];
    rv[i] = s;
  }
  if (c < 384) {
    const float g = p.a_ln_g[l * 384 + c], bb = p.a_ln_b[l * 384 + c];
    const float w0 = p.b_conv_w[(l * 3 + 0) * 384 + c], w1 = p.b_conv_w[(l * 3 + 1) * 384 + c], w2 = p.b_conv_w[(l * 3 + 2) * 384 + c];
#pragma unroll
    for (int t = 0; t < 4; t++) {
      float m_ = rv[t] * (1.f / 384.f);
      float var = rv[4 + t] * (1.f / 384.f) - m_ * m_;
      float rstd = rsqrtf(fmaxf(var, 0.f) + EPS);
      float y = (o[t] - m_) * rstd * g + bb;
      float ya = siluf_(y) * bf2f(inter[(Rs + t) * IW + 384 + c]);
      p.mix[(Rs + t) * DM + c] = f2bf(ya);
      float cv = w0 * zin[t] + w1 * zin[t + 1] + w2 * zin[t + 2];
      float yb = bf2f(inter[(Rs + t) * IW + 1152 + c]) * cv;
      p.mix[(Rs + t) * DM + 384 + c] = f2bf(yb);
    }
    p.out[O_SBS + ((size_t)(l * 128 + n) * 2 + 0) * 384 + c] = zin[4];
    p.out[O_SBS + ((size_t)(l * 128 + n) * 2 + 1) * 384 + c] = zin[5];
  }
  if (c < 256) {
    const float g = p.c_ln_g[l * 256 + c], bb = p.c_ln_b[l * 256 + c];
    const int h = c >> 6;
    float vn[4];
#pragma unroll
    for (int t = 0; t < 4; t++) {
      float m_ = rv[8 + t] * (1.f / 256.f);
      float var = rv[12 + t] * (1.f / 256.f) - m_ * m_;
      float rstd = rsqrtf(fmaxf(var, 0.f) + EPS);
      vn[t] = (cvv[t] - m_) * rstd * g + bb;
      p.out[O_SCV + ((size_t)(l * 128 + n) * 4 + t) * 256 + c] = vn[t];
    }
#pragma unroll
    for (int t = 0; t < 4; t++) {
      float acc = p.c_bs[(l * 4 + h) * 128 + t];
#pragma unroll
      for (int s = 0; s < 4; s++)
        if (s <= t) acc += p.c_ws[((size_t)(l * 4 + h) * 128 + t) * 128 + s] * vn[s];
      float yc = bf2f(inter[(Rs + t) * IW + 1536 + c]) * acc;
      p.mix[(Rs + t) * DM + 768 + c] = f2bf(yc);
    }
  }
  __syncthreads();
}

__device__ void phase2(const Params& p, int l, char* smem) {
  float* red = (float*)(smem + 90112);
  const int nb = gridDim.x, b = blockIdx.x;
  p2_stage_w(p, l, smem);
  {
    ATileRegs A;
    if (b < 512) p2_ab_load(p, b, A);
#pragma unroll 1
    for (int it = b; it < 512; it += nb) {
      p2_ab_store(A, smem);
      __syncthreads();
      const int nx = (it + nb < 512) ? it + nb : it;
      p2_ab_load(p, nx, A);
      p2_ab(p, l, it, smem);
    }
  }
  for (int it = b; it < 128; it += nb) {
    asm volatile("" ::: "memory");
    p2_c(p, l, it, smem);
  }
  for (int it = (b + nb - (128 % nb)) % nb; it < 128; it += nb) {
    asm volatile("" ::: "memory");
    p2_s(p, l, it, red, (float*)smem);
  }
}

__device__ void phase4(const Params& p) {
  const int tid = otid();
  const float* ssq = p.sumsq + (size_t)2 * NTOK;
  for (int idx = blockIdx.x * NT + tid; idx < NTOK * 128; idx += gridDim.x * NT) {
    const int row = idx >> 7, c8 = idx & 127;
    uint4 v = *(const uint4*)(p.xb + (size_t)row * DM + c8 * 8);
    const float rs = rsqrtf(ssq[row] * (1.f / 1024.f) + EPS);
    float4 g0 = *(const float4*)(p.final_g + c8 * 8), g1 = *(const float4*)(p.final_g + c8 * 8 + 4);
    float f[8];
    unpack8(v, f);
    float* o = p.out + (size_t)row * DM + c8 * 8;
    *(float4*)o = make_float4(f[0] * rs * g0.x, f[1] * rs * g0.y, f[2] * rs * g0.z, f[3] * rs * g0.w);
    *(float4*)(o + 4) = make_float4(f[4] * rs * g1.x, f[5] * rs * g1.y, f[6] * rs * g1.z, f[7] * rs * g1.w);
  }
}

#define CEN_WORD(j) (XCD_BAR_WORDS + 64 * (j))
#define BAR_TOTAL_WORDS (XCD_BAR_WORDS + 64 * 16)
__global__ void __launch_bounds__(NT) fwd_megakernel(Params p) {
  extern __shared__ __attribute__((aligned(16))) char smem[];
  __shared__ uint4 xb_words;
  __shared__ uint4 sched_words;
  if (threadIdx.x == 0) {
    xb_words = make_uint4(0u, 0u, 0u, 0u);
    const unsigned x = xb_xcc_id();
    const unsigned slot = xb_add(&p.bar[CEN_WORD(x)], 1u);
    sched_words = make_uint4(slot, 1u, 0u, gridDim.x);
  }
  __syncthreads();
  XcdBarrier gb = xcd_barrier_post(p.bar, (volatile LAS unsigned*)&xb_words);
  const volatile LAS unsigned* sched = (const volatile LAS unsigned*)&sched_words;
  phase0(p, smem);
  xcd_barrier(gb);
  if (threadIdx.x == 0) {
    const unsigned x = xb_xcc_id();
    unsigned prefix = 0u, mine = 1u;
#pragma unroll
    for (unsigned j = 0; j < 16; ++j) {
      const unsigned c = xb_ld(&p.bar[CEN_WORD(j)]);
      prefix += (j < x) ? c : 0u;
      mine = (j == x) ? c : mine;
    }
    volatile LAS unsigned* sw = (volatile LAS unsigned*)&sched_words;
    sw[1] = mine;
    sw[2] = prefix;
  }
  __syncthreads();
#pragma unroll 1
  for (int l = 0; l < 2; l++) {
    phase1(p, l, smem);
    xcd_barrier(gb);
    phase2(p, l, smem);
    xcd_barrier(gb);
    phase3(p, l, smem);
    xcd_barrier(gb);
  }
  phase4(p);
}

extern "C" void kernel_launch(void* const* d_in, const int* in_sizes, int n_in, void* d_out, int out_size, void* d_ws,
                              size_t ws_size, hipStream_t stream) {
  static int grid_blocks = 0;
  if (!grid_blocks) {
    int dev = 0, cus = 0, per_cu = 0;
    hipGetDevice(&dev);
    hipDeviceGetAttribute(&cus, hipDeviceAttributeMultiprocessorCount, dev);
    hipFuncSetAttribute((const void*)fwd_megakernel, hipFuncAttributeMaxDynamicSharedMemorySize, LDS_BYTES);
    hipOccupancyMaxActiveBlocksPerMultiprocessor(&per_cu, (const void*)fwd_megakernel, NT, LDS_BYTES);
    if (per_cu < 1) { fprintf(stderr, "occupancy query returned %d\n", per_cu); per_cu = 1; }
    if (per_cu > 1) per_cu = 1;
    grid_blocks = cus * per_cu;
  }
  Params p{};
  p.x_prompt = (const float*)d_in[0];
  p.x_sample = (const float*)d_in[1];
  p.state_a = (const float*)d_in[2];
  p.state_b = (const float*)d_in[3];
  p.norm_g = (const float*)d_in[4];
  p.w_in = (const float*)d_in[5];
  p.a_conv_w = (const float*)d_in[6];
  p.a_conv_b = (const float*)d_in[7];
  p.a_ln_g = (const float*)d_in[8];
  p.a_ln_b = (const float*)d_in[9];
  p.b_conv_w = (const float*)d_in[10];
  p.c_ln_g = (const float*)d_in[11];
  p.c_ln_b = (const float*)d_in[12];
  p.c_ws = (const float*)d_in[13];
  p.c_bs = (const float*)d_in[14];
  p.w_out = (const float*)d_in[15];
  p.final_g = (const float*)d_in[16];
  p.out = (float*)d_out;
  char* ws = (char*)d_ws;
  size_t off = 0;
  auto take = [&](size_t bytes) { char* r = ws + off; off += (bytes + 255) & ~(size_t)255; return r; };
  p.win_b = (u16*)take((size_t)2 * 3584 * DM * 2);
  p.wout_b = (u16*)take((size_t)2 * DM * DM * 2);
  p.wc_b = (u16*)take((size_t)2 * 4 * 128 * 128 * 2);
  p.xb = (u16*)take((size_t)NTOK * DM * 2);
  p.inter = (u16*)take((size_t)NTOK * IW * 2);
  p.mix = (u16*)take((size_t)NTOK * DM * 2);
  p.sumsq = (float*)take((size_t)3 * NTOK * 4);
  p.rsw = (float*)take((size_t)2 * 4 * 128 * 4);
  p.bar = (unsigned*)take((size_t)BAR_TOTAL_WORDS * 4);
  hipMemsetAsync(p.bar, 0, (size_t)BAR_TOTAL_WORDS * 4, stream);
  void* args[] = {&p};
  hipError_t e = hipLaunchCooperativeKernel((const void*)fwd_megakernel, dim3(grid_blocks), dim3(NT), args, LDS_BYTES, stream);
  if (e != hipSuccess) fprintf(stderr, "cooperative launch failed: %s (grid %d)\n", hipGetErrorString(e), grid_blocks);
}
```

```cpp
#include <hip/hip_runtime.h>
#include <cstdio>
#include <cstdint>
#include <type_traits>

typedef unsigned short u16;
typedef short bf16x8 __attribute__((ext_vector_type(8)));
typedef float f32x16 __attribute__((ext_vector_type(16)));
typedef unsigned int u32x4 __attribute__((ext_vector_type(4)));

constexpr int NTOK = 16896, NPR = 16384, DM = 1024, INW = 3456, IW = 2048;
constexpr int NT = 512;
constexpr int INWP = 3584;
constexpr int LDS_BYTES = 131072;
constexpr float EPS = 1e-6f;

constexpr size_t O_SAP = 17301504, O_SBP = 17485824, O_SAS = 17498112, O_SBS = 20447232, O_SCV = 20643840;

struct Params {
  const float *x_prompt, *x_sample, *state_a, *state_b, *norm_g, *w_in, *a_conv_w, *a_conv_b, *a_ln_g, *a_ln_b,
      *b_conv_w, *c_ln_g, *c_ln_b, *c_ws, *c_bs, *w_out, *final_g;
  float* out;
  u16 *win_b, *wout_b, *wc_b, *xb, *inter, *mix;
  float *sumsq, *rsw;
  unsigned* bar;
};

__device__ __forceinline__ u16 f2bf(float f) {
  unsigned u = __float_as_uint(f);
  u += 0x7fffu + ((u >> 16) & 1u);
  return (u16)(u >> 16);
}
__device__ __forceinline__ float bf2f(u16 h) { return __uint_as_float(((unsigned)h) << 16); }
__device__ __forceinline__ unsigned pack2(float a, float b) {
  unsigned r;
  asm volatile("v_cvt_pk_bf16_f32 %0, %1, %2" : "=v"(r) : "v"(a), "v"(b));
  return r;
}
__device__ __forceinline__ float sigmoidf_(float x) { return __builtin_amdgcn_rcpf(1.f + __builtin_amdgcn_exp2f(-1.44269504f * x)); }
__device__ __forceinline__ float siluf_(float x) { return x * __builtin_amdgcn_rcpf(1.f + __builtin_amdgcn_exp2f(-1.44269504f * x)); }

__device__ __forceinline__ void unpack8(const uint4& v, float (&f)[8]) {
  f[0] = __uint_as_float(v.x << 16); f[1] = __uint_as_float(v.x & 0xffff0000u);
  f[2] = __uint_as_float(v.y << 16); f[3] = __uint_as_float(v.y & 0xffff0000u);
  f[4] = __uint_as_float(v.z << 16); f[5] = __uint_as_float(v.z & 0xffff0000u);
  f[6] = __uint_as_float(v.w << 16); f[7] = __uint_as_float(v.w & 0xffff0000u);
}
__device__ __forceinline__ uint4 pack8(const float (&f)[8]) {
  uint4 o;
  o.x = pack2(f[0], f[1]); o.y = pack2(f[2], f[3]); o.z = pack2(f[4], f[5]); o.w = pack2(f[6], f[7]);
  return o;
}

__device__ __forceinline__ __amdgpu_buffer_rsrc_t mk_rsrc(void* base, unsigned bytes) {
  return __builtin_amdgcn_make_buffer_rsrc(base, 0, bytes, 0x00020000);
}
__device__ __forceinline__ void st16_wt(__amdgpu_buffer_rsrc_t r, unsigned byte_off, const uint4& v) {
  u32x4 d = {v.x, v.y, v.z, v.w};
  __builtin_amdgcn_raw_buffer_store_b128(d, r, byte_off, 0, 16);
}

__device__ __forceinline__ int otid() {
  int t = threadIdx.x;
  asm volatile("" : "+v"(t));
  return t;
}

__device__ __forceinline__ int vcol_src(int vc);

#define XB_TMO      128
#define XB_XCNT(j)  (256  + 64 * (j))
#define XB_XSUB(j)  (1280 + 64 * (j))
#define XB_XGEN(j)  (2304 + 64 * (j))
#define XB_TOP      3328
#define XB_TOPGEN   3392
#define XCD_BAR_WORDS 3456
#define XB_SPIN_CAP (1u << 18)
#define LAS __attribute__((address_space(3)))

__device__ __forceinline__ unsigned xb_ld(unsigned* p)              { return __hip_atomic_load(p, __ATOMIC_RELAXED, __HIP_MEMORY_SCOPE_AGENT); }
__device__ __forceinline__ unsigned xb_add(unsigned* p, unsigned v) { return __hip_atomic_fetch_add(p, v, __ATOMIC_RELAXED, __HIP_MEMORY_SCOPE_AGENT); }
__device__ __forceinline__ unsigned xb_xcc_id() { return (unsigned)__builtin_amdgcn_s_getreg((3 << 11) | 20) & 0xFu; }
#define XB_SPIN(cond, bar) do { unsigned _sp = 0; while (cond) { __builtin_amdgcn_s_sleep(1); \
    if ((++_sp & 255u) == 0u) { if (xb_ld(&(bar)[XB_TMO])) break; if (_sp > XB_SPIN_CAP) { atomicAdd(&(bar)[XB_TMO], 1u); break; } } } } while (0)

struct XcdBarrier {
  unsigned* bar; unsigned x;
  volatile LAS unsigned* st;
};
__device__ __forceinline__ XcdBarrier xcd_barrier_post(unsigned* bar, volatile LAS unsigned* st) {
  XcdBarrier b; b.bar = bar; b.x = xb_xcc_id(); b.st = st;
  if (threadIdx.x == 0) (void)xb_add(&bar[XB_XCNT(b.x)], 1u);
  return b;
}
__device__ __forceinline__ void xcd_barrier_complete(unsigned* bar, unsigned x, unsigned& nloc, unsigned& nx) {
  const unsigned G = gridDim.x * gridDim.y * gridDim.z;
  unsigned sum, cnt, mine, sp = 0u;
  for (;;) {
    sum = 0u; cnt = 0u; mine = 0u;
#pragma unroll
    for (unsigned j = 0; j < 16; ++j) { const unsigned c = xb_ld(&bar[XB_XCNT(j)]); sum += c; cnt += (c > 0u) ? 1u : 0u; mine = (j == x) ? c : mine; }
    if (sum == G) break;
    __builtin_amdgcn_s_sleep(1);
    if ((++sp & 255u) == 0u) { if (xb_ld(&bar[XB_TMO])) break; if (sp > XB_SPIN_CAP) { atomicAdd(&bar[XB_TMO], 1u); break; } }
  }
  nloc = mine > 0u ? mine : 1u; nx = cnt > 0u ? cnt : 1u;
}
__device__ __forceinline__ void xcd_barrier(const XcdBarrier& b) {
  asm volatile("s_waitcnt vmcnt(0)" ::: "memory");
  __syncthreads();
  if (threadIdx.x == 0) {
    unsigned* bar = b.bar;
    __builtin_amdgcn_s_waitcnt(0);
    unsigned nloc = b.st[0], nx = b.st[1];
    if (nloc == 0u) { xcd_barrier_complete(bar, b.x, nloc, nx); b.st[0] = nloc; b.st[1] = nx; }
    const unsigned old = xb_add(&bar[XB_XSUB(b.x)], 1u);
    const unsigned gen = old / nloc;
    if (old + 1u == (gen + 1u) * nloc) {
      __builtin_amdgcn_fence(__ATOMIC_RELEASE, "agent");
      asm volatile("s_waitcnt vmcnt(0)" ::: "memory");
      const unsigned og = xb_add(&bar[XB_TOP], 1u);
      const unsigned tg = og / nx;
      if (og + 1u == (tg + 1u) * nx) xb_add(&bar[XB_TOPGEN], 1u);
      else XB_SPIN(xb_ld(&bar[XB_TOPGEN]) == tg, bar);
      __builtin_amdgcn_fence(__ATOMIC_ACQUIRE, "agent");
      xb_add(&bar[XB_XGEN(b.x)], 1u);
      asm volatile("s_waitcnt vmcnt(0)" ::: "memory");
    } else {
      XB_SPIN(xb_ld(&bar[XB_XGEN(b.x)]) == gen, bar);
      __builtin_amdgcn_fence(__ATOMIC_ACQUIRE, "agent");
      asm volatile("s_waitcnt vmcnt(0)" ::: "memory");
    }
  }
  __syncthreads();
}

__device__ void p0_transpose(const float* __restrict__ W, int ncols, const float* __restrict__ g, u16* __restrict__ outp,
                             int k0, int v0, bool mapv, float* tile) {
  int tid = otid();
  float vals[16];
#pragma unroll
  for (int i = 0; i < 16; i++) {
    int e = tid + i * NT;
    int kk = e >> 7, v = e & 127;
    int src = mapv ? vcol_src(v0 + v) : (v0 + v);
    float val = 0.f;
    if (src >= 0) val = __builtin_nontemporal_load(W + (size_t)(k0 + kk) * ncols + src);
    vals[i] = val;
  }
#pragma unroll
  for (int i = 0; i < 16; i++) {
    int e = tid + i * NT;
    int kk = e >> 7, v = e & 127;
    float val = vals[i];
    if (g) val *= g[k0 + kk];
    tile[kk * 129 + v] = val;
  }
  __syncthreads();
#pragma unroll
  for (int h = 0; h < 2; h++) {
    int v = (tid >> 3) + h * 64, kq = tid & 7;
    const float* tp = tile + (kq * 8) * 129 + v;
    uint4 o;
    o.x = pack2(tp[0], tp[129]);
    o.y = pack2(tp[2 * 129], tp[3 * 129]);
    o.z = pack2(tp[4 * 129], tp[5 * 129]);
    o.w = pack2(tp[6 * 129], tp[7 * 129]);
    *(uint4*)(outp + (size_t)(v0 + v) * 1024 + k0 + kq * 8) = o;
  }
  __syncthreads();
}

__device__ void p0_weights(const Params& p, int l, int rank, int nranks, float* tile) {
  for (int it = rank; it < 16 * 28; it += nranks) {
    int kb = it / 28, vb = it % 28;
    p0_transpose(p.w_in + (size_t)l * DM * INW, INW, p.norm_g + l * DM, p.win_b + (size_t)l * INWP * DM, kb * 64, vb * 128, true, tile);
  }
  for (int it = rank; it < 16 * 8; it += nranks) {
    int kb = it >> 3, vb = it & 7;
    p0_transpose(p.w_out + (size_t)l * DM * DM, DM, nullptr, p.wout_b + (size_t)l * DM * DM, kb * 64, vb * 128, false, tile);
  }
}

__device__ void phase0(const Params& p, char* smem) {
  float* tile = (float*)smem;
  int nb = gridDim.x, b = blockIdx.x, tid = otid();
  const int wave = tid >> 6, lane = tid & 63;
  for (int e = b * NT + tid; e < 2 * NTOK; e += nb * NT) p.sumsq[NTOK + e] = 0.f;
  for (int e = b * NT + tid; e < 2 * 4 * 128 * 128; e += nb * NT) {
    int s = e & 127, t = (e >> 7) & 127;
    p.wc_b[e] = (s <= t) ? f2bf(p.c_ws[e]) : (u16)0;
  }
  for (int r = b * 8 + wave; r < 2 * 4 * 128; r += nb * 8) {
    const int t = r & 127;
    const float* wr = p.c_ws + (size_t)r * 128;
    float s = 0.f;
    if (lane <= t) s += bf2f(f2bf(wr[lane]));
    if (lane + 64 <= t) s += bf2f(f2bf(wr[lane + 64]));
#pragma unroll
    for (int m = 32; m >= 1; m >>= 1) s += __shfl_xor(s, m);
    if (lane == 0) p.rsw[r] = s;
  }
  const bool wfirst = (b & 1) != 0;
  if (wfirst) p0_weights(p, 0, b, nb, tile);
  for (int row = (b * 8 + wave) * 2; row < NTOK; row += nb * 16) {
    const float* xr0 = (row < NPR) ? (p.x_prompt + (size_t)row * DM) : (p.x_sample + (size_t)(row - NPR) * DM);
    const float* xr1 = xr0 + DM;
    float4 v0[4], v1[4];
#pragma unroll
    for (int j = 0; j < 4; j++) {
      typedef float f4v __attribute__((ext_vector_type(4)));
      f4v a = __builtin_nontemporal_load((const f4v*)(xr0 + (j * 64 + lane) * 4));
      f4v c = __builtin_nontemporal_load((const f4v*)(xr1 + (j * 64 + lane) * 4));
      v0[j] = make_float4(a.x, a.y, a.z, a.w);
      v1[j] = make_float4(c.x, c.y, c.z, c.w);
    }
    float s0 = 0.f, s1 = 0.f;
#pragma unroll
    for (int j = 0; j < 4; j++) {
      s0 += v0[j].x * v0[j].x + v0[j].y * v0[j].y + v0[j].z * v0[j].z + v0[j].w * v0[j].w;
      s1 += v1[j].x * v1[j].x + v1[j].y * v1[j].y + v1[j].z * v1[j].z + v1[j].w * v1[j].w;
      *(uint2*)(p.xb + (size_t)row * DM + (j * 64 + lane) * 4) = make_uint2(pack2(v0[j].x, v0[j].y), pack2(v0[j].z, v0[j].w));
      *(uint2*)(p.xb + (size_t)(row + 1) * DM + (j * 64 + lane) * 4) = make_uint2(pack2(v1[j].x, v1[j].y), pack2(v1[j].z, v1[j].w));
    }
#pragma unroll
    for (int m = 32; m >= 1; m >>= 1) { s0 += __shfl_xor(s0, m); s1 += __shfl_xor(s1, m); }
    if (lane == 0) { p.sumsq[row] = s0; p.sumsq[row + 1] = s1; }
  }
  if (!wfirst) p0_weights(p, 0, b, nb, tile);
}

namespace pg8 {
#define PG8_LAS __attribute__((address_space(3)))
typedef unsigned short bf16_t;
typedef short bf16x8 __attribute__((ext_vector_type(8)));
typedef float f32x4 __attribute__((ext_vector_type(4)));
typedef unsigned u32x4 __attribute__((ext_vector_type(4)));
constexpr int BM = 256, BK = 64, HALF = 128, HTB = HALF * BK * 2  , STAGE_BYTES = 8 * HTB, NXCD = 8, WGM = 8;

__host__ __device__ __forceinline__ int lds_byte(int r, int c) { const int st = (r >> 4) * 2 + (c >> 5), rr = r & 15, cc = c & 31, ob = rr * 64 + cc * 2; return st * 1024 + (ob ^ (((ob >> 9) & 1) << 5)); }
__host__ __device__ __forceinline__ void stage_rc(int b, int& R, int& C) { const int st = b / 1024, sb = b % 1024, swz = sb ^ (((sb >> 9) & 1) << 5); R = (st >> 1) * 16 + swz / 64; C = (st & 1) * 32 + (swz % 64) / 2; }
__host__ __device__ __forceinline__ int perm32(int rho) { const int n = rho >> 4, i = rho & 15; return 8 * (i >> 2) + 4 * n + (i & 3); }

struct Unit { int pm, pn; };
struct Gemm { const bf16_t* A; const bf16_t* Bt; int M, N, K; };

struct StaticOrder {
    int nM, nN, nwg, G, c;
    __host__ __device__ void init(int M, int N, int G_, int c_) { nM = M / BM; nN = N / BM; nwg = nM * nN; G = G_; c = c_; }
    __host__ __device__ bool next(int i, Unit& u) const {
        const long L = (long)i * G + c; if (L >= nwg) return false;
        int wgid = (int)L; { const int q = nwg / NXCD, r = nwg % NXCD, xcd = wgid % NXCD, off = wgid / NXCD; wgid = (xcd < r ? xcd * (q + 1) : r * (q + 1) + (xcd - r) * q) + off; }
        const int nig = WGM * nN, gid = wgid / nig, fm = gid * WGM, gsz = (nM - fm) < WGM ? (nM - fm) : WGM;
        u.pm = fm + ((wgid % nig) % gsz); u.pn = (wgid % nig) / gsz; return true;
    }
    __device__ __forceinline__ void a_ready(const Unit&) const {}
    __device__ __forceinline__ void done(const Unit&) const {}
};
__device__ __forceinline__ unsigned cvt_pk_bf16(float lo, float hi) { unsigned r; asm volatile("v_cvt_pk_bf16_f32 %0, %1, %2" : "=v"(r) : "v"(lo), "v"(hi)); return r; }
template <class Epi, class Sched, bool STAMP = false>
__device__ __forceinline__ void gemm_phase(PG8_LAS unsigned char* lds, const Gemm g, const Sched& S, const Epi& E, unsigned long long* stamps) {
    const int tid = otid(), wid = __builtin_amdgcn_readfirstlane(tid >> 6), lane = tid & 63, wr = wid >> 2, wc = wid & 3, fr = lane & 15, fq = lane >> 4;
    const int K = g.K, nt = K / BK;
    int ts_lo = 0, ts_hi = 0, nts = 0; const unsigned long long rt_entry = STAMP ? (unsigned long long)wall_clock64() : 0ull;
#define PG8_STAMP() do { if (STAMP && wid == 0 && nts < 64) { const unsigned long long _c = (unsigned long long)clock64(); \
        ts_lo = (lane == nts) ? (int)(unsigned)_c : ts_lo; ts_hi = (lane == nts) ? (int)(unsigned)(_c >> 32) : ts_hi; ++nts; } } while (0)
    PG8_STAMP();
    unsigned voffA[2], voffB[2];
#pragma unroll
    for (int i = 0; i < 2; ++i) { int R, C; stage_rc(tid * 16 + i * 8192, R, C); const int Rb = Epi::PERM ? ((R & ~31) + perm32(R & 31)) : R;
        voffA[i] = (unsigned)(R * K + C) * 2u; voffB[i] = (unsigned)(Rb * K + C) * 2u; }
    const size_t kstep = (size_t)(BK * 2);
    const size_t hstep = (size_t)HALF * K * 2;
    const size_t tstep = 2 * hstep;
    const unsigned ldsw = (unsigned)wid * 1024u;
    const int aoff = lds_byte(wr * 64 + fr, fq * 8), boff = lds_byte(wc * 32 + fr, fq * 8);
#define PG8_SA(b, h) (((b) * 2 + (h)) * HTB)
#define PG8_SB(b, h) ((4 + (b) * 2 + (h)) * HTB)
#define PG8_STAGE(bufoff, gbase, voff) do { _Pragma("unroll") for (int _i = 0; _i < 2; ++_i) \
        __builtin_amdgcn_global_load_lds((const unsigned*)((const char*)(gbase) + (voff)[_i]), (PG8_LAS unsigned*)(lds + (bufoff) + ldsw + _i * 8192), 16, 0, 0); } while (0)
#define PG8_LDA(dst, b, h) do { _Pragma("unroll") for (int m = 0; m < 4; ++m) _Pragma("unroll") for (int k = 0; k < 2; ++k) dst[m][k] = *(const PG8_LAS bf16x8*)(lds + PG8_SA(b, h) + aoff + m * 2048 + k * 1024); } while (0)
#define PG8_LDB(dst, b, h) do { _Pragma("unroll") for (int n = 0; n < 2; ++n) _Pragma("unroll") for (int k = 0; k < 2; ++k) dst[n][k] = *(const PG8_LAS bf16x8*)(lds + PG8_SB(b, h) + boff + n * 2048 + k * 1024); } while (0)
#define PG8_MMA(ai, bj, At, Bt) do { __builtin_amdgcn_s_setprio(1); _Pragma("unroll") for (int m = 0; m < 4; ++m) _Pragma("unroll") for (int n = 0; n < 2; ++n) _Pragma("unroll") for (int k = 0; k < 2; ++k) \
        acc[ai][bj][m][n] = __builtin_amdgcn_mfma_f32_16x16x32_bf16(Bt[n][k], At[m][k], acc[ai][bj][m][n], 0, 0, 0); __builtin_amdgcn_s_setprio(0); } while (0)
#define PG8_WAIT_V(n) asm volatile("s_waitcnt vmcnt(" #n ")" ::: "memory")
#define PG8_WAIT_L(n) asm volatile("s_waitcnt lgkmcnt(" #n ")" ::: "memory")
#define PG8_BAR __builtin_amdgcn_s_barrier()
#define PG8_SCHED __builtin_amdgcn_sched_barrier(0)
    Unit cur, nxt; int ui = 0;
    if (!S.next(0, cur)) return;
    f32x4 acc[2][2][4][2];
#pragma unroll
    for (int a = 0; a < 2; ++a)
#pragma unroll
        for (int b = 0; b < 2; ++b)
#pragma unroll
            for (int m = 0; m < 4; ++m)
#pragma unroll
                for (int n = 0; n < 2; ++n) acc[a][b][m][n] = (f32x4){0.f, 0.f, 0.f, 0.f};
    bf16x8 At[4][2], B0[2][2], B1[2][2];
    const char* cA = (const char*)g.A + (size_t)cur.pm * tstep; const char* cB = (const char*)g.Bt + (size_t)cur.pn * tstep;
    typename Epi::Pre pre;
    E.preload(cur, wr, fr, pre);
    S.a_ready(cur);
    PG8_STAGE(PG8_SB(0, 0), cB, voffB); PG8_STAGE(PG8_SA(0, 0), cA, voffA); PG8_STAGE(PG8_SB(0, 1), cB + hstep, voffB); PG8_STAGE(PG8_SA(0, 1), cA + hstep, voffA);
    if (wr == 1) PG8_BAR;
    PG8_WAIT_V(4); PG8_BAR;
    PG8_STAGE(PG8_SB(1, 0), cB + kstep, voffB); PG8_STAGE(PG8_SA(1, 0), cA + kstep, voffA); PG8_STAGE(PG8_SB(1, 1), cB + hstep + kstep, voffB);
    PG8_WAIT_V(6); PG8_BAR;
    PG8_STAMP();
    for (;;) {
        const bool has_next = S.next(ui + 1, nxt);
        const char* nA = has_next ? (const char*)g.A + (size_t)nxt.pm * tstep : cA; const char* nB = has_next ? (const char*)g.Bt + (size_t)nxt.pn * tstep : cB;
        for (int t = 0; t < nt; t += 2) {
            const bool last = (t == nt - 2);
            const char* a1 = cA + (size_t)(t + 1) * kstep;
            const char* a2 = last ? nA : cA + (size_t)(t + 2) * kstep; const char* b2 = last ? nB : cB + (size_t)(t + 2) * kstep;
            const char* a3 = a2 + kstep; const char* b3 = b2 + kstep;
            if (last && has_next) S.a_ready(nxt);
            PG8_LDB(B0, 0, 0); PG8_SCHED; PG8_LDA(At, 0, 0); PG8_STAGE(PG8_SA(1, 1), a1 + hstep, voffA);
            PG8_WAIT_L(8); PG8_BAR; PG8_WAIT_L(0); PG8_MMA(0, 0, At, B0); PG8_BAR; PG8_SCHED;
            PG8_LDB(B1, 0, 1); PG8_STAGE(PG8_SB(0, 0), b2, voffB);
            PG8_BAR; PG8_WAIT_L(0); PG8_MMA(0, 1, At, B1); PG8_BAR;
            PG8_LDA(At, 0, 1); PG8_STAGE(PG8_SA(0, 0), a2, voffA);
            PG8_BAR; PG8_WAIT_L(0); PG8_MMA(1, 0, At, B0); PG8_BAR; PG8_SCHED;
            PG8_STAGE(PG8_SB(0, 1), b2 + hstep, voffB);
            PG8_WAIT_V(6); PG8_BAR; PG8_MMA(1, 1, At, B1); PG8_BAR;
            PG8_LDB(B0, 1, 0); PG8_SCHED; PG8_LDA(At, 1, 0); PG8_STAGE(PG8_SA(0, 1), a2 + hstep, voffA);
            PG8_WAIT_L(8); PG8_BAR; PG8_WAIT_L(0); PG8_MMA(0, 0, At, B0); PG8_BAR; PG8_SCHED;
            PG8_LDB(B1, 1, 1); PG8_STAGE(PG8_SB(1, 0), b3, voffB);
            PG8_BAR; PG8_WAIT_L(0); PG8_MMA(0, 1, At, B1); PG8_BAR;
            PG8_LDA(At, 1, 1); PG8_STAGE(PG8_SA(1, 0), a3, voffA);
            PG8_BAR; PG8_WAIT_L(0); PG8_MMA(1, 0, At, B0); PG8_BAR; PG8_SCHED;
            PG8_STAGE(PG8_SB(1, 1), b3 + hstep, voffB);
            PG8_WAIT_V(6); PG8_BAR; PG8_MMA(1, 1, At, B1); PG8_BAR;
        }
        PG8_STAMP();
        if constexpr (!Epi::AFTER_DRAIN) { E(acc, cur, wr, wc, fr, fq, pre); S.done(cur); }
        PG8_STAMP();
        if (!has_next) break;
#pragma unroll
        for (int a = 0; a < 2; ++a)
#pragma unroll
            for (int b = 0; b < 2; ++b)
#pragma unroll
                for (int m = 0; m < 4; ++m)
#pragma unroll
                    for (int n = 0; n < 2; ++n) acc[a][b][m][n] = (f32x4){0.f, 0.f, 0.f, 0.f};
        cur = nxt; cA = nA; cB = nB; ++ui;
        E.preload(cur, wr, fr, pre);
    }
    PG8_WAIT_V(0);
    if (wr == 0) PG8_BAR;
    PG8_BAR;
    if constexpr (Epi::AFTER_DRAIN) { E.fused(acc, cur, wr, wc, fr, fq, lds, wid, lane); S.done(cur); }
    PG8_STAMP();
    if (STAMP && wid == 0) { stamps[lane] = lane < nts ? (((unsigned long long)(unsigned)ts_hi << 32) | (unsigned)ts_lo) : 0ull;
        if (lane == 62) stamps[62] = rt_entry; if (lane == 63) stamps[63] = (unsigned long long)wall_clock64(); }
#undef PG8_STAMP
#undef PG8_SA
#undef PG8_SB
#undef PG8_STAGE
#undef PG8_LDA
#undef PG8_LDB
#undef PG8_MMA
#undef PG8_WAIT_V
#undef PG8_WAIT_L
#undef PG8_BAR
#undef PG8_SCHED
}
}


__device__ __forceinline__ int vcol_src(int vc) {
  const int un = vc >> 8, h = (vc >> 7) & 1, i = vc & 127;
  if (un < 3) return (h ? 384 : 0) + 128 * un + i;
  if (un < 6) return (h ? 1920 : 1152) + 128 * (un - 3) + i;
  if (un < 9) return (h ? 2304 : 1536) + 128 * (un - 6) + i;
  if (un < 11) return (h ? 3200 : 2688) + 128 * (un - 9) + i;
  if (un == 11) return 768 + 128 * h + i;
  if (un == 12) return h ? (2944 + i) : (768 + 256 + i);
  return h ? -1 : (2944 + 128 + i);
}

typedef float f32x4_ __attribute__((ext_vector_type(4)));
struct Epi1 {
  static constexpr bool PERM = true, AFTER_DRAIN = false;
  u16* inter; const float* ssq;
  struct Pre { float s[8]; };
  __device__ __forceinline__ void preload(const pg8::Unit& u, int wr, int fr, Pre& P) const {
#pragma unroll
    for (int ai = 0; ai < 2; ++ai)
#pragma unroll
      for (int m = 0; m < 4; ++m) P.s[ai * 4 + m] = ssq[u.pm * 256 + 64 * wr + fr + 128 * ai + 16 * m];
  }
  __device__ __forceinline__ void operator()(const pg8::f32x4 (&acc)[2][2][4][2], const pg8::Unit& u, int wr, int wc, int fr, int fq, const Pre& P) const {
    const int un = u.pn;
    int k0, ob0, k1 = -1, ob1 = 0;
    if (un < 3) { k0 = 0; ob0 = 128 * un; }
    else if (un < 6) { k0 = 2; ob0 = 768 + 128 * (un - 3); }
    else if (un < 9) { k0 = 3; ob0 = 1152 + 128 * (un - 6); }
    else if (un < 11) { k0 = 3; ob0 = 1536 + 128 * (un - 9); }
    else if (un == 11) { k0 = 1; ob0 = 384; k1 = 1; ob1 = 384 + 128; }
    else if (un == 12) { k0 = 1; ob0 = 384 + 256; k1 = 4; ob1 = 1792; }
    else { k0 = 4; ob0 = 1792 + 128; k1 = -2; }
    const int cl = 32 * wc + 8 * fq;
    const int rbase = u.pm * 256 + 64 * wr + fr;
    const __amdgpu_buffer_rsrc_t irs = mk_rsrc(inter, (unsigned)NTOK * IW * 2u);
    auto body = [&](auto K0c, auto K1c) {
      constexpr int K0 = decltype(K0c)::value, K1 = decltype(K1c)::value;
#pragma unroll
      for (int ai = 0; ai < 2; ++ai)
#pragma unroll
        for (int m = 0; m < 4; ++m) {
          const int row = rbase + 128 * ai + 16 * m;
          const float rs = rsqrtf(P.s[ai * 4 + m] * (1.f / 1024.f) + EPS);
          float a[8], b[8], o[8];
#pragma unroll
          for (int i = 0; i < 4; i++) {
            a[i] = acc[ai][0][m][0][i] * rs; a[4 + i] = acc[ai][0][m][1][i] * rs;
            b[i] = acc[ai][1][m][0][i] * rs; b[4 + i] = acc[ai][1][m][1][i] * rs;
          }
          const unsigned rpo = ((unsigned)row * IW + cl) * 2u;
          if (K1 == -1) {
#pragma unroll
            for (int i = 0; i < 8; i++) o[i] = (K0 == 0) ? a[i] * sigmoidf_(b[i]) : (K0 == 2) ? a[i] * b[i] : a[i] * siluf_(b[i]);
            st16_wt(irs, rpo + ob0 * 2u, pack8(o));
          } else {
#pragma unroll
            for (int i = 0; i < 8; i++) o[i] = (K0 == 1) ? siluf_(a[i]) : a[i];
            st16_wt(irs, rpo + ob0 * 2u, pack8(o));
            if (K1 != -2) {
#pragma unroll
              for (int i = 0; i < 8; i++) o[i] = (K1 == 1) ? siluf_(b[i]) : b[i];
              st16_wt(irs, rpo + ob1 * 2u, pack8(o));
            }
          }
        }
    };
    using std::integral_constant;
    if (k1 == -1) {
      if (k0 == 0) body(integral_constant<int, 0>{}, integral_constant<int, -1>{});
      else if (k0 == 2) body(integral_constant<int, 2>{}, integral_constant<int, -1>{});
      else body(integral_constant<int, 3>{}, integral_constant<int, -1>{});
    } else if (k1 == 1) body(integral_constant<int, 1>{}, integral_constant<int, 1>{});
    else if (k1 == 4) body(integral_constant<int, 1>{}, integral_constant<int, 4>{});
    else body(integral_constant<int, 4>{}, integral_constant<int, -2>{});
  }
};
struct Epi2 {
  static constexpr bool PERM = true, AFTER_DRAIN = false;
  u16* xb; float* ssq;
  struct Pre {};
  __device__ __forceinline__ void preload(const pg8::Unit&, int, int, Pre&) const {}
  __device__ __forceinline__ void operator()(const pg8::f32x4 (&acc)[2][2][4][2], const pg8::Unit& u, int wr, int wc, int fr, int fq, const Pre&) const {
    const int cl = u.pn * 256 + 32 * wc + 8 * fq;
    const __amdgpu_buffer_rsrc_t xrs = mk_rsrc(xb, (unsigned)NTOK * DM * 2u);
#pragma unroll
    for (int ai = 0; ai < 2; ++ai)
#pragma unroll
      for (int m = 0; m < 4; ++m) {
        const int row = u.pm * 256 + 128 * ai + 64 * wr + 16 * m + fr;
        u16* rp = xb + (size_t)row * DM + cl;
        uint4 o0 = *(const uint4*)(rp), o1 = *(const uint4*)(rp + 128);
        float x0[8], x1[8];
        unpack8(o0, x0);
        unpack8(o1, x1);
        float ss = 0.f;
#pragma unroll
        for (int i = 0; i < 4; i++) {
          x0[i] += acc[ai][0][m][0][i]; x0[4 + i] += acc[ai][0][m][1][i];
          x1[i] += acc[ai][1][m][0][i]; x1[4 + i] += acc[ai][1][m][1][i];
        }
#pragma unroll
        for (int i = 0; i < 8; i++) ss += x0[i] * x0[i] + x1[i] * x1[i];
        const unsigned xo = ((unsigned)row * DM + cl) * 2u;
        st16_wt(xrs, xo, pack8(x0));
        st16_wt(xrs, xo + 256u, pack8(x1));
        ss += __shfl_xor(ss, 16);
        ss += __shfl_xor(ss, 32);
        if (fq == 0) atomicAdd(ssq + row, ss);
      }
  }
};

__device__ void phase1(const Params& p, int l, char* smem) {
  pg8::Gemm g{p.xb, p.win_b + (size_t)l * INWP * DM, NTOK, INWP, DM};
  pg8::StaticOrder S;
  S.init(NTOK, INWP, (int)gridDim.x, (int)blockIdx.x);
  Epi1 E{p.inter, p.sumsq + (size_t)l * NTOK};
  pg8::gemm_phase<Epi1, pg8::StaticOrder, false>((PG8_LAS unsigned char*)smem, g, S, E, nullptr);
  if (l == 0) {
    const int G = (int)gridDim.x, c = (int)blockIdx.x;
    const int rem = ((NTOK / 256) * (INWP / 256)) % G;
    const int nidle = (rem == 0) ? G : G - rem;
    const int rank = (rem == 0) ? c : c - rem;
    if (rank >= 0) p0_weights(p, 1, rank, nidle, (float*)smem);
  }
}
__device__ void phase3_sample(const Params& p, int l, char* smem) {
  const int tid = otid();
  const int lane = tid & 63, w = tid >> 6;
  const int l32 = lane & 31, lh = lane >> 5;
  float* part = (float*)smem;
  float* ssq = p.sumsq + (size_t)(l + 1) * NTOK;
  for (int T = blockIdx.x; T < 256; T += gridDim.x) {
    const int row0 = NPR + (T >> 4) * 32, col0 = (T & 15) * 64;
    const u16* ap = p.mix + (size_t)(row0 + l32) * DM + w * 128 + lh * 8;
    const u16* bp = p.wout_b + ((size_t)l * DM + col0 + l32) * DM + w * 128 + lh * 8;
    bf16x8 af[8], b0[8], b1[8];
#pragma unroll
    for (int s = 0; s < 8; s++) {
      af[s] = *(const bf16x8*)(ap + s * 16);
      b0[s] = *(const bf16x8*)(bp + s * 16);
      b1[s] = *(const bf16x8*)(bp + (size_t)32 * DM + s * 16);
    }
    f32x16 acc0, acc1;
#pragma unroll
    for (int r = 0; r < 16; r++) { acc0[r] = 0.f; acc1[r] = 0.f; }
#pragma unroll
    for (int s = 0; s < 8; s++) {
      acc0 = __builtin_amdgcn_mfma_f32_32x32x16_bf16(b0[s], af[s], acc0, 0, 0, 0);
      acc1 = __builtin_amdgcn_mfma_f32_32x32x16_bf16(b1[s], af[s], acc1, 0, 0, 0);
    }
#pragma unroll
    for (int r = 0; r < 16; r++) {
      part[((w * 2 + 0) * 16 + r) * 64 + lane] = acc0[r];
      part[((w * 2 + 1) * 16 + r) * 64 + lane] = acc1[r];
    }
    __syncthreads();
    float ss = 0.f;
    const int row = row0 + l32;
#pragma unroll
    for (int ni = 0; ni < 2; ni++) {
#pragma unroll
      for (int rr = 0; rr < 2; rr++) {
        const int r = 2 * w + rr;
        float v = 0.f;
#pragma unroll
        for (int pw = 0; pw < 8; pw++) v += part[((pw * 2 + ni) * 16 + r) * 64 + lane];
        const int col = col0 + ni * 32 + (r & 3) + 8 * (r >> 2) + 4 * lh;
        u16* xp = p.xb + (size_t)row * DM + col;
        v += bf2f(*xp);
        ss += v * v;
        *xp = f2bf(v);
      }
    }
    ss += __shfl_xor(ss, 32);
    if (lh == 0) atomicAdd(ssq + row, ss);
    __syncthreads();
  }
}

__device__ void phase3(const Params& p, int l, char* smem) {
  const bool late = (blockIdx.x & 1) != 0;
  if (!late) phase3_sample(p, l, smem);
  pg8::Gemm g{p.mix, p.wout_b + (size_t)l * DM * DM, NPR, DM, DM};
  pg8::StaticOrder S;
  S.init(NPR, DM, (int)gridDim.x, (int)blockIdx.x);
  Epi2 E{p.xb, p.sumsq + (size_t)(l + 1) * NTOK};
  pg8::gemm_phase<Epi2, pg8::StaticOrder, false>((PG8_LAS unsigned char*)smem, g, S, E, nullptr);
  if (late) phase3_sample(p, l, smem);
}

__device__ void p2_stage_w(const Params& p, int l, char* smem) {
  const int tid = otid();
  const float4* src = (const float4*)(p.a_conv_w + (size_t)l * 31 * 384);
  for (int f = tid; f < 36 * 96; f += NT) {
    int j = f / 96, q = f - j * 96;
    float4 v = make_float4(0.f, 0.f, 0.f, 0.f);
    if (j < 31) v = src[f];
    ((float4*)smem)[(j * 2 + (q & 1)) * 48 + (q >> 1)] = v;
  }
}

struct ATileRegs { u32x4 r0, r1, r2, r3, r4, r5; };
__device__ __forceinline__ void p2_ab_load(const Params& p, int it, ATileRegs& A) {
  const int tid = otid();
  const int R0 = it * 32;
  const int spos = R0 & 2047;
  const u16* __restrict__ inter = p.inter;
  auto ld = [&](int i) -> u32x4 {
    const int e = tid + i * NT;
    const int r = e / 48, ch = e - r * 48;
    u32x4 v = {0u, 0u, 0u, 0u};
    if (r < 62 && spos - 30 + r >= 0) v = *(const u32x4*)(inter + (size_t)(R0 - 30 + r) * IW + ch * 8);
    return v;
  };
  A.r0 = ld(0); A.r1 = ld(1); A.r2 = ld(2); A.r3 = ld(3); A.r4 = ld(4); A.r5 = ld(5);
}
__device__ __forceinline__ void p2_ab_store(const ATileRegs& A, char* smem) {
  const int tid = otid();
  char* atile = smem + 55296 + tid * 16;
  *(u32x4*)(atile) = A.r0;
  *(u32x4*)(atile + 1 * NT * 16) = A.r1;
  *(u32x4*)(atile + 2 * NT * 16) = A.r2;
  *(u32x4*)(atile + 3 * NT * 16) = A.r3;
  *(u32x4*)(atile + 4 * NT * 16) = A.r4;
  *(u32x4*)(atile + 5 * NT * 16) = A.r5;
}

typedef float f32x2 __attribute__((ext_vector_type(2)));
__device__ void p2_ab(const Params& p, int l, int it, char* smem) {
  const int tid = otid();
  const int lane = tid & 63, w = tid >> 6;
  const bool active = lane < 48;
  const int o = active ? lane : 47;
  const int R0 = it * 32;
  const int spos = R0 & 2047;
  const int bseq = R0 >> 11;
  const bool last = (spos == 2016);
  const u16* __restrict__ inter = p.inter;
  char* atile = smem + 55296;
  const float4* wts = (const float4*)smem;
  const size_t rowq = (size_t)R0 + 4 * w;
  const __amdgpu_buffer_rsrc_t mrs = mk_rsrc(p.mix, (unsigned)NTOK * DM * 2u);
  uint4 szv[4], gbv[4], zv[6];
#pragma unroll
  for (int t = 0; t < 4; t++) {
    szv[t] = *(const uint4*)(inter + (rowq + t) * IW + 384 + 8 * o);
    gbv[t] = *(const uint4*)(inter + (rowq + t) * IW + 1152 + 8 * o);
  }
#pragma unroll
  for (int s2 = 0; s2 < 6; s2++) {
    zv[s2] = make_uint4(0, 0, 0, 0);
    if (spos + 4 * w - 2 + s2 >= 0) zv[s2] = *(const uint4*)(inter + (rowq - 2 + s2) * IW + 768 + 8 * o);
  }
  f32x2 acc2[4][4];
  {
    float4 b0 = *(const float4*)(p.a_conv_b + l * 384 + 8 * o), b1 = *(const float4*)(p.a_conv_b + l * 384 + 8 * o + 4);
#pragma unroll
    for (int t = 0; t < 4; t++) {
      acc2[t][0] = (f32x2){b0.x, b0.y}; acc2[t][1] = (f32x2){b0.z, b0.w};
      acc2[t][2] = (f32x2){b1.x, b1.y}; acc2[t][3] = (f32x2){b1.z, b1.w};
    }
  }
  f32x2 wwin[4][4];
#pragma unroll
  for (int u = 0; u < 4; u++)
#pragma unroll
    for (int c = 0; c < 4; c++) wwin[u][c] = (f32x2){0.f, 0.f};
  const char* arow = atile + (4 * w) * 768 + o * 16;
#pragma unroll 1
  for (int s4 = 0; s4 < 36; s4 += 4) {
    const char* ar = arow + s4 * 768;
    const float4* wr = wts + (s4 * 2) * 48 + o;
#pragma unroll
    for (int u = 0; u < 4; u++) {
      uint4 av = *(const uint4*)(ar + u * 768);
      float4 wa = wr[(u * 2) * 48], wb = wr[(u * 2 + 1) * 48];
      f32x2 v[4];
      v[0] = (f32x2){__uint_as_float(av.x << 16), __uint_as_float(av.x & 0xffff0000u)};
      v[1] = (f32x2){__uint_as_float(av.y << 16), __uint_as_float(av.y & 0xffff0000u)};
      v[2] = (f32x2){__uint_as_float(av.z << 16), __uint_as_float(av.z & 0xffff0000u)};
      v[3] = (f32x2){__uint_as_float(av.w << 16), __uint_as_float(av.w & 0xffff0000u)};
      wwin[u][0] = (f32x2){wa.x, wa.y}; wwin[u][1] = (f32x2){wa.z, wa.w};
      wwin[u][2] = (f32x2){wb.x, wb.y}; wwin[u][3] = (f32x2){wb.z, wb.w};
#pragma unroll
      for (int t = 0; t < 4; t++) {
#pragma unroll
        for (int c = 0; c < 4; c++) acc2[t][c] = __builtin_elementwise_fma(wwin[(u - t) & 3][c], v[c], acc2[t][c]);
      }
    }
  }
  if (last && active) {
#pragma unroll
    for (int t = 0; t < 4; t++) {
      int pp = spos + 4 * w + t;
      if (pp >= 2018) {
        float v[8];
        unpack8(*(const uint4*)(arow + (30 + t) * 768), v);
        float* so = p.out + O_SAP + ((size_t)(l * 8 + bseq) * 30 + (pp - 2018)) * 384 + 8 * o;
        *(float4*)so = make_float4(v[0], v[1], v[2], v[3]);
        *(float4*)(so + 4) = make_float4(v[4], v[5], v[6], v[7]);
      }
    }
  }
  float acc[4][8];
#pragma unroll
  for (int t = 0; t < 4; t++)
#pragma unroll
    for (int c = 0; c < 4; c++) { acc[t][2 * c] = acc2[t][c].x; acc[t][2 * c + 1] = acc2[t][c].y; }
  float s1[4], s2[4];
#pragma unroll
  for (int t = 0; t < 4; t++) {
    float a = 0.f, b = 0.f;
#pragma unroll
    for (int c = 0; c < 8; c++) { a += acc[t][c]; b += acc[t][c] * acc[t][c]; }
    s1[t] = active ? a : 0.f;
    s2[t] = active ? b : 0.f;
  }
#pragma unroll
  for (int t = 0; t < 4; t++) {
#pragma unroll
    for (int m = 32; m >= 1; m >>= 1) { s1[t] += __shfl_xor(s1[t], m); s2[t] += __shfl_xor(s2[t], m); }
  }
  {
    float g8[8], b8[8];
    {
      float4 a0 = *(const float4*)(p.a_ln_g + l * 384 + 8 * o), a1 = *(const float4*)(p.a_ln_g + l * 384 + 8 * o + 4);
      float4 c0 = *(const float4*)(p.a_ln_b + l * 384 + 8 * o), c1 = *(const float4*)(p.a_ln_b + l * 384 + 8 * o + 4);
      g8[0] = a0.x; g8[1] = a0.y; g8[2] = a0.z; g8[3] = a0.w; g8[4] = a1.x; g8[5] = a1.y; g8[6] = a1.z; g8[7] = a1.w;
      b8[0] = c0.x; b8[1] = c0.y; b8[2] = c0.z; b8[3] = c0.w; b8[4] = c1.x; b8[5] = c1.y; b8[6] = c1.z; b8[7] = c1.w;
    }
#pragma unroll
    for (int t = 0; t < 4; t++) {
      float mu = s1[t] * (1.f / 384.f);
      float var = s2[t] * (1.f / 384.f) - mu * mu;
      float rstd = rsqrtf(fmaxf(var, 0.f) + EPS);
      float sz[8], y[8];
      unpack8(szv[t], sz);
#pragma unroll
      for (int c = 0; c < 8; c++) y[c] = siluf_((acc[t][c] - mu) * rstd * g8[c] + b8[c]) * sz[c];
      if (active) st16_wt(mrs, ((unsigned)(rowq + t) * DM + 8 * o) * 2u, pack8(y));
    }
  }
  {
    float w0[8], w1[8], w2[8];
    {
      const float* bw = p.b_conv_w + (size_t)l * 3 * 384 + 8 * o;
      float4 a0 = *(const float4*)(bw), a1 = *(const float4*)(bw + 4);
      float4 c0 = *(const float4*)(bw + 384), c1 = *(const float4*)(bw + 384 + 4);
      float4 d0 = *(const float4*)(bw + 768), d1 = *(const float4*)(bw + 768 + 4);
      w0[0] = a0.x; w0[1] = a0.y; w0[2] = a0.z; w0[3] = a0.w; w0[4] = a1.x; w0[5] = a1.y; w0[6] = a1.z; w0[7] = a1.w;
      w1[0] = c0.x; w1[1] = c0.y; w1[2] = c0.z; w1[3] = c0.w; w1[4] = c1.x; w1[5] = c1.y; w1[6] = c1.z; w1[7] = c1.w;
      w2[0] = d0.x; w2[1] = d0.y; w2[2] = d0.z; w2[3] = d0.w; w2[4] = d1.x; w2[5] = d1.y; w2[6] = d1.z; w2[7] = d1.w;
    }
    float z[6][8];
#pragma unroll
    for (int s2i = 0; s2i < 6; s2i++) unpack8(zv[s2i], z[s2i]);
#pragma unroll
    for (int t = 0; t < 4; t++) {
      float gb[8], y[8];
      unpack8(gbv[t], gb);
#pragma unroll
      for (int c = 0; c < 8; c++) y[c] = gb[c] * (w0[c] * z[t][c] + w1[c] * z[t + 1][c] + w2[c] * z[t + 2][c]);
      if (active) st16_wt(mrs, ((unsigned)(rowq + t) * DM + 384 + 8 * o) * 2u, pack8(y));
    }
    if (last && w == 7 && active) {
#pragma unroll
      for (int i = 0; i < 2; i++) {
        float* so = p.out + O_SBP + ((size_t)(l * 8 + bseq) * 2 + i) * 384 + 8 * o;
        *(float4*)so = make_float4(z[4 + i][0], z[4 + i][1], z[4 + i][2], z[4 + i][3]);
        *(float4*)(so + 4) = make_float4(z[4 + i][4], z[4 + i][5], z[4 + i][6], z[4 + i][7]);
      }
    }
  }
  __syncthreads();
}

__device__ void p2_c(const Params& p, int l, int ci, char* smem) {
  const int tid = otid();
  const int lane = tid & 63, w = tid >> 6;
  const int l32 = lane & 31, lh = lane >> 5;
  const int R0 = ci * 128;
  const u16* __restrict__ inter = p.inter;
  bf16x8 wf[4][8];
  {
    const u16* wb = p.wc_b + ((size_t)(l * 4 + (w >> 1)) * 128 + l32) * 128 + lh * 8;
#pragma unroll
    for (int ks = 0; ks < 8; ks++)
#pragma unroll
      for (int ti = 0; ti < 4; ti++)
        if (ti >= (ks >> 1)) wf[ti][ks] = *(const bf16x8*)(wb + (size_t)ti * 32 * 128 + ks * 16);
  }
  {
    const int tok = tid >> 2, qd = tid & 3;
    const u16* src = inter + (size_t)(R0 + tok) * IW + 1792 + qd * 64;
    uint4 xv[8];
#pragma unroll
    for (int i = 0; i < 8; i++) xv[i] = *(const uint4*)(src + i * 8);
    float s1 = 0.f, s2 = 0.f;
#pragma unroll
    for (int i = 0; i < 8; i++) {
      float f[8];
      unpack8(xv[i], f);
#pragma unroll
      for (int k = 0; k < 8; k++) { s1 += f[k]; s2 += f[k] * f[k]; }
    }
    s1 += __shfl_xor(s1, 1); s2 += __shfl_xor(s2, 1);
    s1 += __shfl_xor(s1, 2); s2 += __shfl_xor(s2, 2);
    const float mu = s1 * (1.f / 256.f);
    const float rstd = rsqrtf(fmaxf(s2 * (1.f / 256.f) - mu * mu, 0.f) + EPS);
    const int tch = tok >> 3, tlo = (tok & 7) * 2;
#pragma unroll
    for (int i = 0; i < 8; i++) {
      float f[8];
      unpack8(xv[i], f);
#pragma unroll
      for (int k = 0; k < 8; k++) {
        const int c = qd * 64 + i * 8 + k;
        *(u16*)(smem + c * 256 + ((tch ^ (c & 15)) << 4) + tlo) = f2bf((f[k] - mu) * rstd);
      }
    }
  }
  __syncthreads();
  {
    const int h = w >> 1;
    const int cbase = h * 64 + (w & 1) * 32;
    const int c = cbase + l32;
    f32x16 acc[4];
#pragma unroll
    for (int ti = 0; ti < 4; ti++)
#pragma unroll
      for (int r = 0; r < 16; r++) acc[ti][r] = 0.f;
#pragma unroll
    for (int ks = 0; ks < 8; ks++) {
      bf16x8 vfrag = *(const bf16x8*)(smem + c * 256 + (((ks * 2 + lh) ^ (c & 15)) << 4));
#pragma unroll
      for (int ti = 0; ti < 4; ti++) {
        if (ti >= (ks >> 1)) acc[ti] = __builtin_amdgcn_mfma_f32_32x32x16_bf16(vfrag, wf[ti][ks], acc[ti], 0, 0, 0);
      }
    }
    float4 gl[4], bl[4];
#pragma unroll
    for (int g = 0; g < 4; g++) {
      gl[g] = *(const float4*)(p.c_ln_g + l * 256 + cbase + 8 * g + 4 * lh);
      bl[g] = *(const float4*)(p.c_ln_b + l * 256 + cbase + 8 * g + 4 * lh);
    }
#pragma unroll
    for (int ti = 0; ti < 4; ti++) {
      const int t = ti * 32 + l32;
      const size_t row = (size_t)R0 + t;
      const float rsw = p.rsw[(l * 4 + h) * 128 + t];
      const float bs = p.c_bs[(l * 4 + h) * 128 + t];
#pragma unroll
      for (int g = 0; g < 4; g++) {
        const int d0 = cbase + 8 * g + 4 * lh;
        uint2 gc = *(const uint2*)(inter + row * IW + 1536 + d0);
        float y0 = __uint_as_float(gc.x << 16) * (gl[g].x * acc[ti][4 * g + 0] + bl[g].x * rsw + bs);
        float y1 = __uint_as_float(gc.x & 0xffff0000u) * (gl[g].y * acc[ti][4 * g + 1] + bl[g].y * rsw + bs);
        float y2 = __uint_as_float(gc.y << 16) * (gl[g].z * acc[ti][4 * g + 2] + bl[g].z * rsw + bs);
        float y3 = __uint_as_float(gc.y & 0xffff0000u) * (gl[g].w * acc[ti][4 * g + 3] + bl[g].w * rsw + bs);
        *(uint2*)(p.mix + row * DM + 768 + d0) = make_uint2(pack2(y0, y1), pack2(y2, y3));
      }
    }
  }
  __syncthreads();
}

__device__ void p2_s(const Params& p, int l, int n, float* red, float* smem_f) {
  const int tid = otid();
  const int lane = tid & 63, w = tid >> 6;
  const int c = tid;
  const size_t Rs = NPR + (size_t)n * 4;
  const u16* __restrict__ inter = p.inter;
  float rv[16];
#pragma unroll
  for (int i = 0; i < 16; i++) rv[i] = 0.f;
  float o[4] = {0.f, 0.f, 0.f, 0.f};
  float zin[6] = {0.f, 0.f, 0.f, 0.f, 0.f, 0.f};
  float cvv[4] = {0.f, 0.f, 0.f, 0.f};
  if (c < 384) {
    float in[34], wv[31];
    const float* sa = p.state_a + ((size_t)(l * 128 + n) * 30) * 384 + c;
    float* so = p.out + O_SAS + ((size_t)(l * 128 + n) * 30) * 384 + c;
#pragma unroll
    for (int i = 0; i < 30; i++) in[i] = sa[i * 384];
#pragma unroll
    for (int t = 0; t < 4; t++) in[30 + t] = bf2f(inter[(Rs + t) * IW + c]);
#pragma unroll
    for (int j = 0; j < 31; j++) wv[j] = p.a_conv_w[(l * 31 + j) * 384 + c];
    const float bias = p.a_conv_b[l * 384 + c];
#pragma unroll
    for (int i = 0; i < 30; i++) so[i * 384] = in[4 + i];
#pragma unroll
    for (int t = 0; t < 4; t++) o[t] = bias;
#pragma unroll
    for (int j = 0; j < 31; j++) {
#pragma unroll
      for (int t = 0; t < 4; t++) o[t] += wv[j] * in[t + j];
    }
#pragma unroll
    for (int t = 0; t < 4; t++) { rv[t] = o[t]; rv[4 + t] = o[t] * o[t]; }
    const float* sb = p.state_b + ((size_t)(l * 128 + n) * 2) * 384 + c;
    zin[0] = sb[0]; zin[1] = sb[384];
#pragma unroll
    for (int t = 0; t < 4; t++) zin[2 + t] = bf2f(inter[(Rs + t) * IW + 768 + c]);
  }
  if (c < 256) {
#pragma unroll
    for (int t = 0; t < 4; t++) {
      cvv[t] = bf2f(inter[(Rs + t) * IW + 1792 + c]);
      rv[8 + t] = cvv[t];
      rv[12 + t] = cvv[t] * cvv[t];
    }
  }
#pragma unroll
  for (int i = 0; i < 16; i++) {
#pragma unroll
    for (int m = 32; m >= 1; m >>= 1) rv[i] += __shfl_xor(rv[i], m);
  }
  if (lane == 0) {
#pragma unroll
    for (int i = 0; i < 16; i++) red[w * 16 + i] = rv[i];
  }
  __syncthreads();
#pragma unroll
  for (int i = 0; i < 16; i++) {
    float s = 0.f;
#pragma unroll
    for (int ww = 0; ww < 8; ww++) s += red[ww * 16 + i];
    rv[i] = s;
  }
  if (c < 384) {
    const float g = p.a_ln_g[l * 384 + c], bb = p.a_ln_b[l * 384 + c];
    const float w0 = p.b_conv_w[(l * 3 + 0) * 384 + c], w1 = p.b_conv_w[(l * 3 + 1) * 384 + c], w2 = p.b_conv_w[(l * 3 + 2) * 384 + c];
#pragma unroll
    for (int t = 0; t < 4; t++) {
      float m_ = rv[t] * (1.f / 384.f);
      float var = rv[4 + t] * (1.f / 384.f) - m_ * m_;
      float rstd = rsqrtf(fmaxf(var, 0.f) + EPS);
      float y = (o[t] - m_) * rstd * g + bb;
      float ya = siluf_(y) * bf2f(inter[(Rs + t) * IW + 384 + c]);
      p.mix[(Rs + t) * DM + c] = f2bf(ya);
      float cv = w0 * zin[t] + w1 * zin[t + 1] + w2 * zin[t + 2];
      float yb = bf2f(inter[(Rs + t) * IW + 1152 + c]) * cv;
      p.mix[(Rs + t) * DM + 384 + c] = f2bf(yb);
    }
    p.out[O_SBS + ((size_t)(l * 128 + n) * 2 + 0) * 384 + c] = zin[4];
    p.out[O_SBS + ((size_t)(l * 128 + n) * 2 + 1) * 384 + c] = zin[5];
  }
  if (c < 256) {
    const float g = p.c_ln_g[l * 256 + c], bb = p.c_ln_b[l * 256 + c];
    const int h = c >> 6;
    float vn[4];
#pragma unroll
    for (int t = 0; t < 4; t++) {
      float m_ = rv[8 + t] * (1.f / 256.f);
      float var = rv[12 + t] * (1.f / 256.f) - m_ * m_;
      float rstd = rsqrtf(fmaxf(var, 0.f) + EPS);
      vn[t] = (cvv[t] - m_) * rstd * g + bb;
      p.out[O_SCV + ((size_t)(l * 128 + n) * 4 + t) * 256 + c] = vn[t];
    }
#pragma unroll
    for (int t = 0; t < 4; t++) {
      float acc = p.c_bs[(l * 4 + h) * 128 + t];
#pragma unroll
      for (int s = 0; s < 4; s++)
        if (s <= t) acc += p.c_ws[((size_t)(l * 4 + h) * 128 + t) * 128 + s] * vn[s];
      float yc = bf2f(inter[(Rs + t) * IW + 1536 + c]) * acc;
      p.mix[(Rs + t) * DM + 768 + c] = f2bf(yc);
    }
  }
  __syncthreads();
}

__device__ void phase2(const Params& p, int l, char* smem) {
  float* red = (float*)(smem + 90112);
  const int nb = gridDim.x, b = blockIdx.x;
  const bool cfirst = (b & 1) != 0;
  ATileRegs A;
  if (cfirst && b < 512) p2_ab_load(p, b, A);
  p2_stage_w(p, l, smem);
  if (cfirst) {
    for (int it = b; it < 128; it += nb) {
      asm volatile("" ::: "memory");
      p2_c(p, l, it, smem + 55296);
    }
    for (int it = (b + nb - (128 % nb)) % nb; it < 128; it += nb) {
      asm volatile("" ::: "memory");
      p2_s(p, l, it, red, (float*)smem);
    }
    __syncthreads();
  } else {
    if (b < 512) p2_ab_load(p, b, A);
  }
#pragma unroll 1
  for (int it = b; it < 512; it += nb) {
    p2_ab_store(A, smem);
    __syncthreads();
    const int nx = (it + nb < 512) ? it + nb : it;
    p2_ab_load(p, nx, A);
    p2_ab(p, l, it, smem);
  }
  if (!cfirst) {
    for (int it = b; it < 128; it += nb) {
      asm volatile("" ::: "memory");
      p2_c(p, l, it, smem + 55296);
    }
    for (int it = (b + nb - (128 % nb)) % nb; it < 128; it += nb) {
      asm volatile("" ::: "memory");
      p2_s(p, l, it, red, (float*)smem);
    }
  }
}

__device__ void phase4(const Params& p) {
  const int tid = otid();
  const float* ssq = p.sumsq + (size_t)2 * NTOK;
  for (int idx = blockIdx.x * NT + tid; idx < NTOK * 128; idx += gridDim.x * NT) {
    const int row = idx >> 7, c8 = idx & 127;
    uint4 v = *(const uint4*)(p.xb + (size_t)row * DM + c8 * 8);
    const float rs = rsqrtf(ssq[row] * (1.f / 1024.f) + EPS);
    float4 g0 = *(const float4*)(p.final_g + c8 * 8), g1 = *(const float4*)(p.final_g + c8 * 8 + 4);
    float f[8];
    unpack8(v, f);
    float* o = p.out + (size_t)row * DM + c8 * 8;
    *(float4*)o = make_float4(f[0] * rs * g0.x, f[1] * rs * g0.y, f[2] * rs * g0.z, f[3] * rs * g0.w);
    *(float4*)(o + 4) = make_float4(f[4] * rs * g1.x, f[5] * rs * g1.y, f[6] * rs * g1.z, f[7] * rs * g1.w);
  }
}

#define CEN_WORD(j) (XCD_BAR_WORDS + 64 * (j))
#define BAR_TOTAL_WORDS (XCD_BAR_WORDS + 64 * 16)
__global__ void __launch_bounds__(NT) fwd_megakernel(Params p) {
  extern __shared__ __attribute__((aligned(16))) char smem[];
  __shared__ uint4 xb_words;
  __shared__ uint4 sched_words;
  if (threadIdx.x == 0) {
    xb_words = make_uint4(0u, 0u, 0u, 0u);
    const unsigned x = xb_xcc_id();
    const unsigned slot = xb_add(&p.bar[CEN_WORD(x)], 1u);
    sched_words = make_uint4(slot, 1u, 0u, gridDim.x);
  }
  __syncthreads();
  XcdBarrier gb = xcd_barrier_post(p.bar, (volatile LAS unsigned*)&xb_words);
  const volatile LAS unsigned* sched = (const volatile LAS unsigned*)&sched_words;
  phase0(p, smem);
  xcd_barrier(gb);
  if (threadIdx.x == 0) {
    const unsigned x = xb_xcc_id();
    unsigned prefix = 0u, mine = 1u;
#pragma unroll
    for (unsigned j = 0; j < 16; ++j) {
      const unsigned c = xb_ld(&p.bar[CEN_WORD(j)]);
      prefix += (j < x) ? c : 0u;
      mine = (j == x) ? c : mine;
    }
    volatile LAS unsigned* sw = (volatile LAS unsigned*)&sched_words;
    sw[1] = mine;
    sw[2] = prefix;
  }
  __syncthreads();
#pragma unroll 1
  for (int l = 0; l < 2; l++) {
    phase1(p, l, smem);
    xcd_barrier(gb);
    phase2(p, l, smem);
    xcd_barrier(gb);
    phase3(p, l, smem);
    xcd_barrier(gb);
  }
  phase4(p);
}

extern "C" void kernel_launch(void* const* d_in, const int* in_sizes, int n_in, void* d_out, int out_size, void* d_ws,
                              size_t ws_size, hipStream_t stream) {
  static int grid_blocks = 0;
  if (!grid_blocks) {
    int dev = 0, cus = 0, per_cu = 0;
    hipGetDevice(&dev);
    hipDeviceGetAttribute(&cus, hipDeviceAttributeMultiprocessorCount, dev);
    hipFuncSetAttribute((const void*)fwd_megakernel, hipFuncAttributeMaxDynamicSharedMemorySize, LDS_BYTES);
    hipOccupancyMaxActiveBlocksPerMultiprocessor(&per_cu, (const void*)fwd_megakernel, NT, LDS_BYTES);
    if (per_cu < 1) { fprintf(stderr, "occupancy query returned %d\n", per_cu); per_cu = 1; }
    if (per_cu > 1) per_cu = 1;
    grid_blocks = cus * per_cu;
  }
  Params p{};
  p.x_prompt = (const float*)d_in[0];
  p.x_sample = (const float*)d_in[1];
  p.state_a = (const float*)d_in[2];
  p.state_b = (const float*)d_in[3];
  p.norm_g = (const float*)d_in[4];
  p.w_in = (const float*)d_in[5];
  p.a_conv_w = (const float*)d_in[6];
  p.a_conv_b = (const float*)d_in[7];
  p.a_ln_g = (const float*)d_in[8];
  p.a_ln_b = (const float*)d_in[9];
  p.b_conv_w = (const float*)d_in[10];
  p.c_ln_g = (const float*)d_in[11];
  p.c_ln_b = (const float*)d_in[12];
  p.c_ws = (const float*)d_in[13];
  p.c_bs = (const float*)d_in[14];
  p.w_out = (const float*)d_in[15];
  p.final_g = (const float*)d_in[16];
  p.out = (float*)d_out;
  char* ws = (char*)d_ws;
  size_t off = 0;
  auto take = [&](size_t bytes) { char* r = ws + off; off += (bytes + 255) & ~(size_t)255; return r; };
  p.win_b = (u16*)take((size_t)2 * 3584 * DM * 2);
  p.wout_b = (u16*)take((size_t)2 * DM * DM * 2);
  p.wc_b = (u16*)take((size_t)2 * 4 * 128 * 128 * 2);
  p.xb = (u16*)take((size_t)NTOK * DM * 2);
  p.inter = (u16*)take((size_t)NTOK * IW * 2);
  p.mix = (u16*)take((size_t)NTOK * DM * 2);
  p.sumsq = (float*)take((size_t)3 * NTOK * 4);
  p.rsw = (float*)take((size_t)2 * 4 * 128 * 4);
  p.bar = (unsigned*)take((size_t)BAR_TOTAL_WORDS * 4);
  hipMemsetAsync(p.bar, 0, (size_t)BAR_TOTAL_WORDS * 4, stream);
  void* args[] = {&p};
  hipError_t e = hipLaunchCooperativeKernel((const void*)fwd_megakernel, dim3(grid_blocks), dim3(NT), args, LDS_BYTES, stream);
  if (e != hipSuccess) fprintf(stderr, "cooperative launch failed: %s (grid %d)\n", hipGetErrorString(e), grid_blocks);
}
```
